# Optimizing an MI355X kernel written in HIP

```python
import math
import jax, jax.numpy as jnp
from jax import lax
import numpy as np

D_MODEL = 1024
BATCH = 8
SEQ = 4096
DEPTH = 2

MEM_LEN = 256
EPS = 1e-6
D_MIX = D_MODEL
RET_W = D_MIX // 4
RET_HEADS = 4
RET_HEAD_DIM = RET_W // RET_HEADS
RET_CHUNK = 128
ROPE_BASE = 10000.0
SSD_W = D_MIX // 2
SSD_HEAD_DIM = 64
SSD_HEADS = SSD_W // SSD_HEAD_DIM
SSD_GROUPS = 2
SSD_STATE = 128
SSD_CONV = 4
SSD_CHUNK = 128
SSD_XBC_W = SSD_W + 2 * SSD_GROUPS * SSD_STATE
S5_W = D_MIX - RET_W - SSD_W
S5_GROUP = 16
S5_GROUPS = S5_W // S5_GROUP
S5_STATE = 64
IN_SIZES = (RET_W, RET_W, RET_W, RET_W, SSD_W, SSD_XBC_W, SSD_HEADS, S5_W)
IN_COLS = RET_W * 4 + SSD_W + SSD_XBC_W + SSD_HEADS + S5_W
CROSS_HEADS = 4
CROSS_HEAD_DIM = D_MODEL // CROSS_HEADS
MOE_GROUPS = 4
EXPERTS_PER_GROUP = 8
N_EXPERTS = MOE_GROUPS * EXPERTS_PER_GROUP
TOP_K_INNER = 2
D_EXPERT = D_MODEL // 2
MOE_BLOCK = 128

kernel_name = "hybrid_ret_ssd_s5_hmoe"

F32 = jnp.float32


def rmsnorm(x, g):
    xf = x.astype(F32)
    y = xf * lax.rsqrt(jnp.mean(xf * xf, axis=-1, keepdims=True) + EPS)
    return (y * g.astype(F32)).astype(x.dtype)


def rotary(t):
    L, d = t.shape[1], t.shape[-1]
    inv = ROPE_BASE ** (-jnp.arange(0, d, 2, dtype=F32) / d)
    ang = jnp.arange(L, dtype=F32)[:, None] * inv[None, :]
    cos = jnp.cos(ang)[None, :, None, :]
    sin = jnp.sin(ang)[None, :, None, :]
    t1, t2 = t[..., : d // 2].astype(F32), t[..., d // 2:].astype(F32)
    return jnp.concatenate([t1 * cos - t2 * sin, t1 * sin + t2 * cos], axis=-1)


def retention(q, k, v):
    b, L, H, dh = q.shape
    C = RET_CHUNK
    nc = L // C
    lg = jnp.log1p(-(2.0 ** (-5.0 - jnp.arange(H, dtype=F32))))
    q = rotary(q)
    k = rotary(k) * (dh ** -0.5)

    def chunks(t):
        return t.reshape(b, nc, C, H, dh).transpose(0, 3, 1, 2, 4)

    qc, kc, vc = chunks(q), chunks(k), chunks(v.astype(F32))
    i = jnp.arange(C, dtype=F32)
    rel = i[:, None] - i[None, :]
    decay = jnp.where(rel[None] >= 0, jnp.exp(lg[:, None, None] * jnp.maximum(rel, 0.0)[None]), 0.0)
    s = jnp.einsum('bhcid,bhcjd->bhcij', qc, kc) * decay[None, :, None]
    y_in = jnp.einsum('bhcij,bhcjd->bhcid', s, vc)
    k_dec = kc * jnp.exp(lg[:, None] * (C - 1.0 - i)[None])[None, :, None, :, None]
    kv = jnp.einsum('bhcjd,bhcje->bhcde', k_dec, vc)
    chunk_decay = jnp.exp(lg * C)[None, :, None, None]

    def step(S, kv_c):
        return S * chunk_decay + kv_c, S

    _, S_prev = lax.scan(step, jnp.zeros_like(kv[:, :, 0]), kv.transpose(2, 0, 1, 3, 4))
    S_prev = S_prev.transpose(1, 2, 0, 3, 4)
    q_dec = qc * jnp.exp(lg[:, None] * (i + 1.0)[None])[None, :, None, :, None]
    y_x = jnp.einsum('bhcid,bhcde->bhcie', q_dec, S_prev)
    return (y_in + y_x).transpose(0, 2, 3, 1, 4).reshape(b, L, H, dh)


def ssd_mixer(z, xbc, dt_raw, conv_w, conv_b, dt_bias, A_log, D, norm_g):
    b, L, _ = xbc.shape
    xpad = jnp.pad(xbc, ((0, 0), (SSD_CONV - 1, 0), (0, 0)))
    conv = conv_b
    for j in range(SSD_CONV):
        conv = conv + xpad[:, j:j + L] * conv_w[j]
    xbc = jax.nn.silu(conv)
    xs = xbc[..., :SSD_W]
    Bm = xbc[..., SSD_W:SSD_W + SSD_GROUPS * SSD_STATE]
    Cm = xbc[..., SSD_W + SSD_GROUPS * SSD_STATE:]
    G, R, P, N = SSD_GROUPS, SSD_HEADS // SSD_GROUPS, SSD_HEAD_DIM, SSD_STATE
    C = SSD_CHUNK
    nc = L // C
    x = xs.astype(F32).reshape(b, nc, C, G, R, P)
    Bc = Bm.astype(F32).reshape(b, nc, C, G, N)
    Cc = Cm.astype(F32).reshape(b, nc, C, G, N)
    dt = jax.nn.softplus((dt_raw + dt_bias).astype(F32)).reshape(b, nc, C, G, R)
    A = -jnp.exp(A_log.astype(F32)).reshape(G, R)
    A_cum = jnp.cumsum(dt * A, axis=2)
    Acum_t = A_cum.transpose(0, 1, 3, 4, 2)
    diff = Acum_t[..., :, None] - Acum_t[..., None, :]
    causal = jnp.tril(jnp.ones((C, C), dtype=bool))
    Lmat = jnp.exp(jnp.where(causal, diff, -jnp.inf))
    CB = jnp.einsum('bclgn,bcsgn->bcgls', Cc, Bc)
    xdt = x * dt[..., None]
    y_diag = jnp.einsum('bcgrls,bcsgrp->bclgrp', CB[:, :, :, None] * Lmat, xdt)
    decay_states = jnp.exp(A_cum[:, :, -1:] - A_cum)
    states = jnp.einsum('bclgn,bclgrp->bcgrpn', Bc, xdt * decay_states[..., None])
    chunk_decay = jnp.exp(A_cum[:, :, -1])

    def step(S, inp):
        st, dc = inp
        return S * dc[..., None, None] + st, S

    _, S_prev = lax.scan(step, jnp.zeros((b, G, R, P, N), F32),
                         (states.transpose(1, 0, 2, 3, 4, 5), chunk_decay.transpose(1, 0, 2, 3)))
    S_prev = S_prev.transpose(1, 0, 2, 3, 4, 5)
    y_off = jnp.einsum('bclgn,bcgrpn->bclgrp', Cc, S_prev) * jnp.exp(A_cum)[..., None]
    y = y_diag + y_off + x * D.astype(F32).reshape(G, R)[..., None]
    y = y.reshape(b, L, SSD_W)
    return rmsnorm(y * jax.nn.silu(z.astype(F32)), norm_g)


def _complex_affine_combine(e1, e2):
    a1r, a1i, b1r, b1i = e1
    a2r, a2i, b2r, b2i = e2
    return (a2r * a1r - a2i * a1i,
            a2r * a1i + a2i * a1r,
            a2r * b1r - a2i * b1i + b2r,
            a2r * b1i + a2i * b1r + b2i)


def s5_mixer(u, A_re, A_im, B_re, B_im, C_re, C_im, log_step, D, w_glu, b_glu):
    b, L, _ = u.shape
    ug = u.astype(F32).reshape(b, L, S5_GROUPS, S5_GROUP)
    delta = jnp.exp(log_step.astype(F32))[:, None]
    ar, ai = A_re.astype(F32), A_im.astype(F32)
    mag = jnp.exp(ar * delta)
    ang = ai * delta
    lr, li = mag * jnp.cos(ang), mag * jnp.sin(ang)
    den = ar * ar + ai * ai
    nr, ni = lr - 1.0, li
    cr = (nr * ar + ni * ai) / den
    ci = (ni * ar - nr * ai) / den
    br, bi = B_re.astype(F32), B_im.astype(F32)
    Bbr = cr[..., None] * br - ci[..., None] * bi
    Bbi = cr[..., None] * bi + ci[..., None] * br
    bu_r = jnp.einsum('blgc,gpc->blgp', ug, Bbr)
    bu_i = jnp.einsum('blgc,gpc->blgp', ug, Bbi)
    a_r = jnp.broadcast_to(lr, bu_r.shape)
    a_i = jnp.broadcast_to(li, bu_r.shape)
    _, _, xr, xi = lax.associative_scan(_complex_affine_combine, (a_r, a_i, bu_r, bu_i), axis=1)
    y = (jnp.einsum('gcp,blgp->blgc', C_re.astype(F32), xr)
         - jnp.einsum('gcp,blgp->blgc', C_im.astype(F32), xi))
    y = y.reshape(b, L, S5_W) + D.astype(F32) * u.astype(F32)
    g = jax.nn.gelu(y)
    return g * jax.nn.sigmoid(g @ w_glu.astype(F32) + b_glu.astype(F32))


def hybrid_mixer(hn, w_in, ret_gn_g, ssd_conv_w, ssd_conv_b, ssd_dt_bias, ssd_A_log, ssd_D, ssd_norm_g,
                 s5_A_re, s5_A_im, s5_B_re, s5_B_im, s5_C_re, s5_C_im, s5_log_step, s5_D, s5_w_glu, s5_b_glu,
                 w_out):
    b, L, _ = hn.shape
    proj = hn @ w_in
    splits = [int(s) for s in np.cumsum(IN_SIZES)[:-1]]
    q, k, v, g, z, xbc, dt_raw, u = jnp.split(proj, splits, axis=-1)
    shp = (b, L, RET_HEADS, RET_HEAD_DIM)
    yr = retention(q.reshape(shp), k.reshape(shp), v.reshape(shp))
    yr = yr * lax.rsqrt(jnp.mean(yr * yr, axis=-1, keepdims=True) + EPS)
    out_r = jax.nn.silu(g.astype(F32)) * (yr.reshape(b, L, RET_W) * ret_gn_g.astype(F32))
    out_m = ssd_mixer(z, xbc, dt_raw, ssd_conv_w, ssd_conv_b, ssd_dt_bias, ssd_A_log, ssd_D, ssd_norm_g)
    out_s = s5_mixer(u, s5_A_re, s5_A_im, s5_B_re, s5_B_im, s5_C_re, s5_C_im, s5_log_step, s5_D,
                     s5_w_glu, s5_b_glu)
    cat = jnp.concatenate([out_r, out_m.astype(F32), out_s], axis=-1).astype(hn.dtype)
    return cat @ w_out


def cross_attend(hn, mn, wq, wk, wv, wo):
    b, L, _ = hn.shape
    q = (hn @ wq).reshape(b, L, CROSS_HEADS, CROSS_HEAD_DIM)
    k = (mn @ wk).reshape(b, MEM_LEN, CROSS_HEADS, CROSS_HEAD_DIM)
    v = (mn @ wv).reshape(b, MEM_LEN, CROSS_HEADS, CROSS_HEAD_DIM)
    s = jnp.einsum('blhd,bmhd->bhlm', q, k).astype(F32) * (CROSS_HEAD_DIM ** -0.5)
    p = jax.nn.softmax(s, axis=-1).astype(v.dtype)
    o = jnp.einsum('bhlm,bmhd->blhd', p, v).reshape(b, L, D_MODEL)
    return o @ wo


def hier_moe(xn, w_rg, b_rg, w_re, b_re, w_gate, w_up, w_down):
    T, d = xn.shape
    glog = (xn @ w_rg + b_rg).astype(F32)
    gsel = jnp.argmax(glog, axis=-1)
    pg = jnp.take_along_axis(jax.nn.softmax(glog, axis=-1), gsel[:, None], axis=-1)
    elog = (xn @ w_re + b_re).astype(F32).reshape(T, MOE_GROUPS, EXPERTS_PER_GROUP)
    elog = jnp.take_along_axis(elog, gsel[:, None, None], axis=1)[:, 0]
    top_p, top_i = lax.top_k(jax.nn.softmax(elog, axis=-1), TOP_K_INNER)
    gate = pg * top_p / jnp.sum(top_p, axis=-1, keepdims=True)
    expert = gsel[:, None] * EXPERTS_PER_GROUP + top_i
    flat_e = expert.reshape(-1)
    flat_t = jnp.repeat(jnp.arange(T), TOP_K_INNER)
    flat_w = gate.reshape(-1)
    M = T * TOP_K_INNER
    order = jnp.argsort(flat_e)
    se, st, sw = flat_e[order], flat_t[order], flat_w[order]
    counts = jnp.bincount(flat_e, length=N_EXPERTS)
    starts = jnp.cumsum(counts) - counts
    padded = (counts + MOE_BLOCK - 1) // MOE_BLOCK * MOE_BLOCK
    pends = jnp.cumsum(padded)
    pstarts = pends - padded
    dest = pstarts[se] + jnp.arange(M) - starts[se]
    nb = -(-M // MOE_BLOCK) + N_EXPERTS
    buf = jnp.zeros((nb * MOE_BLOCK, d), xn.dtype).at[dest].set(xn[st])
    block_e = jnp.minimum(jnp.searchsorted(pends, jnp.arange(nb) * MOE_BLOCK, side='right'), N_EXPERTS - 1)

    def expert_block(args):
        xb, e = args
        h = jax.nn.silu(xb @ w_gate[e]) * (xb @ w_up[e])
        return h @ w_down[e]

    ybuf = lax.map(expert_block, (buf.reshape(nb, MOE_BLOCK, d), block_e)).reshape(nb * MOE_BLOCK, d)
    y = ybuf[dest].astype(F32) * sw[:, None]
    return jax.ops.segment_sum(y, st, num_segments=T).astype(xn.dtype)


def setup_inputs(seed: int = 0) -> dict:
    key = jax.random.key(seed)
    ks = iter(jax.random.split(key, 48))

    def nrm(shape, scale):
        return jax.random.normal(next(ks), shape, F32) * scale

    def unif(shape, lo, hi):
        return jax.random.uniform(next(ks), shape, F32, lo, hi)

    def gain(shape):
        return 1.0 + nrm(shape, 0.02)

    x = nrm((BATCH, SEQ, D_MODEL), 1.0)
    mem = nrm((BATCH, MEM_LEN, D_MODEL), 1.0)
    dt0 = jnp.exp(unif((DEPTH, SSD_HEADS), math.log(1e-3), math.log(1e-1)))
    n_idx = jnp.arange(S5_STATE, dtype=F32)
    return {
        'x': x,
        'mem': mem,
        'norm_mix_g': gain((DEPTH, D_MODEL)),
        'w_in': nrm((DEPTH, D_MODEL, IN_COLS), D_MODEL ** -0.5),
        'ret_gn_g': gain((DEPTH, RET_W)),
        'ssd_conv_w': nrm((DEPTH, SSD_CONV, SSD_XBC_W), SSD_CONV ** -0.5),
        'ssd_conv_b': nrm((DEPTH, SSD_XBC_W), 0.02),
        'ssd_dt_bias': dt0 + jnp.log(-jnp.expm1(-dt0)),
        'ssd_A_log': jnp.log(unif((DEPTH, SSD_HEADS), 1.0, 16.0)),
        'ssd_D': gain((DEPTH, SSD_HEADS)),
        'ssd_norm_g': gain((DEPTH, SSD_W)),
        's5_A_re': -0.5 + nrm((DEPTH, S5_GROUPS, S5_STATE), 0.01),
        's5_A_im': math.pi * n_idx + nrm((DEPTH, S5_GROUPS, S5_STATE), 0.01),
        's5_B_re': nrm((DEPTH, S5_GROUPS, S5_STATE, S5_GROUP), (2 * S5_GROUP) ** -0.5),
        's5_B_im': nrm((DEPTH, S5_GROUPS, S5_STATE, S5_GROUP), (2 * S5_GROUP) ** -0.5),
        's5_C_re': nrm((DEPTH, S5_GROUPS, S5_GROUP, S5_STATE), (2 * S5_STATE) ** -0.5),
        's5_C_im': nrm((DEPTH, S5_GROUPS, S5_GROUP, S5_STATE), (2 * S5_STATE) ** -0.5),
        's5_log_step': unif((DEPTH, S5_GROUPS), math.log(1e-3), math.log(1e-1)),
        's5_D': nrm((DEPTH, S5_W), 0.5),
        's5_w_glu': nrm((DEPTH, S5_W, S5_W), S5_W ** -0.5),
        's5_b_glu': nrm((DEPTH, S5_W), 0.02),
        'w_out': nrm((DEPTH, D_MIX, D_MODEL), D_MIX ** -0.5),
        'norm_cross_g': gain((DEPTH, D_MODEL)),
        'mem_norm_g': gain((D_MODEL,)),
        'w_cq': nrm((DEPTH, D_MODEL, D_MODEL), D_MODEL ** -0.5),
        'w_ck': nrm((DEPTH, D_MODEL, D_MODEL), D_MODEL ** -0.5),
        'w_cv': nrm((DEPTH, D_MODEL, D_MODEL), D_MODEL ** -0.5),
        'w_co': nrm((DEPTH, D_MODEL, D_MODEL), D_MODEL ** -0.5),
        'norm_ffn_g': gain((DEPTH, D_MODEL)),
        'w_route_group': nrm((DEPTH, D_MODEL, MOE_GROUPS), D_MODEL ** -0.5),
        'b_route_group': nrm((DEPTH, MOE_GROUPS), 0.01),
        'w_route_expert': nrm((DEPTH, D_MODEL, N_EXPERTS), D_MODEL ** -0.5),
        'b_route_expert': nrm((DEPTH, N_EXPERTS), 0.01),
        'w_gate': nrm((DEPTH, N_EXPERTS, D_MODEL, D_EXPERT), D_MODEL ** -0.5),
        'w_up': nrm((DEPTH, N_EXPERTS, D_MODEL, D_EXPERT), D_MODEL ** -0.5),
        'w_down': nrm((DEPTH, N_EXPERTS, D_EXPERT, D_MODEL), D_EXPERT ** -0.5),
        'norm_final_g': gain((D_MODEL,)),
    }


def reference(x, mem, norm_mix_g, w_in, ret_gn_g, ssd_conv_w, ssd_conv_b, ssd_dt_bias, ssd_A_log, ssd_D,
              ssd_norm_g, s5_A_re, s5_A_im, s5_B_re, s5_B_im, s5_C_re, s5_C_im, s5_log_step, s5_D, s5_w_glu,
              s5_b_glu, w_out, norm_cross_g, mem_norm_g, w_cq, w_ck, w_cv, w_co, norm_ffn_g, w_route_group,
              b_route_group, w_route_expert, b_route_expert, w_gate, w_up, w_down, norm_final_g):
    b, L, d = x.shape
    h = x
    mn = rmsnorm(mem, mem_norm_g)
    for i in range(DEPTH):
        hn = rmsnorm(h, norm_mix_g[i])
        h = h + hybrid_mixer(hn, w_in[i], ret_gn_g[i], ssd_conv_w[i], ssd_conv_b[i], ssd_dt_bias[i],
                             ssd_A_log[i], ssd_D[i], ssd_norm_g[i], s5_A_re[i], s5_A_im[i], s5_B_re[i],
                             s5_B_im[i], s5_C_re[i], s5_C_im[i], s5_log_step[i], s5_D[i], s5_w_glu[i],
                             s5_b_glu[i], w_out[i]).astype(h.dtype)
        hn = rmsnorm(h, norm_cross_g[i])
        h = h + cross_attend(hn, mn, w_cq[i], w_ck[i], w_cv[i], w_co[i]).astype(h.dtype)
        hn = rmsnorm(h, norm_ffn_g[i]).reshape(b * L, d)
        h = h + hier_moe(hn, w_route_group[i], b_route_group[i], w_route_expert[i], b_route_expert[i],
                         w_gate[i], w_up[i], w_down[i]).reshape(b, L, d).astype(h.dtype)
    return rmsnorm(h, norm_final_g)
```

```cpp
#include <hip/hip_runtime.h>
#include <cstdio>
#include <cstdint>

#define GAS __attribute__((address_space(1)))
#define LAS __attribute__((address_space(3)))
typedef unsigned short bf16;
typedef unsigned v4u __attribute__((ext_vector_type(4)));
typedef unsigned v2u __attribute__((ext_vector_type(2)));
typedef float f32x4 __attribute__((ext_vector_type(4)));
typedef float f32x2 __attribute__((ext_vector_type(2)));
typedef float f32x16 __attribute__((ext_vector_type(16)));
typedef short bf16x8 __attribute__((ext_vector_type(8)));
typedef short bf16x4 __attribute__((ext_vector_type(4)));

#ifndef BAR_SCOPE
#define BAR_SCOPE "agent"
#endif
#ifndef DBG_WHICH
#define DBG_WHICH 0
#endif
#ifndef STOP_AFTER
#define STOP_AFTER 999
#endif

constexpr int NWAVES = 8, NTHREADS = NWAVES * 64;
constexpr int BATCH = 8, SEQ = 4096, DM = 1024, T = BATCH * SEQ, NL = 2;
constexpr int MEMLEN = 256, TM = BATCH * MEMLEN;
constexpr int NCHUNK = SEQ / 128, NUNIT = BATCH * NCHUNK;
constexpr float EPS = 1e-6f;
constexpr int IN_COLS = 2824;
constexpr int PROJ_LD = 2816;
constexpr int COL_Q = 0, COL_K = 256, COL_V = 512, COL_G = 768, COL_Z = 1024, COL_X = 1536, COL_B = 2048, COL_C = 2304, COL_U = 2560;
constexpr int NEXP = 32, DEXP = 512;
constexpr int NSLOT = 2 * T + NEXP * 256;

constexpr size_t MiB = 1u << 20;
constexpr size_t WS_CTL = 0, CTL_ZERO_BYTES = 256 * 1024;
constexpr int CW_DIAG = 64;
constexpr int CW_CNT = 1024;
constexpr int CW_BAR = 4096;
constexpr size_t WS_SSQ0 = 2 * MiB;
constexpr size_t WS_ROPE = 3 * MiB;
constexpr size_t WS_S5TAB = 4 * MiB;
constexpr size_t S5TAB_LAYER = 256 * 1024, S5TAB_BBAR = 16 * 1024, S5TAB_CT = 80 * 1024;
constexpr size_t WS_DT = 5 * MiB;
constexpr size_t WS_WR = 6 * MiB;
constexpr size_t WS_WGLU = 7 * MiB;
constexpr size_t WS_WIN = 8 * MiB;
constexpr size_t WS_WOUT = 20 * MiB, WS_WQ = 24 * MiB, WS_WK = 28 * MiB, WS_WV = 32 * MiB, WS_WO = 36 * MiB;
constexpr size_t WS_MN = 40 * MiB;
constexpr size_t WS_KB = 44 * MiB;
constexpr size_t WS_VT = 52 * MiB;
constexpr size_t WS_TOKLIST = 60 * MiB;
constexpr size_t WS_SLOTW = 64 * MiB;
constexpr size_t WS_SLOTR = 68 * MiB;
constexpr size_t WS_TOKSLOT = 72 * MiB;
constexpr size_t WS_SSDDEC = 73 * MiB;
constexpr size_t WS_WGU = 76 * MiB;
constexpr size_t WS_WD = 140 * MiB;
constexpr size_t WS_HB = 172 * MiB;
constexpr size_t WS_SCR = 236 * MiB;
constexpr size_t WS_PROJ = WS_SCR;
constexpr size_t WS_RETST = WS_SCR + 192 * MiB;
constexpr size_t WS_SSDST = WS_SCR + 208 * MiB;
constexpr size_t WS_S5ST = WS_SCR + 240 * MiB;
constexpr size_t WS_CAT = WS_SCR + 242 * MiB;
constexpr size_t WS_Q = WS_SCR;
constexpr size_t WS_HMID = WS_SCR;
constexpr size_t WS_YBUF = WS_SCR + 72 * MiB;
constexpr size_t WS_SSQ1 = WS_SCR + 308 * MiB;
constexpr size_t WS_SSQ2 = WS_SCR + 312 * MiB;
constexpr size_t WS_END = WS_SCR + 321 * MiB;
static_assert(WS_END <= 576 * MiB, "workspace");
static_assert((size_t)NSLOT * 512 * 2 <= 72 * MiB && (size_t)NSLOT * 1024 * 2 <= 144 * MiB, "moe buffers");

constexpr int RING_BYTES = 131072;
constexpr int MOE_LDS = 131072;
constexpr int SCRATCH_BYTES = 151552;
constexpr int LDSCTL_OFF = SCRATCH_BYTES, MISC_OFF = LDSCTL_OFF + 320;
constexpr int LDS_BYTES = 155648;

#define FULL_SYNC() do { asm volatile("s_waitcnt vmcnt(0) lgkmcnt(0)" ::: "memory"); __syncthreads(); } while (0)
#define LDS_WAIT() asm volatile("s_waitcnt lgkmcnt(0)" ::: "memory")
#define VM_WAIT() asm volatile("s_waitcnt vmcnt(0)" ::: "memory")
__device__ __forceinline__ unsigned f2bf(float f) { unsigned u = __builtin_bit_cast(unsigned, f); return (u + 0x7fffu + ((u >> 16) & 1u)) >> 16; }
__device__ __forceinline__ unsigned pk2(float lo, float hi) { return f2bf(lo) | (f2bf(hi) << 16); }
__device__ __forceinline__ float bf2f(unsigned b) { return __builtin_bit_cast(float, b << 16); }
__device__ __forceinline__ float bflo(unsigned w) { return __builtin_bit_cast(float, w << 16); }
__device__ __forceinline__ float bfhi(unsigned w) { return __builtin_bit_cast(float, w & 0xffff0000u); }
__device__ __forceinline__ float wave_sum(float v) {
#pragma unroll
    for (int o = 1; o < 64; o <<= 1) v += __shfl_xor(v, o);
    return v;
}
__device__ __forceinline__ float sigmoidf_(float x) { return 1.f / (1.f + __expf(-x)); }
__device__ __forceinline__ float siluf_(float x) { return x / (1.f + __expf(-x)); }
__device__ __forceinline__ float softplusf_(float x) { return x > 20.f ? x : log1pf(__expf(x)); }
__device__ __forceinline__ float gelu_tanh(float x) { const float u = 0.7978845608f * (x + 0.044715f * x * x * x); const float t = 1.f - 2.f / (__expf(2.f * u) + 1.f); return 0.5f * x * (1.f + t); }
__device__ __forceinline__ f32x16 zero16() { f32x16 z;
#pragma unroll
    for (int i = 0; i < 16; ++i) z[i] = 0.f; return z; }
#define MFMA32(a, b, c) __builtin_amdgcn_mfma_f32_32x32x16_bf16((a), (b), (c), 0, 0, 0)

__device__ __forceinline__ int fresh_tid() { int t = threadIdx.x; asm volatile("" : "+v"(t)); return t; }

#define XB_TMO      128
#define XB_XCNT(j)  (256  + 64 * (j))
#define XB_XSUB(j)  (1280 + 64 * (j))
#define XB_XGEN(j)  (2304 + 64 * (j))
#define XB_TOP      3328
#define XB_TOPGEN   3392
#define XCD_BAR_WORDS 3456
#define XB_SPIN_CAP (1u << 18)
__device__ __forceinline__ unsigned xb_ld(unsigned* p)              { return __hip_atomic_load(p, __ATOMIC_RELAXED, __HIP_MEMORY_SCOPE_AGENT); }
__device__ __forceinline__ unsigned xb_add(unsigned* p, unsigned v) { return __hip_atomic_fetch_add(p, v, __ATOMIC_RELAXED, __HIP_MEMORY_SCOPE_AGENT); }
__device__ __forceinline__ unsigned xb_xcc_id() { return (unsigned)__builtin_amdgcn_s_getreg((3 << 11) | 20) & 0xFu; }
#define XB_SPIN(cond, bar) do { unsigned _sp = 0; while (cond) { __builtin_amdgcn_s_sleep(1); \
    if ((++_sp & 255u) == 0u) { if (xb_ld(&(bar)[XB_TMO])) break; if (_sp > XB_SPIN_CAP) { atomicAdd(&(bar)[XB_TMO], 1u); break; } } } } while (0)
struct XcdBarrier { unsigned* bar; unsigned x; volatile LAS unsigned* st; };
__device__ __forceinline__ XcdBarrier xcd_barrier_post(unsigned* bar, volatile LAS unsigned* st) {
    XcdBarrier b; b.bar = bar; b.x = xb_xcc_id(); b.st = st;
    if (threadIdx.x == 0) (void)xb_add(&bar[XB_XCNT(b.x)], 1u);
    return b;
}
__device__ __forceinline__ void xcd_barrier_complete(unsigned* bar, unsigned x, unsigned& nloc, unsigned& nx) {
    const unsigned G = gridDim.x * gridDim.y * gridDim.z;
    unsigned sum, cnt, mine, sp = 0u;
    for (;;) {
        sum = 0u; cnt = 0u; mine = 0u;
#pragma unroll
        for (unsigned j = 0; j < 16; ++j) { const unsigned c = xb_ld(&bar[XB_XCNT(j)]); sum += c; cnt += (c > 0u) ? 1u : 0u; mine = (j == x) ? c : mine; }
        if (sum == G) break;
        __builtin_amdgcn_s_sleep(1);
        if ((++sp & 255u) == 0u) { if (xb_ld(&bar[XB_TMO])) break; if (sp > XB_SPIN_CAP) { atomicAdd(&bar[XB_TMO], 1u); break; } }
    }
    nloc = mine > 0u ? mine : 1u; nx = cnt > 0u ? cnt : 1u;
}
__device__ __forceinline__ void xcd_barrier(const XcdBarrier& b) {
    asm volatile("s_waitcnt vmcnt(0)" ::: "memory");
    __syncthreads();
    if (threadIdx.x == 0) {
        unsigned* bar = b.bar;
        __builtin_amdgcn_s_waitcnt(0);
        unsigned nloc = b.st[0], nx = b.st[1];
        if (nloc == 0u) { xcd_barrier_complete(bar, b.x, nloc, nx); b.st[0] = nloc; b.st[1] = nx; }
        const unsigned old = xb_add(&bar[XB_XSUB(b.x)], 1u);
        const unsigned gen = old / nloc;
        if (old + 1u == (gen + 1u) * nloc) {
            __builtin_amdgcn_fence(__ATOMIC_RELEASE, BAR_SCOPE);
            asm volatile("s_waitcnt vmcnt(0)" ::: "memory");
            const unsigned og = xb_add(&bar[XB_TOP], 1u);
            const unsigned tg = og / nx;
            if (og + 1u == (tg + 1u) * nx) xb_add(&bar[XB_TOPGEN], 1u);
            else XB_SPIN(xb_ld(&bar[XB_TOPGEN]) == tg, bar);
            __builtin_amdgcn_fence(__ATOMIC_ACQUIRE, BAR_SCOPE);
            xb_add(&bar[XB_XGEN(b.x)], 1u);
            asm volatile("s_waitcnt vmcnt(0)" ::: "memory");
        } else {
            XB_SPIN(xb_ld(&bar[XB_XGEN(b.x)]) == gen, bar);
            __builtin_amdgcn_fence(__ATOMIC_ACQUIRE, BAR_SCOPE);
            asm volatile("s_waitcnt vmcnt(0)" ::: "memory");
        }
    }
    __syncthreads();
}

namespace pg8 {
constexpr int BM = 256, BK = 64, HALF = 128, HTB = HALF * BK * 2, STAGE_BYTES = 8 * HTB, NXCD = 8, WGM = 8;
__host__ __device__ __forceinline__ int lds_byte(int r, int c) { const int st = (r >> 4) * 2 + (c >> 5), rr = r & 15, cc = c & 31, ob = rr * 64 + cc * 2; return st * 1024 + (ob ^ (((ob >> 9) & 1) << 5)); }
__host__ __device__ __forceinline__ void stage_rc(int b, int& R, int& C) { const int st = b / 1024, sb = b % 1024, swz = sb ^ (((sb >> 9) & 1) << 5); R = (st >> 1) * 16 + swz / 64; C = (st & 1) * 32 + (swz % 64) / 2; }
__host__ __device__ __forceinline__ int perm32(int rho) { const int n = rho >> 4, i = rho & 15; return 8 * (i >> 2) + 4 * n + (i & 3); }
struct Unit { int pm, pn, z; };
__device__ __forceinline__ unsigned cvt_pk_bf16(float lo, float hi) { unsigned r; asm volatile("v_cvt_pk_bf16_f32 %0, %1, %2" : "=v"(r) : "v"(lo), "v"(hi)); return r; }

template <class Epi, class Sched, bool GATHER>
__device__ __forceinline__ void gemm_phase(LAS unsigned char* lds, const int K, const Sched& S, const Epi& E) {
    const int tid = fresh_tid(), wid = __builtin_amdgcn_readfirstlane(tid >> 6), lane = tid & 63, wr = wid >> 2, wc = wid & 3, fr = lane & 15, fq = lane >> 4;
    const int nt = K / BK;
    unsigned voffA[2][2], voffB[2];
#pragma unroll
    for (int i = 0; i < 2; ++i) { int R, C; stage_rc(tid * 16 + i * 8192, R, C); const int Rb = (R & ~31) + perm32(R & 31); voffB[i] = (unsigned)(Rb * K + C) * 2u; }
    const size_t kstep = (size_t)(BK * 2);
    const size_t hstep = (size_t)HALF * K * 2;
    const unsigned ldsw = (unsigned)wid * 1024u;
    const int aoff = lds_byte(wr * 64 + fr, fq * 8), boff = lds_byte(wc * 32 + fr, fq * 8);
#define PG8_SA(b, h) (((b) * 2 + (h)) * HTB)
#define PG8_SB(b, h) ((4 + (b) * 2 + (h)) * HTB)
#define PG8_STAGE(bufoff, gbase, voff) do { _Pragma("unroll") for (int _i = 0; _i < 2; ++_i) \
        __builtin_amdgcn_global_load_lds((const unsigned*)((const char*)(gbase) + (voff)[_i]), (LAS unsigned*)(lds + (bufoff) + ldsw + _i * 8192), 16, 0, 0); } while (0)
#define PG8_LDA(dst, b, h) do { _Pragma("unroll") for (int m = 0; m < 4; ++m) _Pragma("unroll") for (int k = 0; k < 2; ++k) dst[m][k] = *(const LAS bf16x8*)(lds + PG8_SA(b, h) + aoff + m * 2048 + k * 1024); } while (0)
#define PG8_LDB(dst, b, h) do { _Pragma("unroll") for (int n = 0; n < 2; ++n) _Pragma("unroll") for (int k = 0; k < 2; ++k) dst[n][k] = *(const LAS bf16x8*)(lds + PG8_SB(b, h) + boff + n * 2048 + k * 1024); } while (0)
#define PG8_MMA(ai, bj, At, Bt) do { __builtin_amdgcn_s_setprio(1); _Pragma("unroll") for (int m = 0; m < 4; ++m) _Pragma("unroll") for (int n = 0; n < 2; ++n) _Pragma("unroll") for (int k = 0; k < 2; ++k) \
        acc[ai][bj][m][n] = __builtin_amdgcn_mfma_f32_16x16x32_bf16(Bt[n][k], At[m][k], acc[ai][bj][m][n], 0, 0, 0); __builtin_amdgcn_s_setprio(0); } while (0)
#define PG8_WAIT_V(n) asm volatile("s_waitcnt vmcnt(" #n ")" ::: "memory")
#define PG8_WAIT_L(n) asm volatile("s_waitcnt lgkmcnt(" #n ")" ::: "memory")
#define PG8_BAR __builtin_amdgcn_s_barrier()
#define PG8_SCHED __builtin_amdgcn_sched_barrier(0)
    Unit cur, nxt; int ui = 0;
    if (!S.next(0, cur)) return;
    f32x4 acc[2][2][4][2];
#pragma unroll
    for (int a = 0; a < 2; ++a)
#pragma unroll
        for (int b = 0; b < 2; ++b)
#pragma unroll
            for (int m = 0; m < 4; ++m)
#pragma unroll
                for (int n = 0; n < 2; ++n) acc[a][b][m][n] = (f32x4){0.f, 0.f, 0.f, 0.f};
    bf16x8 At[4][2], B0[2][2], B1[2][2];
    const char* cA = S.a_base(cur); const char* cB = S.b_base(cur);
    S.a_voff(0, cur, K, voffA, tid);
    PG8_STAGE(PG8_SB(0, 0), cB, voffB); PG8_STAGE(PG8_SB(0, 1), cB + hstep, voffB); PG8_STAGE(PG8_SA(0, 0), cA, voffA[0]); PG8_STAGE(PG8_SA(0, 1), cA, voffA[1]);
    if (wr == 1) PG8_BAR;
    PG8_WAIT_V(2); PG8_BAR;
    PG8_STAGE(PG8_SB(1, 0), cB + kstep, voffB); PG8_STAGE(PG8_SA(1, 0), cA + kstep, voffA[0]); PG8_STAGE(PG8_SB(1, 1), cB + hstep + kstep, voffB);
    PG8_WAIT_V(6); PG8_BAR;
    for (;;) {
        const bool has_next = S.next(ui + 1, nxt);
        const char* nA = has_next ? S.a_base(nxt) : cA; const char* nB = has_next ? S.b_base(nxt) : cB;
        for (int t = 0; t < nt; t += 2) {
            const bool last = (t == nt - 2);
            const char* a1 = cA + (size_t)(t + 1) * kstep;
            const char* a2 = last ? nA : cA + (size_t)(t + 2) * kstep; const char* b2 = last ? nB : cB + (size_t)(t + 2) * kstep;
            const char* a3 = a2 + kstep; const char* b3 = b2 + kstep;
            PG8_LDB(B0, 0, 0); PG8_LDB(B1, 0, 1); PG8_SCHED; PG8_LDA(At, 0, 0); PG8_STAGE(PG8_SA(1, 1), a1, voffA[1]);
            if (GATHER) { if (last && has_next) S.a_voff(ui + 1, nxt, K, voffA, tid); }
            PG8_WAIT_V(8); PG8_WAIT_L(0); PG8_BAR; PG8_MMA(0, 0, At, B0); PG8_MMA(0, 1, At, B1); PG8_BAR; PG8_SCHED;
            PG8_LDA(At, 0, 1); PG8_STAGE(PG8_SB(0, 0), b2, voffB); PG8_STAGE(PG8_SB(0, 1), b2 + hstep, voffB); PG8_STAGE(PG8_SA(0, 0), a2, voffA[0]);
            PG8_WAIT_V(8); PG8_WAIT_L(0); PG8_BAR; PG8_MMA(1, 0, At, B0); PG8_MMA(1, 1, At, B1); PG8_BAR; PG8_SCHED;
            PG8_LDB(B0, 1, 0); PG8_LDB(B1, 1, 1); PG8_SCHED; PG8_LDA(At, 1, 0); PG8_STAGE(PG8_SA(0, 1), a2, voffA[1]);
            PG8_WAIT_V(8); PG8_WAIT_L(0); PG8_BAR; PG8_MMA(0, 0, At, B0); PG8_MMA(0, 1, At, B1); PG8_BAR; PG8_SCHED;
            PG8_LDA(At, 1, 1); PG8_STAGE(PG8_SB(1, 0), b3, voffB); PG8_STAGE(PG8_SB(1, 1), b3 + hstep, voffB); PG8_STAGE(PG8_SA(1, 0), a3, voffA[0]);
            PG8_WAIT_V(8); PG8_WAIT_L(0); PG8_BAR; PG8_MMA(1, 0, At, B0); PG8_MMA(1, 1, At, B1); PG8_BAR; PG8_SCHED;
        }
        if (wr == 0) PG8_BAR;
        E(acc, cur, wr, wc, fr, fq);
        if (!has_next) break;
#pragma unroll
        for (int a = 0; a < 2; ++a)
#pragma unroll
            for (int b = 0; b < 2; ++b)
#pragma unroll
                for (int m = 0; m < 4; ++m)
#pragma unroll
                    for (int n = 0; n < 2; ++n) acc[a][b][m][n] = (f32x4){0.f, 0.f, 0.f, 0.f};
        cur = nxt; cA = nA; cB = nB; ++ui;
        if (wr == 1) PG8_BAR;
    }
    PG8_WAIT_V(0);
    PG8_BAR;
#undef PG8_SA
#undef PG8_SB
#undef PG8_STAGE
#undef PG8_LDA
#undef PG8_LDB
#undef PG8_MMA
#undef PG8_WAIT_V
#undef PG8_WAIT_L
#undef PG8_BAR
#undef PG8_SCHED
}

__device__ __forceinline__ void dense_voff(int K, unsigned (&voffA)[2][2], int tid) {
#pragma unroll
    for (int i = 0; i < 2; ++i) { int R, C; stage_rc(tid * 16 + i * 8192, R, C);
        voffA[0][i] = (unsigned)(R * K + C) * 2u; voffA[1][i] = (unsigned)((R + HALF) * K + C) * 2u; }
}
struct DenseOrder {
    const char* A; const char* Bt; int K, nM, nN, nwg, G, c;
    __device__ __forceinline__ void init(const void* A_, const void* Bt_, int M, int N, int K_, int G_, int c_) { A = (const char*)A_; Bt = (const char*)Bt_; K = K_; nM = M / BM; nN = N / BM; nwg = nM * nN; G = G_; c = c_; }
    __device__ __forceinline__ bool next(int i, Unit& u) const {
        const long L = (long)i * G + c; if (L >= nwg) return false;
        int wgid = (int)L; { const int q = nwg / NXCD, r = nwg % NXCD, xcd = wgid % NXCD, off = wgid / NXCD; wgid = (xcd < r ? xcd * (q + 1) : r * (q + 1) + (xcd - r) * q) + off; }
        const int nig = WGM * nN, gid = wgid / nig, fm = gid * WGM, gsz = (nM - fm) < WGM ? (nM - fm) : WGM;
        u.pm = fm + ((wgid % nig) % gsz); u.pn = (wgid % nig) / gsz; u.z = 0; return true;
    }
    __device__ __forceinline__ const char* a_base(const Unit& u) const { return A + (size_t)u.pm * BM * K * 2; }
    __device__ __forceinline__ const char* b_base(const Unit& u) const { return Bt + (size_t)u.pn * BM * K * 2; }
    __device__ __forceinline__ void a_voff(int, const Unit&, int K_, unsigned (&voffA)[2][2], int tid) const { dense_voff(K_, voffA, tid); }
};
}
using pg8::Unit; using pg8::cvt_pk_bf16;

__device__ __forceinline__ float ssq16(const float* p) { const f32x4 a = *(const f32x4*)p, b = *(const f32x4*)(p + 4), c = *(const f32x4*)(p + 8), d = *(const f32x4*)(p + 12);
    return (((a.x + a.y) + (a.z + a.w)) + ((b.x + b.y) + (b.z + b.w))) + (((c.x + c.y) + (c.z + c.w)) + ((d.x + d.y) + (d.z + d.w))); }
struct EpiBf16Scaled {
    bf16* O; int ldc; const float* ssq; float scale;
    __device__ __forceinline__ void operator()(const f32x4 (&acc)[2][2][4][2], const Unit& u, int wr, int wc, int fr, int fq) const {
        const int row0 = u.pm * 256 + wr * 64 + fr, col0 = u.pn * 256 + wc * 32 + 8 * fq;
#pragma unroll
        for (int ai = 0; ai < 2; ++ai)
#pragma unroll
            for (int m = 0; m < 4; ++m) { const int row = row0 + ai * 128 + m * 16;
                float s = scale; if (ssq) s *= rsqrtf(ssq16(ssq + (size_t)row * 16) * (1.f / DM) + EPS);
                bf16* rowp = O + (size_t)row * ldc + col0;
#pragma unroll
                for (int bj = 0; bj < 2; ++bj) { const f32x4 v0 = acc[ai][bj][m][0] * s, v1 = acc[ai][bj][m][1] * s;
                    v4u w; w.x = cvt_pk_bf16(v0[0], v0[1]); w.y = cvt_pk_bf16(v0[2], v0[3]); w.z = cvt_pk_bf16(v1[0], v1[1]); w.w = cvt_pk_bf16(v1[2], v1[3]);
                    *(v4u*)(rowp + bj * 128) = w; } }
    }
};
struct EpiProj {
    bf16* P; float* dt; const float* ssq;
    __device__ __forceinline__ void operator()(const f32x4 (&acc)[2][2][4][2], const Unit& u, int wr, int wc, int fr, int fq) const {
        const int row0 = u.pm * 256 + wr * 64 + fr;
        if (u.pn == 11) {
            if (wc == 0 && fq == 0) {
#pragma unroll
                for (int ai = 0; ai < 2; ++ai)
#pragma unroll
                    for (int m = 0; m < 4; ++m) { const int row = row0 + ai * 128 + m * 16; const float s = rsqrtf(ssq[row] * (1.f / DM) + EPS);
                        *(f32x4*)(dt + (size_t)row * 8) = acc[ai][0][m][0] * s; *(f32x4*)(dt + (size_t)row * 8 + 4) = acc[ai][0][m][1] * s; }
            }
            return;
        }
        const int col0 = u.pn * 256 + wc * 32 + 8 * fq;
#pragma unroll
        for (int ai = 0; ai < 2; ++ai)
#pragma unroll
            for (int m = 0; m < 4; ++m) { const int row = row0 + ai * 128 + m * 16; const float s = rsqrtf(ssq[row] * (1.f / DM) + EPS);
                bf16* rowp = P + (size_t)row * PROJ_LD + col0;
#pragma unroll
                for (int bj = 0; bj < 2; ++bj) { const f32x4 v0 = acc[ai][bj][m][0] * s, v1 = acc[ai][bj][m][1] * s;
                    v4u w; w.x = cvt_pk_bf16(v0[0], v0[1]); w.y = cvt_pk_bf16(v0[2], v0[3]); w.z = cvt_pk_bf16(v1[0], v1[1]); w.w = cvt_pk_bf16(v1[2], v1[3]);
                    *(v4u*)(rowp + bj * 128) = w; } }
    }
};
struct EpiResid {
    const float* hin; float* hout; bf16* hb; float* ssq;
    __device__ __forceinline__ void operator()(const f32x4 (&acc)[2][2][4][2], const Unit& u, int wr, int wc, int fr, int fq) const {
        const int row0 = u.pm * 256 + wr * 64 + fr, col0 = u.pn * 256 + wc * 32 + 8 * fq;
#pragma unroll
        for (int ai = 0; ai < 2; ++ai)
#pragma unroll
            for (int m = 0; m < 4; ++m) { const int row = row0 + ai * 128 + m * 16; const size_t off = (size_t)row * DM + col0;
                float sq = 0.f;
#pragma unroll
                for (int bj = 0; bj < 2; ++bj) {
                    const f32x4 v0 = *(const f32x4*)(hin + off + bj * 128) + acc[ai][bj][m][0], v1 = *(const f32x4*)(hin + off + bj * 128 + 4) + acc[ai][bj][m][1];
                    *(f32x4*)(hout + off + bj * 128) = v0; *(f32x4*)(hout + off + bj * 128 + 4) = v1;
                    v4u w; w.x = cvt_pk_bf16(v0[0], v0[1]); w.y = cvt_pk_bf16(v0[2], v0[3]); w.z = cvt_pk_bf16(v1[0], v1[1]); w.w = cvt_pk_bf16(v1[2], v1[3]);
                    *(v4u*)(hb + off + bj * 128) = w;
                    sq += v0[0] * v0[0] + v0[1] * v0[1] + v0[2] * v0[2] + v0[3] * v0[3] + v1[0] * v1[0] + v1[1] * v1[1] + v1[2] * v1[2] + v1[3] * v1[3]; }
                sq += __shfl_xor(sq, 16); sq += __shfl_xor(sq, 32);
                if (fq == 0) ssq[(size_t)row * 16 + u.pn * 4 + wc] = sq;
                asm volatile("" ::: "memory"); }
    }
};

struct Args { const float* in[37]; float* out; unsigned char* ws; unsigned long long ws_size; };
enum { I_X = 0, I_MEM, I_NORM_MIX_G, I_W_IN, I_RET_GN_G, I_CONV_W, I_CONV_B, I_DT_BIAS, I_A_LOG, I_SSD_D, I_SSD_NORM_G, I_S5_ARE, I_S5_AIM, I_S5_BRE, I_S5_BIM, I_S5_CRE, I_S5_CIM,
       I_S5_LOGSTEP, I_S5_D, I_S5_WGLU, I_S5_BGLU, I_W_OUT, I_NORM_CROSS_G, I_MEM_NORM_G, I_W_CQ, I_W_CK, I_W_CV, I_W_CO, I_NORM_FFN_G, I_W_RG, I_B_RG, I_W_RE, I_B_RE, I_W_GATE, I_W_UP, I_W_DOWN, I_NORM_FINAL_G };

struct Ctx {
    LAS unsigned char* lds; unsigned char* ws; int tid, lane, wave, G, vcu, bid;
};


#ifndef DEBUG_STAGE
#define DEBUG_STAGE 0
#endif
constexpr int CW_DBGA = 80, CW_DBGB = 81;
__device__ __forceinline__ void dbg_max(unsigned* ctl, int word, float v) { if (!(v >= 0.f)) v = 1e30f; atomicMax(ctl + word, __builtin_bit_cast(unsigned, v)); }
__device__ __forceinline__ void dbg_emit(const Ctx& F, unsigned* ctl, float* out) {
    if (F.bid != 0) return;
    const float ea = __builtin_bit_cast(float, xb_ld(ctl + CW_DBGA)), eb = __builtin_bit_cast(float, xb_ld(ctl + CW_DBGB));
    const float la = fminf(fmaxf(log10f(fmaxf(ea, 1e-30f)), -6.f), 2.9f), lb = fminf(fmaxf(log10f(fmaxf(eb, 1e-30f)), -6.f), 3.f);
    const float V = 1000.f + 1000.f * (la + 6.f), W = exp10f(2.f + 0.954f * (lb + 6.f) / 9.f);
    for (int i = (1 << 20) + F.tid; i < (2 << 20); i += NTHREADS) out[i] = W;
    if (F.tid == 0) out[0] = V;
}


constexpr int CW_CK = 2048;
constexpr size_t WS_HIST = WS_SCR + 317 * MiB;
__device__ __forceinline__ void dbg_checksum(const Ctx& F, unsigned* ctl, int stage, const void* p, size_t nbytes) {
    const unsigned* w = (const unsigned*)p; const size_t n = nbytes / 4; unsigned s = 0;
    for (size_t i = (size_t)F.bid * NTHREADS + threadIdx.x; i < n; i += (size_t)F.G * NTHREADS) { const unsigned v = w[i]; s += v * 2654435761u + (v >> 7) * (unsigned)(i * 40503u + 1u); }
#pragma unroll
    for (int o = 1; o < 64; o <<= 1) s += __shfl_xor(s, o);
    if ((threadIdx.x & 63) == 0) atomicAdd(ctl + CW_CK + stage, s);
}

__device__ __forceinline__ void dbg_checksum_cols(const Ctx& F, unsigned* ctl, int stage, const void* p, int col_lo, int col_hi) {
    const unsigned* w = (const unsigned*)p; const size_t n = (size_t)T * DM / 2; unsigned s = 0;
    for (size_t i = (size_t)F.bid * NTHREADS + threadIdx.x; i < n; i += (size_t)F.G * NTHREADS) { const int col = (int)((i * 2) & 1023); if (col >= col_lo && col < col_hi) { const unsigned v = w[i]; s += v * 2654435761u + (v >> 7) * (unsigned)(i * 40503u + 1u); } }
#pragma unroll
    for (int o = 1; o < 64; o <<= 1) s += __shfl_xor(s, o);
    if ((threadIdx.x & 63) == 0) atomicAdd(ctl + CW_CK + stage, s);
}
__device__ __forceinline__ void dbg_checksum_route(const Ctx& F, unsigned* ctl, int stage) {
    const unsigned* ts = (const unsigned*)(F.ws + WS_TOKSLOT); const float* sw = (const float*)(F.ws + WS_SLOTW); unsigned s = 0;
    for (int t = F.bid * NTHREADS + threadIdx.x; t < T; t += F.G * NTHREADS) {
        const unsigned a = ts[2 * t], b = ts[2 * t + 1]; const unsigned e1 = a >> 20, e2 = b >> 20;
        const unsigned g1 = __builtin_bit_cast(unsigned, sw[(size_t)e1 * T + (a & 0xFFFFFu)]), g2 = __builtin_bit_cast(unsigned, sw[(size_t)e2 * T + (b & 0xFFFFFu)]);
        s += ((unsigned)t * 2654435761u) ^ (e1 * 97u + e2 * 7919u + 13u) ^ (g1 * 31u) ^ (g2 * 131u); }
#pragma unroll
    for (int o = 1; o < 64; o <<= 1) s += __shfl_xor(s, o);
    if ((threadIdx.x & 63) == 0) atomicAdd(ctl + CW_CK + stage, s);
}

__device__ __forceinline__ void tr_item(const float* __restrict__ W, int ldw, int k0, int col0, int ncols_valid, const float* __restrict__ gk, bf16* __restrict__ dst, int K, LAS float* scr, int lane) {
    const int c = lane & 31, kh = lane >> 5;
#pragma unroll 8
    for (int i = 0; i < 32; ++i) { const int kk = 2 * i + kh; float v = 0.f; if (c < ncols_valid) v = W[(size_t)(k0 + kk) * ldw + col0 + c]; if (gk) v *= gk[k0 + kk]; scr[kk * 33 + c] = v; }
    LDS_WAIT();
    const int ch = lane & 7;
#pragma unroll
    for (int j = 0; j < 4; ++j) { const int n = (lane >> 3) + 8 * j; const LAS float* s = scr + (8 * ch) * 33 + n;
        v4u o; o.x = pk2(s[0 * 33], s[1 * 33]); o.y = pk2(s[2 * 33], s[3 * 33]); o.z = pk2(s[4 * 33], s[5 * 33]); o.w = pk2(s[6 * 33], s[7 * 33]);
        *(v4u*)(dst + (size_t)n * K + 8 * ch) = o; }
    LDS_WAIT();
}
__device__ __forceinline__ void tr_plain(const float* W, int K, int N, const float* gk, bf16* WT, LAS float* scr, int item, int lane) {
    const int nblk = N / 32, kb = item / nblk, nb = item % nblk;
    tr_item(W, N, 64 * kb, 32 * nb, 32, gk, WT + (size_t)(32 * nb) * K + 64 * kb, K, scr, lane);
}

__device__ __forceinline__ void p0_small_weights(const Ctx& F, const Args& args) {
    LAS float* scr = (LAS float*)(F.lds + F.wave * 16384);
    const int gw = F.vcu * NWAVES + F.wave, NGW = F.G * NWAVES;
    constexpr int I_IN = 16 * 96, I_SQ = 16 * 32, I_GLU = 4 * 8;
    constexpr int PER_LAYER = I_IN + 5 * I_SQ + I_GLU;
    for (int it = gw; it < NL * PER_LAYER; it += NGW) {
        const int l = it / PER_LAYER; int r = it % PER_LAYER;
        if (r < I_IN) {
            const int kb = r / 96, nb = r % 96; int col0, nv;
            if (nb < 80) { col0 = 32 * nb; nv = 32; } else if (nb < 88) { col0 = 2568 + 32 * (nb - 80); nv = 32; } else if (nb == 88) { col0 = 2560; nv = 8; } else { col0 = 0; nv = 0; }
            tr_item(args.in[I_W_IN] + (size_t)l * DM * IN_COLS, IN_COLS, 64 * kb, col0, nv, args.in[I_NORM_MIX_G] + l * DM, (bf16*)(F.ws + WS_WIN) + ((size_t)l * 3072 + 32 * nb) * DM + 64 * kb, DM, scr, F.lane);
            continue; }
        r -= I_IN;
        if (r < I_SQ) { tr_plain(args.in[I_W_OUT] + (size_t)l * DM * DM, DM, DM, nullptr, (bf16*)(F.ws + WS_WOUT) + (size_t)l * DM * DM, scr, r, F.lane); continue; } r -= I_SQ;
        if (r < I_SQ) { tr_plain(args.in[I_W_CQ] + (size_t)l * DM * DM, DM, DM, args.in[I_NORM_CROSS_G] + l * DM, (bf16*)(F.ws + WS_WQ) + (size_t)l * DM * DM, scr, r, F.lane); continue; } r -= I_SQ;
        if (r < I_SQ) { tr_plain(args.in[I_W_CK] + (size_t)l * DM * DM, DM, DM, nullptr, (bf16*)(F.ws + WS_WK) + (size_t)l * DM * DM, scr, r, F.lane); continue; } r -= I_SQ;
        if (r < I_SQ) { tr_plain(args.in[I_W_CV] + (size_t)l * DM * DM, DM, DM, nullptr, (bf16*)(F.ws + WS_WV) + (size_t)l * DM * DM, scr, r, F.lane); continue; } r -= I_SQ;
        if (r < I_SQ) { tr_plain(args.in[I_W_CO] + (size_t)l * DM * DM, DM, DM, nullptr, (bf16*)(F.ws + WS_WO) + (size_t)l * DM * DM, scr, r, F.lane); continue; } r -= I_SQ;
        tr_plain(args.in[I_S5_WGLU] + (size_t)l * 256 * 256, 256, 256, nullptr, (bf16*)(F.ws + WS_WGLU) + (size_t)l * 256 * 256, scr, r, F.lane);
    }
}
__device__ __forceinline__ void convert_moe_weights(const Ctx& F0, const Args& args, int l) {
    Ctx F = F0; { const int t = fresh_tid(); F.tid = t; F.lane = t & 63; F.wave = __builtin_amdgcn_readfirstlane(t >> 6); }
    LAS float* scr = (LAS float*)(F.lds + F.wave * 16384);
    const int gw = F.vcu * NWAVES + F.wave, NGW = F.G * NWAVES;
    constexpr int I_GU = 16 * 32, I_D = 8 * 32;
    for (int it = gw; it < NEXP * (I_GU + I_D); it += NGW) {
        const int e = it / (I_GU + I_D); int r = it % (I_GU + I_D);
        if (r < I_GU) { const int kb = r / 32, nb = r % 32, pn = nb >> 3, j = nb & 7;
            const float* W = (j < 4 ? args.in[I_W_GATE] : args.in[I_W_UP]) + ((size_t)l * NEXP + e) * DM * DEXP;
            tr_item(W, DEXP, 64 * kb, 128 * pn + 32 * (j & 3), 32, args.in[I_NORM_FFN_G] + l * DM, (bf16*)(F.ws + WS_WGU) + ((size_t)e * 1024 + 32 * nb) * DM + 64 * kb, DM, scr, F.lane);
        } else { r -= I_GU;
            tr_plain(args.in[I_W_DOWN] + ((size_t)l * NEXP + e) * DEXP * DM, DEXP, DM, nullptr, (bf16*)(F.ws + WS_WD) + (size_t)e * DM * DEXP, scr, r, F.lane); }
    }
}
__device__ __forceinline__ void p0_misc(const Ctx& F, const Args& args) {
    const int gw = F.vcu * NWAVES + F.wave, NGW = F.G * NWAVES, lane = F.lane;
    { const float* x = args.in[I_X]; bf16* hb = (bf16*)(F.ws + WS_HB); float* ssq = (float*)(F.ws + WS_SSQ0);
      for (int m = gw; m < T; m += NGW) {
        const f32x4* xr = (const f32x4*)(x + (size_t)m * DM) + lane; float s = 0.f; f32x4 v[4];
#pragma unroll
        for (int j = 0; j < 4; ++j) { v[j] = xr[64 * j]; s += v[j].x * v[j].x + v[j].y * v[j].y + v[j].z * v[j].z + v[j].w * v[j].w; }
        s = wave_sum(s);
        unsigned long long* o8 = (unsigned long long*)(hb + (size_t)m * DM) + lane;
#pragma unroll
        for (int j = 0; j < 4; ++j) o8[64 * j] = (unsigned long long)pk2(v[j].x, v[j].y) | ((unsigned long long)pk2(v[j].z, v[j].w) << 32);
        if (lane == 0) ssq[m] = s;
      } }
    { const float* mem = args.in[I_MEM]; const float* g = args.in[I_MEM_NORM_G]; bf16* mn = (bf16*)(F.ws + WS_MN);
      for (int m = gw; m < TM; m += NGW) {
        const f32x4* xr = (const f32x4*)(mem + (size_t)m * DM) + lane; const f32x4* gr = (const f32x4*)g + lane; float s = 0.f; f32x4 v[4];
#pragma unroll
        for (int j = 0; j < 4; ++j) { v[j] = xr[64 * j]; s += v[j].x * v[j].x + v[j].y * v[j].y + v[j].z * v[j].z + v[j].w * v[j].w; }
        const float rs = rsqrtf(wave_sum(s) * (1.f / DM) + EPS);
        unsigned long long* o8 = (unsigned long long*)(mn + (size_t)m * DM) + lane;
#pragma unroll
        for (int j = 0; j < 4; ++j) { const f32x4 gg = gr[64 * j]; const f32x4 y = v[j] * rs * gg; o8[64 * j] = (unsigned long long)pk2(y.x, y.y) | ((unsigned long long)pk2(y.z, y.w) << 32); }
      } }
    const int gt = F.vcu * NTHREADS + F.tid, NGT = F.G * NTHREADS;
    { float* ct = (float*)(F.ws + WS_ROPE); float* st = ct + SEQ * 32;
      for (int i = gt; i < SEQ * 32; i += NGT) { const int pos = i >> 5, k = i & 31; const float inv = powf(10000.f, -(float)(2 * k) / 64.f); const float ang = (float)pos * inv; ct[i] = cosf(ang); st[i] = sinf(ang); } }
    { for (int i = gt; i < NL * 48 * DM; i += NGT) { const int l = i / (48 * DM), r = (i / DM) % 48, k = i % DM; const int tile = r >> 4, q = (r >> 2) & 3, ii = r & 3;
        float w; if (tile < 2) w = args.in[I_W_RE][((size_t)l * DM + k) * 32 + q * 8 + tile * 4 + ii]; else w = args.in[I_W_RG][((size_t)l * DM + k) * 4 + ii];
        w *= args.in[I_NORM_FFN_G][l * DM + k];
        const unsigned hi = f2bf(w); const float lo = w - bf2f(hi);
        bf16* wr = (bf16*)(F.ws + WS_WR) + (size_t)l * 2 * 48 * DM; wr[r * DM + k] = (bf16)hi; wr[48 * DM + r * DM + k] = (bf16)f2bf(lo); } }
    { for (int i = gt; i < NL * 16 * 64; i += NGT) { const int l = i / 1024, g = (i / 64) & 15, p = i & 63;
        const float delta = expf(args.in[I_S5_LOGSTEP][l * 16 + g]); const float ar = args.in[I_S5_ARE][i], ai = args.in[I_S5_AIM][i];
        const float mag = expf(ar * delta), ang = ai * delta; const float lr = mag * cosf(ang), li = mag * sinf(ang);
        const float mag128 = expf(ar * delta * 128.f), ang128 = ang * 128.f;
        unsigned char* tab = F.ws + WS_S5TAB + (size_t)l * S5TAB_LAYER;
        ((f32x4*)tab)[g * 64 + p] = (f32x4){lr, li, mag128 * cosf(ang128), mag128 * sinf(ang128)};
        const float den = ar * ar + ai * ai, nr = lr - 1.f, ni = li; const float cr = (nr * ar + ni * ai) / den, ci = (ni * ar - nr * ai) / den;
        bf16* bb = (bf16*)(tab + S5TAB_BBAR) + (size_t)g * 128 * 16;
        const float* bre = args.in[I_S5_BRE] + (size_t)i * 16; const float* bim = args.in[I_S5_BIM] + (size_t)i * 16;
#pragma unroll
        for (int c = 0; c < 16; ++c) { bb[p * 16 + c] = (bf16)f2bf(cr * bre[c] - ci * bim[c]); bb[(64 + p) * 16 + c] = (bf16)f2bf(cr * bim[c] + ci * bre[c]); } }
      for (int i = gt; i < NL * 16 * 32 * 128; i += NGT) { const int l = i / (16 * 32 * 128), g = (i / (32 * 128)) & 15, cc = (i / 128) & 31, k = i & 127;
        float v = 0.f; if (cc < 16) { const size_t o = (((size_t)l * 16 + g) * 16 + cc) * 64 + (k & 63); v = (k < 64) ? args.in[I_S5_CRE][o] : -args.in[I_S5_CIM][o]; }
        ((bf16*)(F.ws + WS_S5TAB + (size_t)l * S5TAB_LAYER + S5TAB_CT))[(g * 32 + cc) * 128 + k] = (bf16)f2bf(v); } }
}


__device__ __forceinline__ int s5_slab_off(int w) { return w < 3 ? w * 16896 : 65536 + (w - 3) * 16896; }
static_assert(65536 + 5 * 16896 <= SCRATCH_BYTES, "s5 slabs");

__device__ __forceinline__ bf16x8 ldsv8(LAS const bf16* p) { return *(LAS const bf16x8*)p; }
template <int KS> __device__ __forceinline__ void mma_tile(f32x16& acc, LAS const bf16* a, LAS const bf16* b) {
#pragma unroll
    for (int ks = 0; ks < KS; ++ks) acc = MFMA32(ldsv8(a + 16 * ks), ldsv8(b + 16 * ks), acc);
}
__device__ __forceinline__ void mma_tile_n(f32x16& acc, LAS const bf16* a, LAS const bf16* b, int ksteps) {
    for (int ks = 0; ks < ksteps; ++ks) acc = MFMA32(ldsv8(a + 16 * ks), ldsv8(b + 16 * ks), acc);
}
__device__ __forceinline__ void unpack8(const v4u w, float (&f)[8]) { f[0] = bflo(w.x); f[1] = bfhi(w.x); f[2] = bflo(w.y); f[3] = bfhi(w.y); f[4] = bflo(w.z); f[5] = bfhi(w.z); f[6] = bflo(w.w); f[7] = bfhi(w.w); }
__device__ __forceinline__ v4u pack8(const float (&f)[8]) { v4u w; w.x = pk2(f[0], f[1]); w.y = pk2(f[2], f[3]); w.z = pk2(f[4], f[5]); w.w = pk2(f[6], f[7]); return w; }
__device__ __forceinline__ float ret_lg(int h) { return log1pf(-exp2f((float)(-5 - h))); }
__device__ __forceinline__ int crow(int reg, int hh) { return (reg & 3) + 8 * (reg >> 2) + 4 * hh; }

__device__ __forceinline__ void conv_silu8(const bf16* xrow, int l, bool first_chunk, const float* cw  , const float* cb  , float (&o)[8]) {
    const f32x4 b0 = *(const f32x4*)cb, b1 = *(const f32x4*)(cb + 4);
    o[0] = b0.x; o[1] = b0.y; o[2] = b0.z; o[3] = b0.w; o[4] = b1.x; o[5] = b1.y; o[6] = b1.z; o[7] = b1.w;
#pragma unroll
    for (int jj = 0; jj < 4; ++jj) {
        const int dl = jj - 3;
        if (!first_chunk || l + dl >= 0) {
            const v4u xv = *(const v4u*)(xrow + (long)dl * PROJ_LD); float xf[8]; unpack8(xv, xf);
            const f32x4 w0 = *(const f32x4*)(cw + jj * 1024), w1 = *(const f32x4*)(cw + jj * 1024 + 4);
            o[0] += w0.x * xf[0]; o[1] += w0.y * xf[1]; o[2] += w0.z * xf[2]; o[3] += w0.w * xf[3]; o[4] += w1.x * xf[4]; o[5] += w1.y * xf[5]; o[6] += w1.z * xf[6]; o[7] += w1.w * xf[7];
        }
    }
#pragma unroll
    for (int q = 0; q < 8; ++q) o[q] = siluf_(o[q]);
}
__device__ __forceinline__ void ssd_dt_acum(const Ctx& F, const Args& args, int l, int unit, LAS float* dt_s, LAS float* acum_s, float* dec_out) {
    const int tid_ = fresh_tid(), w = __builtin_amdgcn_readfirstlane(tid_ >> 6), lane = tid_ & 63, tok0 = unit * 128;
    const float* dtb = (const float*)(F.ws + WS_DT);
    const float bias = args.in[I_DT_BIAS][l * 8 + w], A = -__expf(args.in[I_A_LOG][l * 8 + w]);
    const float d0 = softplusf_(dtb[(size_t)(tok0 + lane) * 8 + w] + bias), d1 = softplusf_(dtb[(size_t)(tok0 + 64 + lane) * 8 + w] + bias);
    float s0 = d0 * A, s1 = d1 * A;
#pragma unroll
    for (int o = 1; o < 64; o <<= 1) { const float t0 = __shfl_up(s0, o), t1 = __shfl_up(s1, o); if (lane >= o) { s0 += t0; s1 += t1; } }
    s1 += __shfl(s0, 63);
    dt_s[w * 128 + lane] = d0; dt_s[w * 128 + 64 + lane] = d1; acum_s[w * 128 + lane] = s0; acum_s[w * 128 + 64 + lane] = s1;
    if (dec_out && lane == 63) dec_out[unit * 8 + w] = __expf(s1);
}


__device__ __forceinline__ unsigned s5_chunk_states(const Ctx& F, int l, int unit, const bool CMP, const size_t alt = 0) {
    const int tid = fresh_tid(), lane = tid & 63, w = __builtin_amdgcn_readfirstlane(tid >> 6), tok0 = unit * 128;
    const bf16* proj = (const bf16*)(F.ws + WS_PROJ);
    const unsigned char* tab = F.ws + WS_S5TAB + (size_t)l * S5TAB_LAYER;
    unsigned bad = 0;
    for (int rd = 0; rd < 2; ++rd) { const int g = w + 8 * rd;
        const f32x4 lam = ((const f32x4*)tab)[g * 64 + lane];
        float bre[16], bim[16];
        { const bf16* bb = (const bf16*)(tab + S5TAB_BBAR) + (size_t)(g * 128 + lane) * 16; float t0[8], t1[8]; unpack8(*(const v4u*)bb, t0); unpack8(*(const v4u*)(bb + 8), t1);
#pragma unroll
          for (int c = 0; c < 8; ++c) { bre[c] = t0[c]; bre[8 + c] = t1[c]; }
          const bf16* bi = bb + 64 * 16; unpack8(*(const v4u*)bi, t0); unpack8(*(const v4u*)(bi + 8), t1);
#pragma unroll
          for (int c = 0; c < 8; ++c) { bim[c] = t0[c]; bim[8 + c] = t1[c]; } }
        float xr = 0.f, xi = 0.f;
        for (int t = 0; t < 128; ++t) {
            const bf16* up = proj + (size_t)(tok0 + t) * PROJ_LD + COL_U + g * 16; float u0[8], u1[8]; unpack8(*(const v4u*)up, u0); unpack8(*(const v4u*)(up + 8), u1);
            float br = 0.f, bi = 0.f;
#pragma unroll
            for (int c = 0; c < 8; ++c) { br += bre[c] * u0[c]; bi += bim[c] * u0[c]; }
#pragma unroll
            for (int c = 0; c < 8; ++c) { br += bre[8 + c] * u1[c]; bi += bim[8 + c] * u1[c]; }
            const float nr = lam.x * xr - lam.y * xi + br, ni = lam.x * xi + lam.y * xr + bi; xr = nr; xi = ni; }
        f32x2* dst = (f32x2*)(F.ws + WS_S5ST + alt) + (size_t)(unit * 16 + g) * 64 + lane;
        if (CMP) { const unsigned* pu = (const unsigned*)dst; const unsigned ox = pu[0], oy = pu[1]; if (ox != __float_as_uint(xr) || oy != __float_as_uint(xi)) ++bad; }
        else *dst = (f32x2){xr, xi};
    }
    return bad;
}

__device__ __forceinline__ void mixer_states(const Ctx& F, const Args& args, int l) {
    const int tid = fresh_tid(), lane = tid & 63, w = __builtin_amdgcn_readfirstlane(tid >> 6), r = lane & 31, hh = lane >> 5;
    const bf16* proj = (const bf16*)(F.ws + WS_PROJ);
    LAS bf16* L16 = (LAS bf16*)F.lds;
    for (int unit = F.bid; unit < NUNIT; unit += F.G) {
        const int c = unit & 31, b = unit >> 5, tok0 = unit * 128, pos0 = c * 128;
        {
            LAS bf16* VT = L16; LAS bf16* KT = L16 + 256 * 136;
#pragma unroll
            for (int i = 0; i < 8; ++i) { const int j = tid & 127, cg = (tid >> 7) + 4 * i;
                const v4u v = *(const v4u*)(proj + (size_t)(tok0 + j) * PROJ_LD + COL_V + 8 * cg); float f[8]; unpack8(v, f);
#pragma unroll
                for (int q = 0; q < 8; ++q) VT[(8 * cg + q) * 136 + j] = (bf16)f2bf(f[q]); }
            const float* ct = (const float*)(F.ws + WS_ROPE); const float* st = ct + SEQ * 32;
#pragma unroll
            for (int i = 0; i < 4; ++i) { const int j = tid & 127, hd = (tid >> 7) + 4 * i, h = hd >> 2, dg = hd & 3;
                const bf16* kp = proj + (size_t)(tok0 + j) * PROJ_LD + COL_K + h * 64 + 8 * dg;
                float k1[8], k2[8]; unpack8(*(const v4u*)kp, k1); unpack8(*(const v4u*)(kp + 32), k2);
                const float* cp = ct + (size_t)(pos0 + j) * 32 + 8 * dg; const float* sp = st + (size_t)(pos0 + j) * 32 + 8 * dg;
                const f32x4 c0 = *(const f32x4*)cp, c1 = *(const f32x4*)(cp + 4), s0 = *(const f32x4*)sp, s1 = *(const f32x4*)(sp + 4);
                const float cs[8] = {c0.x, c0.y, c0.z, c0.w, c1.x, c1.y, c1.z, c1.w}, sn[8] = {s0.x, s0.y, s0.z, s0.w, s1.x, s1.y, s1.z, s1.w};
                const float fac = 0.125f * __expf(ret_lg(h) * (float)(127 - j));
#pragma unroll
                for (int q = 0; q < 8; ++q) { KT[(h * 64 + 8 * dg + q) * 136 + j] = (bf16)f2bf((k1[q] * cs[q] - k2[q] * sn[q]) * fac); KT[(h * 64 + 32 + 8 * dg + q) * 136 + j] = (bf16)f2bf((k1[q] * sn[q] + k2[q] * cs[q]) * fac); } }
            FULL_SYNC();
            const int h = w >> 1, me = w & 1;
            f32x16 a0 = zero16(), a1 = zero16();
            mma_tile<8>(a0, VT + (h * 64 + 32 * me + r) * 136 + 8 * hh, KT + (h * 64 + r) * 136 + 8 * hh);
            mma_tile<8>(a1, VT + (h * 64 + 32 * me + r) * 136 + 8 * hh, KT + (h * 64 + 32 + r) * 136 + 8 * hh);
            float* o = (float*)(F.ws + WS_RETST) + ((size_t)((b * 4 + h) * 32 + c)) * 4096;
#pragma unroll
            for (int rg = 0; rg < 16; ++rg) { const int e = 32 * me + crow(rg, hh); o[e * 64 + r] = a0[rg]; o[e * 64 + 32 + r] = a1[rg]; }
            FULL_SYNC();
        }
        {
            LAS bf16* BT = L16; LAS bf16* XT = L16 + 128 * 136; LAS float* dt_s = (LAS float*)(F.lds + 104448); LAS float* acum_s = dt_s + 1024;
            ssd_dt_acum(F, args, l, unit, dt_s, acum_s, (float*)(F.ws + WS_SSDDEC));
            FULL_SYNC();
            const float* cw = args.in[I_CONV_W] + (size_t)l * 4 * 1024; const float* cb = args.in[I_CONV_B] + (size_t)l * 1024;
            for (int g = 0; g < 2; ++g) {
#pragma unroll
                for (int i = 0; i < 4; ++i) { const int ll = tid & 127, ng = (tid >> 7) + 4 * i, chan = 512 + g * 128 + 8 * ng; float o[8];
                    conv_silu8(proj + (size_t)(tok0 + ll) * PROJ_LD + COL_X + chan, ll, c == 0, cw + chan, cb + chan, o);
#pragma unroll
                    for (int q = 0; q < 8; ++q) BT[(8 * ng + q) * 136 + ll] = (bf16)f2bf(o[q]); }
#pragma unroll
                for (int i = 0; i < 8; ++i) { const int ll = tid & 127, cg = (tid >> 7) + 4 * i, chan = g * 256 + 8 * cg, head = g * 4 + (cg >> 3); float o[8];
                    conv_silu8(proj + (size_t)(tok0 + ll) * PROJ_LD + COL_X + chan, ll, c == 0, cw + chan, cb + chan, o);
                    const float sc = dt_s[head * 128 + ll] * __expf(acum_s[head * 128 + 127] - acum_s[head * 128 + ll]);
#pragma unroll
                    for (int q = 0; q < 8; ++q) XT[(8 * cg + q) * 136 + ll] = (bf16)f2bf(o[q] * sc); }
                FULL_SYNC();
                const int mp = w >> 2, nn = w & 3;
#pragma unroll
                for (int hl = 0; hl < 4; ++hl) {
                    f32x16 a = zero16();
                    mma_tile<8>(a, XT + (hl * 64 + 32 * mp + r) * 136 + 8 * hh, BT + (32 * nn + r) * 136 + 8 * hh);
                    bf16* o = (bf16*)(F.ws + WS_SSDST) + ((size_t)(unit * 8 + g * 4 + hl)) * 8192;
#pragma unroll
                    for (int rg = 0; rg < 16; ++rg) o[(32 * mp + crow(rg, hh)) * 128 + 32 * nn + r] = (bf16)f2bf(a[rg]);
                }
                FULL_SYNC();
            }
        }
#if DEBUG_STAGE == 4
        { unsigned bad0 = 0, bad1 = 0;
#pragma nounroll
          for (int rep = 0; rep < 4; ++rep) { const unsigned b_ = s5_chunk_states(F, l, unit, rep >= 2, (rep & 1) ? (size_t)(WS_CAT - WS_S5ST) : 0); if (rep == 2) bad0 += b_; if (rep == 3) bad1 += b_; FULL_SYNC(); }
          if (bad0) atomicAdd((unsigned*)(F.ws + WS_CTL) + CW_DIAG, bad0); if (bad1) atomicAdd((unsigned*)(F.ws + WS_CTL) + CW_DIAG + 1, bad1); }
#else
        (void)s5_chunk_states(F, l, unit, false);
        FULL_SYNC();
#endif
    }
}

__device__ __forceinline__ void mixer_scan(const Ctx& F, const Args& args, int l) {
    const int gt = F.bid * NTHREADS + fresh_tid(), NGT = F.G * NTHREADS;
    constexpr int N_RET = BATCH * 4 * 4096, N_SSD = BATCH * 8 * 1024, N_S5 = BATCH * 1024;
    for (int q0 = gt; q0 < N_RET + N_SSD + N_S5; q0 += NGT) {
        if (q0 < N_RET) {
            const int bh = q0 >> 12, ed = q0 & 4095; float* p = (float*)(F.ws + WS_RETST) + (size_t)bh * 32 * 4096 + ed;
            const float dec = __expf(ret_lg(bh & 3) * 128.f);
            float v[32];
#pragma unroll
            for (int c = 0; c < 32; ++c) v[c] = p[(size_t)c * 4096];
            float S = 0.f; asm volatile("" : "+v"(S));
#pragma unroll
            for (int c = 0; c < 32; ++c) { p[(size_t)c * 4096] = S; S = S * dec + v[c]; }
        } else if (q0 < N_RET + N_SSD) {
            const int q = q0 - N_RET, bh = q >> 10, e8 = q & 1023, b = bh >> 3, head = bh & 7;
            bf16* p = (bf16*)(F.ws + WS_SSDST) + ((size_t)(b * 32) * 8 + head) * 8192 + e8 * 8;
            const float* dec = (const float*)(F.ws + WS_SSDDEC) + (size_t)(b * 32) * 8 + head;
            float S[8];
#pragma unroll
            for (int k = 0; k < 8; ++k) { S[k] = 0.f; asm volatile("" : "+v"(S[k])); }
#pragma unroll 1
            for (int c0 = 0; c0 < 32; c0 += 8) {
                v4u v[8]; float d[8];
#pragma unroll
                for (int c = 0; c < 8; ++c) { v[c] = *(const v4u*)(p + (size_t)(c0 + c) * 8 * 8192); d[c] = dec[(c0 + c) * 8]; }
#pragma unroll
                for (int c = 0; c < 8; ++c) { float f[8]; unpack8(v[c], f); *(v4u*)(p + (size_t)(c0 + c) * 8 * 8192) = pack8(S);
#pragma unroll
                    for (int k = 0; k < 8; ++k) S[k] = S[k] * d[c] + f[k]; }
            }
        } else {
            const int q = q0 - N_RET - N_SSD, b = q >> 10, gp = q & 1023;
            f32x2* p = (f32x2*)(F.ws + WS_S5ST) + (size_t)(b * 32) * 1024 + gp;
            const f32x4 lam = ((const f32x4*)(F.ws + WS_S5TAB + (size_t)l * S5TAB_LAYER))[gp];
            f32x2 v[32];
#pragma unroll
            for (int c = 0; c < 32; ++c) v[c] = p[(size_t)c * 1024];
            float xr = 0.f, xi = 0.f; asm volatile("" : "+v"(xr), "+v"(xi));
#pragma unroll
            for (int c = 0; c < 32; ++c) { p[(size_t)c * 1024] = (f32x2){xr, xi}; const float nr = lam.z * xr - lam.w * xi + v[c].x, ni = lam.z * xi + lam.w * xr + v[c].y; xr = nr; xi = ni; }
        }
    }
}

__device__ __forceinline__ void mixer_out_ret(const Ctx& F, const Args& args, int l) {
    const int tid = fresh_tid(), lane = tid & 63, w = __builtin_amdgcn_readfirstlane(tid >> 6), r = lane & 31, hh = lane >> 5;
    const bf16* proj = (const bf16*)(F.ws + WS_PROJ);
    bf16* cat = (bf16*)(F.ws + WS_CAT);
    LAS bf16* L16 = (LAS bf16*)F.lds;
    for (int unit = F.bid; unit < NUNIT; unit += F.G) {
        const int c = unit & 31, b = unit >> 5, tok0 = unit * 128, pos0 = c * 128; (void)b; (void)pos0;
        {
            LAS bf16* Qs = L16; LAS bf16* Ks = L16 + 128 * 72; LAS bf16* VT = L16 + 2 * 128 * 72; LAS bf16* Ps = VT + 64 * 136; LAS bf16* STs = Ps + 128 * 136; LAS float* exch = (LAS float*)(F.lds + 98304);
            const float* ct = (const float*)(F.ws + WS_ROPE); const float* st = ct + SEQ * 32;
            for (int h = 0; h < 4; ++h) {
                const float lg = ret_lg(h);
                { const int i = tid & 127, dg = tid >> 7;
                  const bf16* qp = proj + (size_t)(tok0 + i) * PROJ_LD + COL_Q + h * 64 + 8 * dg; const bf16* kp = qp + (COL_K - COL_Q);
                  float q1[8], q2[8], k1[8], k2[8]; unpack8(*(const v4u*)qp, q1); unpack8(*(const v4u*)(qp + 32), q2); unpack8(*(const v4u*)kp, k1); unpack8(*(const v4u*)(kp + 32), k2);
                  const float* cp = ct + (size_t)(pos0 + i) * 32 + 8 * dg; const float* sp = st + (size_t)(pos0 + i) * 32 + 8 * dg;
                  const f32x4 c0 = *(const f32x4*)cp, c1 = *(const f32x4*)(cp + 4), s0 = *(const f32x4*)sp, s1 = *(const f32x4*)(sp + 4);
                  const float cs[8] = {c0.x, c0.y, c0.z, c0.w, c1.x, c1.y, c1.z, c1.w}, sn[8] = {s0.x, s0.y, s0.z, s0.w, s1.x, s1.y, s1.z, s1.w};
                  float a1[8], a2[8], b1[8], b2[8];
#pragma unroll
                  for (int q = 0; q < 8; ++q) { a1[q] = q1[q] * cs[q] - q2[q] * sn[q]; a2[q] = q1[q] * sn[q] + q2[q] * cs[q]; b1[q] = 0.125f * (k1[q] * cs[q] - k2[q] * sn[q]); b2[q] = 0.125f * (k1[q] * sn[q] + k2[q] * cs[q]); }
                  *(LAS v4u*)(Qs + i * 72 + 8 * dg) = pack8(a1); *(LAS v4u*)(Qs + i * 72 + 32 + 8 * dg) = pack8(a2);
                  *(LAS v4u*)(Ks + i * 72 + 8 * dg) = pack8(b1); *(LAS v4u*)(Ks + i * 72 + 32 + 8 * dg) = pack8(b2); }
#pragma unroll
                for (int i = 0; i < 2; ++i) { const int j = tid & 127, cg = (tid >> 7) + 4 * i;
                    float f[8]; unpack8(*(const v4u*)(proj + (size_t)(tok0 + j) * PROJ_LD + COL_V + h * 64 + 8 * cg), f);
#pragma unroll
                    for (int q = 0; q < 8; ++q) VT[(8 * cg + q) * 136 + j] = (bf16)f2bf(f[q]); }
                { const int e = tid >> 3, d0 = (tid & 7) * 8; const float* sp = (const float*)(F.ws + WS_RETST) + ((size_t)((b * 4 + h) * 32 + c)) * 4096 + e * 64 + d0;
                  const f32x4 u0 = *(const f32x4*)sp, u1 = *(const f32x4*)(sp + 4); const float f[8] = {u0.x, u0.y, u0.z, u0.w, u1.x, u1.y, u1.z, u1.w};
                  *(LAS v4u*)(STs + e * 72 + d0) = pack8(f); }
                FULL_SYNC();
                { const int ti = w & 3;
#pragma unroll
                  for (int k = 0; k < 2; ++k) { const int tj = 2 * (w >> 2) + k;
                      if (tj <= ti) { f32x16 a = zero16(); mma_tile<4>(a, Qs + (32 * ti + r) * 72 + 8 * hh, Ks + (32 * tj + r) * 72 + 8 * hh);
#pragma unroll
                          for (int rg = 0; rg < 16; ++rg) { const int i = 32 * ti + crow(rg, hh), j = 32 * tj + r; const float v = (j <= i) ? a[rg] * __expf(lg * (float)(i - j)) : 0.f; Ps[i * 136 + j] = (bf16)f2bf(v); } } } }
                FULL_SYNC();
                { const int te = w >> 2, ti = w & 3, i = 32 * ti + r;
                  f32x16 yin = zero16(), yx = zero16();
                  mma_tile_n(yin, VT + (32 * te + r) * 136 + 8 * hh, Ps + (32 * ti + r) * 136 + 8 * hh, 2 * (ti + 1));
                  mma_tile<4>(yx, STs + (32 * te + r) * 72 + 8 * hh, Qs + (32 * ti + r) * 72 + 8 * hh);
                  const float dq = __expf(lg * (float)(i + 1));
                  float ss = 0.f;
#pragma unroll
                  for (int rg = 0; rg < 16; ++rg) { yin[rg] += dq * yx[rg]; ss += yin[rg] * yin[rg]; }
                  ss += __shfl_xor(ss, 32);
                  if (hh == 0) exch[w * 32 + r] = ss;
                  FULL_SYNC();
                  const float rs = rsqrtf((exch[w * 32 + r] + exch[(w ^ 4) * 32 + r]) * (1.f / 64.f) + EPS);
                  const float* gn = args.in[I_RET_GN_G] + l * 256 + h * 64;
#pragma unroll
                  for (int g4 = 0; g4 < 4; ++g4) { const int e0 = 32 * te + 8 * g4 + 4 * hh;
                      const v2u gz = *(const v2u*)(proj + (size_t)(tok0 + i) * PROJ_LD + COL_G + h * 64 + e0); const f32x4 gg = *(const f32x4*)(gn + e0);
                      const float o0 = siluf_(bflo(gz.x)) * yin[4 * g4 + 0] * rs * gg.x, o1 = siluf_(bfhi(gz.x)) * yin[4 * g4 + 1] * rs * gg.y, o2 = siluf_(bflo(gz.y)) * yin[4 * g4 + 2] * rs * gg.z, o3 = siluf_(bfhi(gz.y)) * yin[4 * g4 + 3] * rs * gg.w;
                      v2u ov; ov.x = pk2(o0, o1); ov.y = pk2(o2, o3);
                      *(v2u*)(cat + (size_t)(tok0 + i) * DM + h * 64 + e0) = ov; } }
                FULL_SYNC();
            }
        }
    }
}
__device__ __forceinline__ void mixer_out_ssd(const Ctx& F, const Args& args, int l) {
    const int tid = fresh_tid(), lane = tid & 63, w = __builtin_amdgcn_readfirstlane(tid >> 6), r = lane & 31, hh = lane >> 5;
    const bf16* proj = (const bf16*)(F.ws + WS_PROJ);
    bf16* cat = (bf16*)(F.ws + WS_CAT);
    LAS bf16* L16 = (LAS bf16*)F.lds;
    for (int unit = F.bid; unit < NUNIT; unit += F.G) {
        const int c = unit & 31, b = unit >> 5, tok0 = unit * 128, pos0 = c * 128; (void)b; (void)pos0;
        {
            LAS bf16* Cs = L16; LAS bf16* BMs = L16 + 128 * 136; LAS bf16* XT = L16 + 2 * 128 * 136; LAS bf16* SP = XT + 64 * 136;
            LAS float* dt_s = (LAS float*)(F.lds + 104448); LAS float* acum_s = dt_s + 1024; LAS float* exch = acum_s + 1024; LAS float* rstd_s = exch + 256;
            ssd_dt_acum(F, args, l, unit, dt_s, acum_s, nullptr);
            FULL_SYNC();
            const float* cw = args.in[I_CONV_W] + (size_t)l * 4 * 1024; const float* cb = args.in[I_CONV_B] + (size_t)l * 1024;
            float ssq = 0.f;
            for (int g = 0; g < 2; ++g) {
#pragma unroll
                for (int i = 0; i < 4; ++i) { const int ll = tid & 127, ng = (tid >> 7) + 4 * i; float o[8];
                    conv_silu8(proj + (size_t)(tok0 + ll) * PROJ_LD + COL_X + 768 + g * 128 + 8 * ng, ll, c == 0, cw + 768 + g * 128 + 8 * ng, cb + 768 + g * 128 + 8 * ng, o);
                    *(LAS v4u*)(Cs + ll * 136 + 8 * ng) = pack8(o);
                    conv_silu8(proj + (size_t)(tok0 + ll) * PROJ_LD + COL_X + 512 + g * 128 + 8 * ng, ll, c == 0, cw + 512 + g * 128 + 8 * ng, cb + 512 + g * 128 + 8 * ng, o);
                    *(LAS v4u*)(BMs + ll * 136 + 8 * ng) = pack8(o); }
                FULL_SYNC();
                const int tl = w & 3;
                f32x16 cbt[2];
#pragma unroll
                for (int k = 0; k < 2; ++k) { const int ts = 2 * (w >> 2) + k; cbt[k] = zero16();
                    if (ts <= tl) mma_tile<8>(cbt[k], Cs + (32 * tl + r) * 136 + 8 * hh, BMs + (32 * ts + r) * 136 + 8 * hh); }
                FULL_SYNC();
                for (int hl = 0; hl < 4; ++hl) { const int head = g * 4 + hl;
                    const float Dh = args.in[I_SSD_D][l * 8 + head];
#pragma unroll
                    for (int k = 0; k < 2; ++k) { const int ts = 2 * (w >> 2) + k;
                        if (ts <= tl) {
                            const int s = 32 * ts + r; const float as = acum_s[head * 128 + s];
#pragma unroll
                            for (int rg = 0; rg < 16; ++rg) { const int ll = 32 * tl + crow(rg, hh);
                                float v = (s <= ll) ? cbt[k][rg] * __expf(acum_s[head * 128 + ll] - as) : 0.f;
                                if (s == ll) v += Dh / dt_s[head * 128 + ll];
                                BMs[ll * 136 + s] = (bf16)f2bf(v); } } }
#pragma unroll
                    for (int i = 0; i < 2; ++i) { const int ll = tid & 127, cg = (tid >> 7) + 4 * i, chan = head * 64 + 8 * cg; float o[8];
                        conv_silu8(proj + (size_t)(tok0 + ll) * PROJ_LD + COL_X + chan, ll, c == 0, cw + chan, cb + chan, o);
                        const float sc = dt_s[head * 128 + ll];
#pragma unroll
                        for (int q = 0; q < 8; ++q) XT[(8 * cg + q) * 136 + ll] = (bf16)f2bf(o[q] * sc); }
#pragma unroll
                    for (int i = 0; i < 2; ++i) { const int v = tid + 512 * i, p = v >> 4, n0 = (v & 15) * 8;
                        *(LAS v4u*)(SP + p * 136 + n0) = *(const v4u*)((const bf16*)(F.ws + WS_SSDST) + ((size_t)(unit * 8 + head)) * 8192 + p * 128 + n0); }
                    FULL_SYNC();
                    { const int tp = w >> 2, ll = 32 * tl + r;
                      f32x16 yd = zero16(), yo = zero16();
                      mma_tile_n(yd, XT + (32 * tp + r) * 136 + 8 * hh, BMs + (32 * tl + r) * 136 + 8 * hh, 2 * (tl + 1));
                      mma_tile<8>(yo, SP + (32 * tp + r) * 136 + 8 * hh, Cs + (32 * tl + r) * 136 + 8 * hh);
                      const float ea = __expf(acum_s[head * 128 + ll]);
#pragma unroll
                      for (int g4 = 0; g4 < 4; ++g4) { const int p0 = 32 * tp + 8 * g4 + 4 * hh;
                          const v2u zz = *(const v2u*)(proj + (size_t)(tok0 + ll) * PROJ_LD + COL_Z + head * 64 + p0);
                          const float y0 = (yd[4 * g4 + 0] + ea * yo[4 * g4 + 0]) * siluf_(bflo(zz.x)), y1 = (yd[4 * g4 + 1] + ea * yo[4 * g4 + 1]) * siluf_(bfhi(zz.x)),
                                      y2 = (yd[4 * g4 + 2] + ea * yo[4 * g4 + 2]) * siluf_(bflo(zz.y)), y3 = (yd[4 * g4 + 3] + ea * yo[4 * g4 + 3]) * siluf_(bfhi(zz.y));
                          ssq += y0 * y0 + y1 * y1 + y2 * y2 + y3 * y3;
                          v2u ov; ov.x = pk2(y0, y1); ov.y = pk2(y2, y3);
                          *(v2u*)(cat + (size_t)(tok0 + ll) * DM + 256 + head * 64 + p0) = ov; } }
                    FULL_SYNC();
                }
            }
            ssq += __shfl_xor(ssq, 32);
            if (hh == 0) exch[w * 32 + r] = ssq;
            VM_WAIT();
            FULL_SYNC();
            if (w < 4 && hh == 0) rstd_s[32 * w + r] = rsqrtf((exch[w * 32 + r] + exch[(w + 4) * 32 + r]) * (1.f / 512.f) + EPS);
            FULL_SYNC();
            const float* ng = args.in[I_SSD_NORM_G] + l * 512;
#pragma unroll 4
            for (int i = 0; i < 16; ++i) { const int v = tid + 512 * i, ll = v >> 6, c8 = (v & 63) * 8;
                bf16* p = cat + (size_t)(tok0 + ll) * DM + 256 + c8; float f[8]; unpack8(*(const v4u*)p, f);
                const float rs = rstd_s[ll]; const f32x4 g0 = *(const f32x4*)(ng + c8), g1 = *(const f32x4*)(ng + c8 + 4);
                f[0] *= rs * g0.x; f[1] *= rs * g0.y; f[2] *= rs * g0.z; f[3] *= rs * g0.w; f[4] *= rs * g1.x; f[5] *= rs * g1.y; f[6] *= rs * g1.z; f[7] *= rs * g1.w;
                *(v4u*)p = pack8(f); }
            FULL_SYNC();
        }
    }
}
__device__ __forceinline__ void mixer_out_s5(const Ctx& F, const Args& args, int l) {
    const int tid = fresh_tid(), lane = tid & 63, w = __builtin_amdgcn_readfirstlane(tid >> 6), r = lane & 31, hh = lane >> 5;
    const bf16* proj = (const bf16*)(F.ws + WS_PROJ);
    bf16* cat = (bf16*)(F.ws + WS_CAT);
    LAS bf16* L16 = (LAS bf16*)F.lds;
    for (int unit = F.bid; unit < NUNIT; unit += F.G) {
        const int c = unit & 31, b = unit >> 5, tok0 = unit * 128, pos0 = c * 128; (void)b; (void)pos0;
        {
            LAS unsigned char* slab = F.lds + s5_slab_off(w);
            const unsigned char* tab = F.ws + WS_S5TAB + (size_t)l * S5TAB_LAYER;
            for (int rd = 0; rd < 2; ++rd) { const int g = w + 8 * rd;
                const f32x4 lam = ((const f32x4*)tab)[g * 64 + lane];
                float bre[16], bim[16];
                { const bf16* bb = (const bf16*)(tab + S5TAB_BBAR) + (size_t)(g * 128 + lane) * 16; float t0[8], t1[8]; unpack8(*(const v4u*)bb, t0); unpack8(*(const v4u*)(bb + 8), t1);
#pragma unroll
                  for (int q = 0; q < 8; ++q) { bre[q] = t0[q]; bre[8 + q] = t1[q]; }
                  const bf16* bi_ = bb + 64 * 16; unpack8(*(const v4u*)bi_, t0); unpack8(*(const v4u*)(bi_ + 8), t1);
#pragma unroll
                  for (int q = 0; q < 8; ++q) { bim[q] = t0[q]; bim[8 + q] = t1[q]; } }
                bf16x8 cfr[8];
#pragma unroll
                for (int ks = 0; ks < 8; ++ks) cfr[ks] = *(const bf16x8*)((const bf16*)(tab + S5TAB_CT) + (size_t)(g * 32 + r) * 128 + 16 * ks + 8 * hh);
                const f32x2 x0 = ((const f32x2*)(F.ws + WS_S5ST))[(size_t)(unit * 16 + g) * 64 + lane];
                float xr = x0.x, xi = x0.y;
                const int ch = g * 16 + (r & 15); const float Dc = args.in[I_S5_D][l * 256 + ch];
                for (int s = 0; s < 4; ++s) {
#pragma unroll 4
                    for (int t = 0; t < 32; ++t) {
                        const bf16* up = proj + (size_t)(tok0 + 32 * s + t) * PROJ_LD + COL_U + g * 16; float u0[8], u1[8]; unpack8(*(const v4u*)up, u0); unpack8(*(const v4u*)(up + 8), u1);
                        float br = 0.f, bi = 0.f;
#pragma unroll
                        for (int q = 0; q < 8; ++q) { br += bre[q] * u0[q]; bi += bim[q] * u0[q]; }
#pragma unroll
                        for (int q = 0; q < 8; ++q) { br += bre[8 + q] * u1[q]; bi += bim[8 + q] * u1[q]; }
                        const float nr = lam.x * xr - lam.y * xi + br, ni = lam.x * xi + lam.y * xr + bi; xr = nr; xi = ni;
                        LAS bf16* xrow = (LAS bf16*)(slab + t * 528); xrow[lane] = (bf16)f2bf(xr); xrow[64 + lane] = (bf16)f2bf(xi); }
                    LDS_WAIT();
                    f32x16 y = zero16();
#pragma unroll
                    for (int ks = 0; ks < 8; ++ks) y = MFMA32(*(LAS const bf16x8*)(slab + r * 528 + (16 * ks + 8 * hh) * 2), cfr[ks], y);
                    if (r < 16) {
#pragma unroll
                        for (int rg = 0; rg < 16; ++rg) { const int tok = tok0 + 32 * s + crow(rg, hh);
                            const float uv = bf2f(proj[(size_t)tok * PROJ_LD + COL_U + ch]);
                            cat[(size_t)tok * DM + 768 + ch] = (bf16)f2bf(gelu_tanh(y[rg] + Dc * uv)); } }
                    LDS_WAIT();
                }
            }
            VM_WAIT();
            FULL_SYNC();
            LAS bf16* Gs = L16;
#pragma unroll
            for (int i = 0; i < 8; ++i) { const int v = tid + 512 * i, t = v >> 5, c8 = (v & 31) * 8; *(LAS v4u*)(Gs + t * 264 + c8) = *(const v4u*)(cat + (size_t)(tok0 + t) * DM + 768 + c8); }
            FULL_SYNC();
            const bf16* wg = (const bf16*)(F.ws + WS_WGLU) + (size_t)l * 65536;
            f32x16 acc[4];
#pragma unroll
            for (int tt = 0; tt < 4; ++tt) acc[tt] = zero16();
#pragma unroll 4
            for (int ks = 0; ks < 16; ++ks) { const bf16x8 bf = *(const bf16x8*)(wg + (size_t)(32 * w + r) * 256 + 16 * ks + 8 * hh);
#pragma unroll
                for (int tt = 0; tt < 4; ++tt) acc[tt] = MFMA32(ldsv8(Gs + (32 * tt + r) * 264 + 16 * ks + 8 * hh), bf, acc[tt]); }
            const int j = 32 * w + r; const float bj = args.in[I_S5_BGLU][l * 256 + j];
#pragma unroll
            for (int tt = 0; tt < 4; ++tt)
#pragma unroll
                for (int rg = 0; rg < 16; ++rg) { const int t = 32 * tt + crow(rg, hh); const float gv = bf2f(Gs[t * 264 + j]);
                    cat[(size_t)(tok0 + t) * DM + 768 + j] = (bf16)f2bf(gv * sigmoidf_(acc[tt][rg] + bj)); }
            FULL_SYNC();
        }
    }
}
__device__ __forceinline__ void mixer_outputs(const Ctx& F, const Args& args, int l) { mixer_out_ret(F, args, l); mixer_out_ssd(F, args, l); mixer_out_s5(F, args, l); }


struct KvOrder {
    const char* ws; int G, c;
    __device__ __forceinline__ bool next(int i, Unit& u) const {
        const int L = i * G + c; if (L >= 128) return false;
        const int layer = L >> 6, rem = L & 63, kind = rem >> 5, idx = rem & 31;
        if (kind == 0) { u.pm = idx >> 2; u.pn = idx & 3; } else { u.pm = idx >> 3; u.pn = idx & 7; }
        u.z = layer * 2 + kind; return true;
    }
    __device__ __forceinline__ const char* a_base(const Unit& u) const { return (u.z & 1) ? ws + WS_WV + ((size_t)(u.z >> 1) * DM + u.pm * 256) * DM * 2 : ws + WS_MN + (size_t)u.pm * 256 * DM * 2; }
    __device__ __forceinline__ const char* b_base(const Unit& u) const { return (u.z & 1) ? ws + WS_MN + (size_t)u.pn * 256 * DM * 2 : ws + WS_WK + ((size_t)(u.z >> 1) * DM + u.pn * 256) * DM * 2; }
    __device__ __forceinline__ void a_voff(int, const Unit&, int K_, unsigned (&voffA)[2][2], int tid) const { pg8::dense_voff(K_, voffA, tid); }
};
struct EpiKV {
    unsigned char* ws;
    __device__ __forceinline__ void operator()(const f32x4 (&acc)[2][2][4][2], const Unit& u, int wr, int wc, int fr, int fq) const {
        const int layer = u.z >> 1; const bool isv = u.z & 1;
        bf16* O = isv ? (bf16*)(ws + WS_VT) + (size_t)layer * DM * TM : (bf16*)(ws + WS_KB) + (size_t)layer * TM * DM; const int ldc = isv ? TM : DM;
        const int row0 = u.pm * 256 + wr * 64 + fr, col0 = u.pn * 256 + wc * 32 + 8 * fq;
#pragma unroll
        for (int ai = 0; ai < 2; ++ai)
#pragma unroll
            for (int m = 0; m < 4; ++m) { bf16* rowp = O + (size_t)(row0 + ai * 128 + m * 16) * ldc + col0;
#pragma unroll
                for (int bj = 0; bj < 2; ++bj) { const f32x4 v0 = acc[ai][bj][m][0], v1 = acc[ai][bj][m][1];
                    v4u w; w.x = cvt_pk_bf16(v0[0], v0[1]); w.y = cvt_pk_bf16(v0[2], v0[3]); w.z = cvt_pk_bf16(v1[0], v1[1]); w.w = cvt_pk_bf16(v1[2], v1[3]);
                    *(v4u*)(rowp + bj * 128) = w; } }
    }
};

__device__ __forceinline__ void attn_phase(const Ctx& F, int l) {
    const int tid = fresh_tid(), lane = tid & 63, w = __builtin_amdgcn_readfirstlane(tid >> 6), r = lane & 31, hh = lane >> 5;
    bf16* Q = (bf16*)(F.ws + WS_Q);
    const bf16* KB = (const bf16*)(F.ws + WS_KB) + (size_t)l * TM * DM; const bf16* VTg = (const bf16*)(F.ws + WS_VT) + (size_t)l * DM * TM;
    LAS bf16* L16 = (LAS bf16*)F.lds;
    constexpr int HALF_EL = 33792;
    for (int L = F.vcu; L < 512; L += F.G) {
        const int bh = L >> 4, qt = L & 15, b = bh >> 2, h = bh & 3;
        const int q0 = b * SEQ + qt * 256 + 32 * w;
#pragma unroll 4
        for (int i = 0; i < 16; ++i) { const int v = tid + 512 * i, key = v >> 5, d8 = (v & 31) * 8;
            *(LAS v4u*)(L16 + (key >> 7) * HALF_EL + (key & 127) * 264 + d8) = *(const v4u*)(KB + (size_t)(b * MEMLEN + key) * DM + h * 256 + d8); }
        FULL_SYNC();
        f32x16 S[8];
#pragma unroll
        for (int kt = 0; kt < 8; ++kt) S[kt] = zero16();
        {
            const bf16* qp = Q + (size_t)(q0 + r) * DM + h * 256 + 8 * hh;
            LAS const bf16* kp0 = L16 + r * 264 + 8 * hh;
#pragma unroll 2
            for (int ks = 0; ks < 16; ++ks) {
                const bf16x8 qf = *(const bf16x8*)(qp + 16 * ks);
#pragma unroll
                for (int kt = 0; kt < 8; ++kt) S[kt] = MFMA32(ldsv8(kp0 + (kt >> 2) * HALF_EL + 32 * (kt & 3) * 264 + 16 * ks), qf, S[kt]);
            }
        }
        FULL_SYNC();
#pragma unroll 4
        for (int i = 0; i < 16; ++i) { const int v = tid + 512 * i, d = v >> 5, k8 = (v & 31) * 8;
            const v4u vv = *(const v4u*)(VTg + (size_t)(h * 256 + d) * TM + b * MEMLEN + k8);
            LAS v2u* dst = (LAS v2u*)(L16 + (k8 >> 7) * HALF_EL + d * 132 + (k8 & 127));
            dst[0] = (v2u){vv.x, vv.y}; dst[1] = (v2u){vv.z, vv.w}; }
        float mx = -1e30f;
#pragma unroll
        for (int kt = 0; kt < 8; ++kt)
#pragma unroll
            for (int rg = 0; rg < 16; ++rg) mx = fmaxf(mx, S[kt][rg]);
        mx = fmaxf(mx, __shfl_xor(mx, 32));
        float sum = 0.f;
        bf16x8 pf[8][2];
#pragma unroll
        for (int kt = 0; kt < 8; ++kt) {
#pragma unroll
            for (int rg = 0; rg < 16; ++rg) { S[kt][rg] = __builtin_amdgcn_exp2f(S[kt][rg] - mx); sum += S[kt][rg]; }
#pragma unroll
            for (int s = 0; s < 2; ++s) { v4u pw; pw.x = pk2(S[kt][8 * s + 0], S[kt][8 * s + 1]); pw.y = pk2(S[kt][8 * s + 2], S[kt][8 * s + 3]); pw.z = pk2(S[kt][8 * s + 4], S[kt][8 * s + 5]); pw.w = pk2(S[kt][8 * s + 6], S[kt][8 * s + 7]);
                pf[kt][s] = __builtin_bit_cast(bf16x8, pw); } }
        sum += __shfl_xor(sum, 32);
        const float inv = 1.f / sum;
        FULL_SYNC();
#pragma unroll 1
        for (int dt = 0; dt < 8; ++dt) {
            f32x16 o = zero16();
#pragma unroll
            for (int kt = 0; kt < 8; ++kt)
#pragma unroll
                for (int s = 0; s < 2; ++s) {
                    LAS const bf16* vp = L16 + (kt >> 2) * HALF_EL + (32 * dt + r) * 132 + 32 * (kt & 3) + 16 * s + 4 * hh;
                    const v2u lo = *(LAS const v2u*)vp, hi = *(LAS const v2u*)(vp + 8);
                    const v4u av = {lo.x, lo.y, hi.x, hi.y};
                    o = MFMA32(__builtin_bit_cast(bf16x8, av), pf[kt][s], o); }
#pragma unroll
            for (int g4 = 0; g4 < 4; ++g4) { v2u ov; ov.x = pk2(o[4 * g4 + 0] * inv, o[4 * g4 + 1] * inv); ov.y = pk2(o[4 * g4 + 2] * inv, o[4 * g4 + 3] * inv);
                *(v2u*)(Q + (size_t)(q0 + r) * DM + h * 256 + 32 * dt + 8 * g4 + 4 * hh) = ov; }
        }
        FULL_SYNC();
    }
}

typedef float f32x4v __attribute__((ext_vector_type(4)));
__device__ __forceinline__ void split_hi_lo(const f32x4 a, const f32x4 b, bf16x8& hi, bf16x8& lo) {
    const float f[8] = {a.x, a.y, a.z, a.w, b.x, b.y, b.z, b.w}; unsigned h[8], lw[8];
#pragma unroll
    for (int q = 0; q < 8; ++q) { h[q] = f2bf(f[q]); lw[q] = f2bf(f[q] - bf2f(h[q])); }
    v4u H = {h[0] | (h[1] << 16), h[2] | (h[3] << 16), h[4] | (h[5] << 16), h[6] | (h[7] << 16)}, Lw = {lw[0] | (lw[1] << 16), lw[2] | (lw[3] << 16), lw[4] | (lw[5] << 16), lw[6] | (lw[7] << 16)};
    hi = __builtin_bit_cast(bf16x8, H); lo = __builtin_bit_cast(bf16x8, Lw);
}
__device__ __forceinline__ void route_phase(const Ctx& F, const Args& args, int l, const float* h, unsigned* ctl) {
    convert_moe_weights(F, args, l);
    FULL_SYNC();
    const int tid = fresh_tid(), lane = tid & 63, w = __builtin_amdgcn_readfirstlane(tid >> 6), c16 = lane & 15, q = lane >> 4;
    LAS unsigned* lcnt = (LAS unsigned*)F.lds; LAS unsigned* lbase = lcnt + 32;
    const bf16* wr = (const bf16*)(F.ws + WS_WR) + (size_t)l * 2 * 48 * DM;
    const float* ssq = (const float*)(F.ws + WS_SSQ2) + (size_t)l * T * 16;
    unsigned* cnt = ctl + CW_CNT + 64 * l;
    unsigned* tok_list = (unsigned*)(F.ws + WS_TOKLIST); float* slot_w = (float*)(F.ws + WS_SLOTW); float* slot_r = (float*)(F.ws + WS_SLOTR); unsigned* tok_slot = (unsigned*)(F.ws + WS_TOKSLOT);
    for (int tile0 = F.bid * 8; tile0 < T / 16; tile0 += F.G * 8) {
        if (tid < 32) lcnt[tid] = 0u;
        FULL_SYNC();
        const int tok = (tile0 + w) * 16 + c16;
        f32x4 acc[3];
#pragma unroll
        for (int mt = 0; mt < 3; ++mt) acc[mt] = (f32x4){0.f, 0.f, 0.f, 0.f};
        const float* hp = h + (size_t)tok * DM + 8 * q;
#pragma unroll 2
        for (int ks = 0; ks < 32; ++ks) {
            bf16x8 bh, bl; split_hi_lo(*(const f32x4*)(hp + 32 * ks), *(const f32x4*)(hp + 32 * ks + 4), bh, bl);
#pragma unroll
            for (int mt = 0; mt < 3; ++mt) { const bf16* ap = wr + (size_t)(16 * mt + c16) * DM + 32 * ks + 8 * q;
                const bf16x8 ah = *(const bf16x8*)ap, al = *(const bf16x8*)(ap + 48 * DM);
                acc[mt] = __builtin_amdgcn_mfma_f32_16x16x32_bf16(ah, bh, acc[mt], 0, 0, 0);
                acc[mt] = __builtin_amdgcn_mfma_f32_16x16x32_bf16(ah, bl, acc[mt], 0, 0, 0);
                acc[mt] = __builtin_amdgcn_mfma_f32_16x16x32_bf16(al, bh, acc[mt], 0, 0, 0); } }
        const float rs = rsqrtf(ssq16(ssq + (size_t)tok * 16) * (1.f / DM) + EPS);
        float gl[4];
#pragma unroll
        for (int i = 0; i < 4; ++i) gl[i] = acc[2][i] * rs + args.in[I_B_RG][l * 4 + i];
        int gsel = 0; float gm = gl[0];
#pragma unroll
        for (int i = 1; i < 4; ++i) if (gl[i] > gm) { gm = gl[i]; gsel = i; }
        float gs = 0.f;
#pragma unroll
        for (int i = 0; i < 4; ++i) gs += __expf(gl[i] - gm);
        const float pg = 1.f / gs;
        const bool own = (q == gsel);
        unsigned e1 = 0, e2 = 0, lp1 = 0, lp2 = 0; float g1 = 0.f, g2 = 0.f;
        if (own) {
            float el[8];
#pragma unroll
            for (int i = 0; i < 8; ++i) el[i] = acc[i >> 2][i & 3] * rs + args.in[I_B_RE][l * 32 + q * 8 + i];
            int i1 = 0; float m1 = el[0];
#pragma unroll
            for (int i = 1; i < 8; ++i) if (el[i] > m1) { m1 = el[i]; i1 = i; }
            int i2 = -1; float m2 = -3e38f;
#pragma unroll
            for (int i = 0; i < 8; ++i) if (i != i1 && el[i] > m2) { m2 = el[i]; i2 = i; }
            const float p1 = 1.f / (1.f + __expf(m2 - m1));
            g1 = pg * p1; g2 = pg * (1.f - p1);
            e1 = (unsigned)(q * 8 + i1); e2 = (unsigned)(q * 8 + i2);
            lp1 = __hip_atomic_fetch_add(lcnt + e1, 1u, __ATOMIC_RELAXED, __HIP_MEMORY_SCOPE_WORKGROUP); lp2 = __hip_atomic_fetch_add(lcnt + e2, 1u, __ATOMIC_RELAXED, __HIP_MEMORY_SCOPE_WORKGROUP);
        }
        FULL_SYNC();
        if (tid < 32) lbase[tid] = atomicAdd(cnt + tid, lcnt[tid]);
        FULL_SYNC();
        if (own) {
            const unsigned p1 = lbase[e1] + lp1, p2 = lbase[e2] + lp2;
            tok_list[(size_t)e1 * T + p1] = (unsigned)tok; slot_w[(size_t)e1 * T + p1] = g1; slot_r[(size_t)e1 * T + p1] = rs;
            tok_list[(size_t)e2 * T + p2] = (unsigned)tok; slot_w[(size_t)e2 * T + p2] = g2; slot_r[(size_t)e2 * T + p2] = rs;
            tok_slot[(size_t)tok * 2] = (e1 << 20) | p1; tok_slot[(size_t)tok * 2 + 1] = (e2 << 20) | p2;
        }
        FULL_SYNC();
    }
}

struct MoeMap { LAS unsigned* rowtok; LAS int* ntiles; LAS int* first; LAS int* cnts; LAS unsigned char* te; };
__device__ __forceinline__ MoeMap moe_map_ptrs(const Ctx& F) {
    MoeMap m; m.rowtok = (LAS unsigned*)(F.lds + MOE_LDS); LAS int* base = (LAS int*)(F.lds + MOE_LDS + 8192);
    m.ntiles = base; m.first = base + 1; m.cnts = base + 34; m.te = (LAS unsigned char*)(base + 66); return m;
}
__device__ __forceinline__ void moe_map_build(const Ctx& F, const MoeMap& m, unsigned* cnt) {
    const int tid = fresh_tid();
    if (tid < 32) m.cnts[tid] = (int)xb_ld(cnt + tid);
    FULL_SYNC();
    if (tid == 0) { int a = 0; for (int e = 0; e < 32; ++e) { m.first[e] = a; a += (m.cnts[e] + 255) >> 8; } m.first[32] = a; *m.ntiles = a; }
    FULL_SYNC();
    if (tid < 32) { for (int t = m.first[tid]; t < m.first[tid + 1]; ++t) m.te[t] = (unsigned char)tid; }
    FULL_SYNC();
}
struct MoeGU {
    const char* hb; const char* wgu; MoeMap m; int G, c;
    __device__ __forceinline__ bool next(int i, Unit& u) const { const int L = i * G + c; if (L >= *m.ntiles * 4) return false; u.pm = L >> 2; u.pn = L & 3; u.z = m.te[u.pm]; return true; }
    __device__ __forceinline__ const char* a_base(const Unit&) const { return hb; }
    __device__ __forceinline__ const char* b_base(const Unit& u) const { return wgu + ((size_t)u.z * 1024 + u.pn * 256) * DM * 2; }
    __device__ __forceinline__ void a_voff(int i, const Unit&, int K_, unsigned (&voffA)[2][2], int tid) const {
#pragma unroll
        for (int j = 0; j < 2; ++j) { int R, C; pg8::stage_rc(tid * 16 + j * 8192, R, C);
            voffA[0][j] = (m.rowtok[i * 256 + R] * (unsigned)K_ + (unsigned)C) * 2u; voffA[1][j] = (m.rowtok[i * 256 + 128 + R] * (unsigned)K_ + (unsigned)C) * 2u; }
    }
};
struct MoeDown {
    const char* hmid; const char* wd; MoeMap m; int G, c;
    __device__ __forceinline__ bool next(int i, Unit& u) const { const int L = i * G + c; if (L >= *m.ntiles * 4) return false; u.pm = L >> 2; u.pn = L & 3; u.z = m.te[u.pm]; return true; }
    __device__ __forceinline__ const char* a_base(const Unit& u) const { return hmid + (size_t)u.pm * 256 * DEXP * 2; }
    __device__ __forceinline__ const char* b_base(const Unit& u) const { return wd + ((size_t)u.z * 1024 + u.pn * 256) * DEXP * 2; }
    __device__ __forceinline__ void a_voff(int, const Unit&, int K_, unsigned (&voffA)[2][2], int tid) const { pg8::dense_voff(K_, voffA, tid); }
};
struct EpiGateUp {
    bf16* hmid; const float* slot_r; MoeMap m;
    __device__ __forceinline__ void operator()(const f32x4 (&acc)[2][2][4][2], const Unit& u, int wr, int wc, int fr, int fq) const {
        const int e = u.z, lrow0 = (u.pm - m.first[e]) * 256 + wr * 64 + fr, col0 = u.pn * 128 + wc * 32 + 8 * fq;
#pragma unroll
        for (int ai = 0; ai < 2; ++ai)
#pragma unroll
            for (int mm = 0; mm < 4; ++mm) { const int lr = lrow0 + ai * 128 + mm * 16; const float rs = slot_r[(size_t)e * T + lr];
                const f32x4 g0 = acc[ai][0][mm][0] * rs, g1 = acc[ai][0][mm][1] * rs, u0 = acc[ai][1][mm][0] * rs, u1 = acc[ai][1][mm][1] * rs;
                v4u w; w.x = cvt_pk_bf16(siluf_(g0[0]) * u0[0], siluf_(g0[1]) * u0[1]); w.y = cvt_pk_bf16(siluf_(g0[2]) * u0[2], siluf_(g0[3]) * u0[3]);
                w.z = cvt_pk_bf16(siluf_(g1[0]) * u1[0], siluf_(g1[1]) * u1[1]); w.w = cvt_pk_bf16(siluf_(g1[2]) * u1[2], siluf_(g1[3]) * u1[3]);
                *(v4u*)(hmid + (size_t)(m.first[e] * 256 + lr) * DEXP + col0) = w; }
    }
};
struct EpiDown {
    bf16* ybuf; const float* slot_w; MoeMap m;
    __device__ __forceinline__ void operator()(const f32x4 (&acc)[2][2][4][2], const Unit& u, int wr, int wc, int fr, int fq) const {
        const int e = u.z, lrow0 = (u.pm - m.first[e]) * 256 + wr * 64 + fr, col0 = u.pn * 256 + wc * 32 + 8 * fq;
#pragma unroll
        for (int ai = 0; ai < 2; ++ai)
#pragma unroll
            for (int mm = 0; mm < 4; ++mm) { const int lr = lrow0 + ai * 128 + mm * 16; const float s = slot_w[(size_t)e * T + lr];
                bf16* rowp = ybuf + (size_t)(m.first[e] * 256 + lr) * DM + col0;
#pragma unroll
                for (int bj = 0; bj < 2; ++bj) { const f32x4 v0 = acc[ai][bj][mm][0] * s, v1 = acc[ai][bj][mm][1] * s;
                    v4u w; w.x = cvt_pk_bf16(v0[0], v0[1]); w.y = cvt_pk_bf16(v0[2], v0[3]); w.z = cvt_pk_bf16(v1[0], v1[1]); w.w = cvt_pk_bf16(v1[2], v1[3]);
                    *(v4u*)(rowp + bj * 128) = w; } }
    }
};
__device__ __forceinline__ void combine_phase(const Ctx& F, const Args& args, int l, const MoeMap& m) {
    const int tid = fresh_tid(), lane = tid & 63, w = __builtin_amdgcn_readfirstlane(tid >> 6);
    const int gw = F.bid * NWAVES + w, NGW = F.G * NWAVES;
    const unsigned* tok_slot = (const unsigned*)(F.ws + WS_TOKSLOT); const bf16* ybuf = (const bf16*)(F.ws + WS_YBUF);
    float* h = args.out; bf16* hb = (bf16*)(F.ws + WS_HB); float* ssq0 = (float*)(F.ws + WS_SSQ0) + (size_t)(l + 1) * T;
    const float* gfin = args.in[I_NORM_FINAL_G];
    for (int tok = gw; tok < T; tok += NGW) {
        const unsigned s0 = tok_slot[(size_t)tok * 2], s1 = tok_slot[(size_t)tok * 2 + 1];
        const size_t r0 = (size_t)(m.first[s0 >> 20] * 256 + (int)(s0 & 0xFFFFFu)), r1 = (size_t)(m.first[s1 >> 20] * 256 + (int)(s1 & 0xFFFFFu));
        float v[16]; float ss = 0.f;
#pragma unroll
        for (int j = 0; j < 2; ++j) { const int col = 8 * (lane + 64 * j);
            const f32x4 h0 = *(const f32x4*)(h + (size_t)tok * DM + col), h1 = *(const f32x4*)(h + (size_t)tok * DM + col + 4);
            float a[8], bb[8]; unpack8(*(const v4u*)(ybuf + r0 * DM + col), a); unpack8(*(const v4u*)(ybuf + r1 * DM + col), bb);
            const float hv[8] = {h0.x, h0.y, h0.z, h0.w, h1.x, h1.y, h1.z, h1.w};
#pragma unroll
            for (int q = 0; q < 8; ++q) { v[8 * j + q] = hv[q] + a[q] + bb[q]; ss += v[8 * j + q] * v[8 * j + q]; } }
        ss = wave_sum(ss);
        if (l == NL - 1) {
            const float rs = rsqrtf(ss * (1.f / DM) + EPS);
#pragma unroll
            for (int j = 0; j < 2; ++j) { const int col = 8 * (lane + 64 * j); const f32x4 g0 = *(const f32x4*)(gfin + col), g1 = *(const f32x4*)(gfin + col + 4);
                *(f32x4*)(h + (size_t)tok * DM + col) = (f32x4){v[8 * j] * rs * g0.x, v[8 * j + 1] * rs * g0.y, v[8 * j + 2] * rs * g0.z, v[8 * j + 3] * rs * g0.w};
                *(f32x4*)(h + (size_t)tok * DM + col + 4) = (f32x4){v[8 * j + 4] * rs * g1.x, v[8 * j + 5] * rs * g1.y, v[8 * j + 6] * rs * g1.z, v[8 * j + 7] * rs * g1.w}; }
        } else {
#pragma unroll
            for (int j = 0; j < 2; ++j) { const int col = 8 * (lane + 64 * j);
                *(f32x4*)(h + (size_t)tok * DM + col) = (f32x4){v[8 * j], v[8 * j + 1], v[8 * j + 2], v[8 * j + 3]};
                *(f32x4*)(h + (size_t)tok * DM + col + 4) = (f32x4){v[8 * j + 4], v[8 * j + 5], v[8 * j + 6], v[8 * j + 7]};
                const float f[8] = {v[8 * j], v[8 * j + 1], v[8 * j + 2], v[8 * j + 3], v[8 * j + 4], v[8 * j + 5], v[8 * j + 6], v[8 * j + 7]};
                *(v4u*)(hb + (size_t)tok * DM + col) = pack8(f); }
            if (lane == 0) ssq0[tok] = ss;
        }
    }
}

__device__ __forceinline__ void final_norm_rows(const Ctx& F, const float* h, const float* g, float* out) {
    const int gw = F.vcu * NWAVES + F.wave, NGW = F.G * NWAVES, lane = F.lane;
    for (int m = gw; m < T; m += NGW) {
        const f32x4* xr = (const f32x4*)(h + (size_t)m * DM) + lane; const f32x4* gr = (const f32x4*)g + lane; float s = 0.f; f32x4 v[4];
#pragma unroll
        for (int j = 0; j < 4; ++j) { v[j] = xr[64 * j]; s += v[j].x * v[j].x + v[j].y * v[j].y + v[j].z * v[j].z + v[j].w * v[j].w; }
        const float rs = rsqrtf(wave_sum(s) * (1.f / DM) + EPS);
        f32x4* orow = (f32x4*)(out + (size_t)m * DM) + lane;
#pragma unroll
        for (int j = 0; j < 4; ++j) orow[64 * j] = v[j] * rs * gr[64 * j];
    }
}


#if DEBUG_STAGE == 7
#define GRID_BAR() do { ++bar_epoch; if (threadIdx.x == 0) ((unsigned*)(F.ws + WS_HIST + 2 * MiB))[F.bid * 64] = bar_epoch; xcd_barrier(bar); \
    if (threadIdx.x < (unsigned)F.G) { const unsigned* sl = (const unsigned*)(F.ws + WS_HIST + 2 * MiB) + threadIdx.x * 64; const unsigned a = *sl; const unsigned b_ = __hip_atomic_load(sl, __ATOMIC_RELAXED, __HIP_MEMORY_SCOPE_SYSTEM); \
        if (a != bar_epoch) atomicAdd(ctl + CW_DIAG + 4, 1u); if (b_ != bar_epoch) atomicAdd(ctl + CW_DIAG + 5, 1u); } xcd_barrier(bar); } while (0)
#else
#define GRID_BAR() xcd_barrier(bar)
#endif
#if STOP_AFTER < 999
#define STAGE_END() do { GRID_BAR(); if (++nstage == STOP_AFTER) return true; } while (0)
#else
#define STAGE_END() GRID_BAR()
#endif
template <int LAYER>
__device__ __forceinline__ bool layer_body(Ctx& F, const Args& args, unsigned* ctl, const XcdBarrier& bar, int& nstage, unsigned& bar_epoch) {
    constexpr int l = LAYER;
        {
            pg8::DenseOrder S; S.init(F.ws + WS_HB, F.ws + WS_WIN + (size_t)l * 3072 * DM * 2, T, 3072, DM, F.G, F.bid);
            EpiProj E{(bf16*)(F.ws + WS_PROJ), (float*)(F.ws + WS_DT), (const float*)(F.ws + WS_SSQ0) + (size_t)l * T};
            pg8::gemm_phase<EpiProj, pg8::DenseOrder, false>(F.lds, DM, S, E);
        }
        STAGE_END();
#if DEBUG_STAGE == 3
        dbg_checksum(F, ctl, l == 0 ? 1 : 11, F.ws + WS_PROJ, (size_t)T * PROJ_LD * 2); GRID_BAR();
#endif
#if DEBUG_STAGE == 8
        { unsigned nd = 0; const unsigned* pr = (const unsigned*)(F.ws + WS_PROJ);
          for (int unit = F.bid; unit < NUNIT; unit += F.G) { const size_t w0 = (size_t)unit * 128 * PROJ_LD / 2;
            for (size_t i = threadIdx.x; i < (size_t)128 * PROJ_LD / 2; i += NTHREADS) { const unsigned a = pr[w0 + i]; const unsigned b_ = __hip_atomic_load(pr + w0 + i, __ATOMIC_RELAXED, __HIP_MEMORY_SCOPE_SYSTEM); if (a != b_) ++nd; } }
          if (nd) atomicAdd(ctl + CW_DIAG + 6 + l, nd); }
#endif
        mixer_states(F, args, l);
        STAGE_END();
#if DEBUG_STAGE == 9
        if (l == 0) { unsigned bad = 0; for (int unit = F.bid; unit < NUNIT; unit += F.G) bad += s5_chunk_states(F, l, unit, true); __syncthreads(); if (bad) atomicAdd(ctl + CW_DIAG + 6, bad); GRID_BAR(); }
#endif
#if DEBUG_STAGE == 6
        {
            unsigned nd = 0;
            { const unsigned* cur = (const unsigned*)(F.ws + WS_S5ST);
              for (size_t i = (size_t)F.bid * NTHREADS + threadIdx.x; i < (2 * MiB) / 4; i += (size_t)F.G * NTHREADS) { const unsigned a = cur[i]; const unsigned b = __hip_atomic_load(cur + i, __ATOMIC_RELAXED, __HIP_MEMORY_SCOPE_SYSTEM); if (a != b) ++nd; } }
            if (nd) atomicAdd(ctl + CW_DIAG, nd);
        }
#endif
#if DEBUG_STAGE == 5
        if (l == 0) {
            unsigned nd = 0;
            { const unsigned* cur = (const unsigned*)(F.ws + WS_S5ST);
              for (size_t i = (size_t)F.bid * NTHREADS + threadIdx.x; i < (2 * MiB) / 4; i += (size_t)F.G * NTHREADS) { const unsigned a = cur[i]; const unsigned b = __hip_atomic_load(cur + i, __ATOMIC_RELAXED, __HIP_MEMORY_SCOPE_SYSTEM); if (a != b) ++nd; } }
            if (nd) atomicAdd(ctl + CW_DIAG, nd);
            return true;
        }
#endif
#if DEBUG_STAGE == 4
        if (l == 0) {
            return true;
        }
#endif
#if DEBUG_STAGE == 3
        if (l == 0) { dbg_checksum(F, ctl, 2, F.ws + WS_S5TAB, (size_t)512 * 1024); dbg_checksum(F, ctl, 3, F.ws + WS_RETST, (size_t)16 * MiB); dbg_checksum(F, ctl, 4, F.ws + WS_SSDST, (size_t)32 * MiB); dbg_checksum(F, ctl, 5, F.ws + WS_S5ST, (size_t)2 * MiB);
            { const unsigned* cur = (const unsigned*)(F.ws + WS_S5ST); unsigned* prev = (unsigned*)(F.ws + WS_HIST + MiB); const unsigned* hist = (const unsigned*)(F.ws + WS_HIST); const bool have = hist[0] == 0x5EEDC0DEu; unsigned nd = 0, ndw = 0;
              for (size_t i = (size_t)F.bid * NTHREADS + threadIdx.x; i < (2 * MiB) / 4; i += (size_t)F.G * NTHREADS) { const unsigned c = cur[i]; if (have && prev[i] != c) { ++nd; const float a = __uint_as_float(c), b = __uint_as_float(prev[i]); if (fabsf(a - b) > 1e-3f * (fabsf(a) + fabsf(b)) + 1e-5f) ++ndw; } prev[i] = c; }
              if (nd) atomicAdd(ctl + CW_DIAG + 2, nd); if (ndw) atomicAdd(ctl + CW_DIAG + 3, ndw); } } GRID_BAR();
#endif
        mixer_scan(F, args, l);
        STAGE_END();
#if DEBUG_STAGE == 3
        if (l == 0) { dbg_checksum(F, ctl, 6, F.ws + WS_SSDST, (size_t)32 * MiB); dbg_checksum(F, ctl, 7, F.ws + WS_S5ST, (size_t)2 * MiB); } GRID_BAR();
#endif
        mixer_outputs(F, args, l);
        STAGE_END();
#if DEBUG_STAGE == 3
        if (l == 0) { dbg_checksum_cols(F, ctl, 8, F.ws + WS_CAT, 0, 256); dbg_checksum_cols(F, ctl, 9, F.ws + WS_CAT, 256, 768); dbg_checksum_cols(F, ctl, 10, F.ws + WS_CAT, 768, 1024); } GRID_BAR();
#endif
        {
            pg8::DenseOrder S; S.init(F.ws + WS_CAT, F.ws + WS_WOUT + (size_t)l * DM * DM * 2, T, DM, DM, F.G, F.bid);
            EpiResid E{l == 0 ? args.in[I_X] : args.out, args.out, (bf16*)(F.ws + WS_HB), (float*)(F.ws + WS_SSQ1) + (size_t)l * T * 16};
            pg8::gemm_phase<EpiResid, pg8::DenseOrder, false>(F.lds, DM, S, E);
        }
        STAGE_END();
#if DEBUG_STAGE == 3
        dbg_checksum(F, ctl, 10 * l + 13, args.out, (size_t)T * DM * 4); GRID_BAR();
#endif
        {
            pg8::DenseOrder S; S.init(F.ws + WS_HB, F.ws + WS_WQ + (size_t)l * DM * DM * 2, T, DM, DM, F.G, F.bid);
            EpiBf16Scaled E{(bf16*)(F.ws + WS_Q), DM, (const float*)(F.ws + WS_SSQ1) + (size_t)l * T * 16, 0.0625f * 1.44269504f};
            pg8::gemm_phase<EpiBf16Scaled, pg8::DenseOrder, false>(F.lds, DM, S, E);
        }
        STAGE_END();
#if DEBUG_STAGE == 3
        dbg_checksum(F, ctl, 10 * l + 14, F.ws + WS_Q, (size_t)T * DM * 2); GRID_BAR();
#endif
        attn_phase(F, l);
        STAGE_END();
#if DEBUG_STAGE == 3
        dbg_checksum(F, ctl, 10 * l + 15, F.ws + WS_Q, (size_t)T * DM * 2); GRID_BAR();
#endif
        {
            pg8::DenseOrder S; S.init(F.ws + WS_Q, F.ws + WS_WO + (size_t)l * DM * DM * 2, T, DM, DM, F.G, F.bid);
            EpiResid E{args.out, args.out, (bf16*)(F.ws + WS_HB), (float*)(F.ws + WS_SSQ2) + (size_t)l * T * 16};
            pg8::gemm_phase<EpiResid, pg8::DenseOrder, false>(F.lds, DM, S, E);
        }
        STAGE_END();
#if DEBUG_STAGE == 3
        dbg_checksum(F, ctl, 10 * l + 16, args.out, (size_t)T * DM * 4); GRID_BAR();
#endif
        route_phase(F, args, l, args.out, ctl);
        STAGE_END();
#if DEBUG_STAGE == 3
        dbg_checksum_route(F, ctl, 10 * l + 17); GRID_BAR();
#endif
        const MoeMap mm = moe_map_ptrs(F);
        moe_map_build(F, mm, ctl + CW_CNT + 64 * l);
        {
            const int tid = fresh_tid(); const unsigned* tok_list = (const unsigned*)(F.ws + WS_TOKLIST);
            for (int i = 0; i < 8; ++i) { const int L = i * F.G + F.vcu; if (L >= *mm.ntiles * 4) break;
                const int rt = L >> 2, e = mm.te[rt], lt = rt - mm.first[e];
                if (tid < 256) { const int pos = lt * 256 + tid; mm.rowtok[i * 256 + tid] = pos < mm.cnts[e] ? tok_list[(size_t)e * T + pos] : 0u; } }
            __syncthreads();
            MoeGU S{(const char*)(F.ws + WS_HB), (const char*)(F.ws + WS_WGU), mm, F.G, F.vcu};
            EpiGateUp E{(bf16*)(F.ws + WS_HMID), (const float*)(F.ws + WS_SLOTR), mm};
            pg8::gemm_phase<EpiGateUp, MoeGU, true>(F.lds, DM, S, E);
        }
        STAGE_END();
        {
            MoeDown S{(const char*)(F.ws + WS_HMID), (const char*)(F.ws + WS_WD), mm, F.G, F.vcu};
            EpiDown E{(bf16*)(F.ws + WS_YBUF), (const float*)(F.ws + WS_SLOTW), mm};
            pg8::gemm_phase<EpiDown, MoeDown, false>(F.lds, DEXP, S, E);
        }
        STAGE_END();
        combine_phase(F, args, l, mm);
#if DEBUG_STAGE == 3
        GRID_BAR(); dbg_checksum(F, ctl, 10 * l + 19, args.out, (size_t)T * DM * 4);
#endif
        if (l + 1 < NL) STAGE_END();
    return false;
}

__global__ void __launch_bounds__(NTHREADS, 2) mega_fwd(Args args) {
    extern __shared__ __attribute__((aligned(16))) unsigned char lds_raw[];
    Ctx F;
    F.lds = (LAS unsigned char*)lds_raw; F.ws = args.ws;
    F.tid = threadIdx.x; F.lane = F.tid & 63; F.wave = __builtin_amdgcn_readfirstlane(F.tid >> 6);
    F.G = gridDim.x; F.bid = blockIdx.x; F.vcu = (F.G % 8 == 0) ? (F.bid % 8) * (F.G / 8) + F.bid / 8 : F.bid;
    volatile LAS unsigned* MISC = (volatile LAS unsigned*)(F.lds + MISC_OFF);
    unsigned* ctl = (unsigned*)(args.ws + WS_CTL);
    for (int u = F.tid; u < (LDS_BYTES - LDSCTL_OFF) / 4; u += NTHREADS) ((LAS unsigned*)(F.lds + LDSCTL_OFF))[u] = 0u;
    __syncthreads();
    XcdBarrier bar = xcd_barrier_post(ctl + CW_BAR, MISC + 8);
    unsigned bar_epoch = 0; (void)bar_epoch;

    p0_small_weights(F, args);
    p0_misc(F, args);
#if DEBUG_STAGE == 3
    { unsigned* z = (unsigned*)(args.ws + WS_S5ST); for (size_t i = (size_t)F.bid * NTHREADS + threadIdx.x; i < (2 * MiB) / 4; i += (size_t)F.G * NTHREADS) z[i] = 0x3F800000u; }
#endif
    GRID_BAR();

    {
        KvOrder S{(const char*)F.ws, F.G, F.bid}; EpiKV E{F.ws};
        pg8::gemm_phase<EpiKV, KvOrder, false>(F.lds, DM, S, E);
    }
    int nstage = 0; (void)nstage;
    if (layer_body<0>(F, args, ctl, bar, nstage, bar_epoch) || layer_body<1>(F, args, ctl, bar, nstage, bar_epoch)) {
        final_norm_rows(F, nstage < 5 ? args.in[I_X] : args.out, args.in[I_NORM_FINAL_G], args.out);
#if DEBUG_STAGE == 4 || DEBUG_STAGE == 5
        xcd_barrier(bar);
        if (F.bid == 0 && threadIdx.x == 0) args.out[0] = 1000.f + (float)xb_ld(ctl + CW_DIAG);
        if (F.bid == 0) { const float W = 100.f + (float)xb_ld(ctl + CW_DIAG + 1) * (1.f / 400.f); for (int i = (1 << 20) + (int)threadIdx.x; i < (2 << 20); i += NTHREADS) args.out[i] = W; }
#endif
    }

#if DEBUG_STAGE == 9
    xcd_barrier(bar);
    { const unsigned* cur = (const unsigned*)(args.ws + WS_S5ST); unsigned* sv = (unsigned*)(args.ws + WS_HIST + MiB);
      for (size_t i = (size_t)F.bid * NTHREADS + threadIdx.x; i < (2 * MiB) / 4; i += (size_t)F.G * NTHREADS) sv[i] = cur[i]; }
#endif
#if DEBUG_STAGE == 8 || DEBUG_STAGE == 9
    xcd_barrier(bar);
    if (F.bid == 0 && threadIdx.x == 0) {
        unsigned* hist = (unsigned*)(args.ws + WS_HIST);
        unsigned c0 = 0, c1 = 0; if (hist[0] == 0x5EEDC0DEu) { c0 = hist[104]; c1 = hist[105]; }
        c0 += xb_ld(ctl + CW_DIAG + 6); c1 += xb_ld(ctl + CW_DIAG + 7);
        hist[104] = c0; hist[105] = c1; hist[0] = 0x5EEDC0DEu;
#if DEBUG_STAGE == 9
        if (c0) { const unsigned nm = c0 & 0xFFFFu, no = c0 >> 16; args.out[0] = (no * 2 >= nm) ? 6000.f : (no > 0 ? 4000.f : 2000.f); }
#else
        if (c0 | c1) args.out[0] = (c1 ? 4000.f : 0.f) + (c0 ? 2000.f : 0.f);
#endif
    }
#endif
#if DEBUG_STAGE == 7
    xcd_barrier(bar);
    if (F.bid == 0 && threadIdx.x == 0) {
        unsigned* hist = (unsigned*)(args.ws + WS_HIST);
        unsigned c4 = 0, c5 = 0, ct = 0; if (hist[0] == 0x5EEDC0DEu) { c4 = hist[104]; c5 = hist[105]; ct = hist[106]; }
        c4 += xb_ld(ctl + CW_DIAG + 4); c5 += xb_ld(ctl + CW_DIAG + 5); ct += xb_ld(ctl + CW_BAR + XB_TMO);
        hist[104] = c4; hist[105] = c5; hist[106] = ct; hist[0] = 0x5EEDC0DEu;
        if (c4 | c5 | ct) args.out[0] = (ct ? 8000.f : 0.f) + (c5 ? 4000.f : 0.f) + (c4 ? 2000.f : 0.f);
    }
#endif
#if DEBUG_STAGE == 6
    xcd_barrier(bar);
    if (F.bid == 0 && threadIdx.x == 0) {
        unsigned* hist = (unsigned*)(args.ws + WS_HIST);
        unsigned cnt = (hist[0] == 0x5EEDC0DEu) ? hist[101] : 0u;
        cnt += xb_ld(ctl + CW_DIAG);
        hist[101] = cnt; hist[0] = 0x5EEDC0DEu;
        if (cnt) args.out[0] = 500.f * (1.f + log2f((float)cnt + 1.f));
    }
#endif
#if DEBUG_STAGE == 3
    xcd_barrier(bar);
    if (F.bid == 0 && threadIdx.x == 0) {
        unsigned* hist = (unsigned*)(args.ws + WS_HIST);
        unsigned sticky = 0;
        if (hist[0] == 0x5EEDC0DEu) { sticky = hist[100];
            if (sticky == 0) { for (int k = 1; k < 30; ++k) if (hist[k] != xb_ld(ctl + CW_CK + k)) { sticky = (unsigned)k; break; } } }
        for (int k = 1; k < 30; ++k) hist[k] = xb_ld(ctl + CW_CK + k);
        hist[100] = sticky; hist[0] = 0x5EEDC0DEu;
        unsigned nd = hist[101], ndw = hist[102];
        if (nd == 0 || nd == 0xAAAAAAAAu) { nd = xb_ld(ctl + CW_DIAG + 2); ndw = xb_ld(ctl + CW_DIAG + 3); }
        hist[101] = nd; hist[102] = ndw;
        if (sticky) args.out[0] = 1000.f * (float)sticky;
    }
#endif
    return;
#if DEBUG_STAGE == 1
    {
        const float* x = args.in[I_X]; const float* g = args.in[I_NORM_MIX_G]; const float* w = args.in[I_W_IN];
        const bf16* P = (const bf16*)(F.ws + WS_PROJ); const float* dtb = (const float*)(F.ws + WS_DT);
        float emax = 0.f, rmax = 0.f;
        for (int idx = F.bid * NTHREADS + F.tid; idx < 64 * IN_COLS; idx += F.G * NTHREADS) {
            const int rs = idx / IN_COLS, col = idx % IN_COLS; const int row = (rs * 509 + 17) % T;
            float ss = 0.f, acc = 0.f;
            for (int k = 0; k < DM; ++k) { const float xv = x[(size_t)row * DM + k]; ss += xv * xv; acc += xv * g[k] * w[(size_t)k * IN_COLS + col]; }
            const float ref = acc * rsqrtf(ss / DM + EPS);
            float got;
            if (col < 2560) got = bf2f(P[(size_t)row * PROJ_LD + col]); else if (col < 2568) got = dtb[(size_t)row * 8 + (col - 2560)]; else got = bf2f(P[(size_t)row * PROJ_LD + 2560 + (col - 2568)]);
            emax = fmaxf(emax, fabsf(got - ref)); rmax = fmaxf(rmax, fabsf(ref));
        }
        dbg_max(ctl, CW_DBGA, emax); dbg_max(ctl, CW_DBGB, rmax);
    }
    GRID_BAR();
    final_norm_rows(F, args.in[I_X], args.in[I_NORM_FINAL_G], args.out);
    GRID_BAR();
    dbg_emit(F, ctl, args.out);
    return;
#endif
    final_norm_rows(F, args.in[I_X], args.in[I_NORM_FINAL_G], args.out);
}

extern "C" void kernel_launch(void* const* d_in, const int* in_sizes, int n_in, void* d_out, int out_size, void* d_ws, size_t ws_size, hipStream_t stream) {
    static int grid = 0;
    if (grid == 0) {
        int dev = 0, cus = 0, per_cu = 0;
        if (n_in != 37 || out_size != T * DM || ws_size < WS_END) { fprintf(stderr, "kernel_launch: unexpected problem (n_in %d out %d ws %zu)\n", n_in, out_size, ws_size); grid = -1; return; }
        if (hipGetDevice(&dev) != hipSuccess || hipDeviceGetAttribute(&cus, hipDeviceAttributeMultiprocessorCount, dev) != hipSuccess) { fprintf(stderr, "kernel_launch: device query failed\n"); grid = -1; return; }
        if (hipFuncSetAttribute((const void*)mega_fwd, hipFuncAttributeMaxDynamicSharedMemorySize, LDS_BYTES) != hipSuccess) { fprintf(stderr, "kernel_launch: hipFuncSetAttribute failed\n"); grid = -1; return; }
        if (hipOccupancyMaxActiveBlocksPerMultiprocessor(&per_cu, (const void*)mega_fwd, NTHREADS, LDS_BYTES) != hipSuccess || per_cu < 1) { fprintf(stderr, "kernel_launch: occupancy query reports %d\n", per_cu); per_cu = 1; }
        (void)hipGetLastError();
        grid = cus;
    }
    if (grid < 0) return;
    if (hipMemsetAsync((char*)d_ws + WS_CTL, 0, CTL_ZERO_BYTES, stream) != hipSuccess) { fprintf(stderr, "kernel_launch: memset failed\n"); return; }
    Args a{};
    for (int i = 0; i < 37; ++i) a.in[i] = (const float*)d_in[i];
    a.out = (float*)d_out; a.ws = (unsigned char*)d_ws; a.ws_size = (unsigned long long)ws_size;
    void* kargs[] = {&a};
    hipError_t e = hipLaunchCooperativeKernel((const void*)mega_fwd, dim3(grid), dim3(NTHREADS), kargs, LDS_BYTES, stream);
    if (e != hipSuccess) fprintf(stderr, "kernel_launch: cooperative launch failed: %s (grid %d)\n", hipGetErrorString(e), grid);
}
```

```cpp
#include <hip/hip_runtime.h>
#include <cstdio>
#include <cstdint>

#define GAS __attribute__((address_space(1)))
#define LAS __attribute__((address_space(3)))
typedef unsigned short bf16;
typedef unsigned v4u __attribute__((ext_vector_type(4)));
typedef unsigned v2u __attribute__((ext_vector_type(2)));
typedef float f32x4 __attribute__((ext_vector_type(4)));
typedef float f32x2 __attribute__((ext_vector_type(2)));
typedef float f32x16 __attribute__((ext_vector_type(16)));
typedef short bf16x8 __attribute__((ext_vector_type(8)));
typedef short bf16x4 __attribute__((ext_vector_type(4)));

#ifndef PROBE_N
#define PROBE_N 1536
#endif
#ifndef REPEAT_MASK
#define REPEAT_MASK 0
#endif
#ifndef TS_A0
#define TS_A0 0
#define TS_A1 1
#define TS_B0 1
#define TS_B1 2
#endif
#ifndef BAR_SCOPE
#define BAR_SCOPE "agent"
#endif
#ifndef DBG_WHICH
#define DBG_WHICH 0
#endif
#ifndef STOP_AFTER
#define STOP_AFTER 999
#endif

constexpr int NWAVES = 8, NTHREADS = NWAVES * 64;
constexpr int BATCH = 8, SEQ = 4096, DM = 1024, T = BATCH * SEQ, NL = 2;
constexpr int MEMLEN = 256, TM = BATCH * MEMLEN;
constexpr int NCHUNK = SEQ / 128, NUNIT = BATCH * NCHUNK;
constexpr float EPS = 1e-6f;
constexpr int IN_COLS = 2824;
constexpr int PROJ_LD = 2816;
constexpr int COL_Q = 0, COL_K = 256, COL_V = 512, COL_G = 768, COL_Z = 1024, COL_X = 1536, COL_B = 2048, COL_C = 2304, COL_U = 2560;
constexpr int NEXP = 32, DEXP = 512;
constexpr int NSLOT = 2 * T + NEXP * 256;

constexpr size_t MiB = 1u << 20;
constexpr size_t WS_CTL = 0, CTL_ZERO_BYTES = 256 * 1024;
constexpr int CW_DIAG = 64;
constexpr int CW_CNT = 1024;
constexpr int CW_BAR = 4096;
constexpr int CW_JCNT = 8192;
constexpr size_t WS_SSQ0 = 2 * MiB;
constexpr size_t WS_ROPE = 3 * MiB;
constexpr size_t WS_S5TAB = 4 * MiB;
constexpr size_t S5TAB_LAYER = 256 * 1024, S5TAB_BBAR = 16 * 1024, S5TAB_CT = 80 * 1024;
constexpr size_t WS_DT = 5 * MiB;
constexpr size_t WS_WR = 6 * MiB;
constexpr size_t WS_WGLU = 7 * MiB;
constexpr size_t WS_WIN = 8 * MiB;
constexpr size_t WS_WOUT = 20 * MiB, WS_WQ = 24 * MiB, WS_WK = 28 * MiB, WS_WV = 32 * MiB, WS_WO = 36 * MiB;
constexpr size_t WS_MN = 40 * MiB;
constexpr size_t WS_KB = 44 * MiB;
constexpr size_t WS_VT = 52 * MiB;
constexpr size_t WS_TOKLIST = 60 * MiB;
constexpr size_t WS_SLOTW = 64 * MiB;
constexpr size_t WS_SLOTR = 68 * MiB;
constexpr size_t WS_TOKSLOT = 72 * MiB;
constexpr size_t WS_SSDDEC = 73 * MiB;
constexpr size_t WS_WGU = 76 * MiB;
constexpr size_t WS_WD = 140 * MiB;
constexpr size_t WS_HB = 172 * MiB;
constexpr size_t WS_SCR = 236 * MiB;
constexpr size_t WS_PROJ = WS_SCR;
constexpr size_t WS_RETST = WS_SCR + 192 * MiB;
constexpr size_t WS_SSDST = WS_SCR + 208 * MiB;
constexpr size_t WS_S5ST = WS_SCR + 240 * MiB;
constexpr size_t WS_CAT = WS_SCR + 242 * MiB;
constexpr size_t WS_Q = WS_SCR;
constexpr size_t WS_HMID = WS_SCR;
constexpr size_t WS_YBUF = WS_SCR + 72 * MiB;
constexpr size_t WS_SSQ1 = WS_SCR + 308 * MiB;
constexpr size_t WS_SSQ2 = WS_SCR + 312 * MiB;
constexpr size_t WS_END = WS_SCR + 321 * MiB;
static_assert(WS_END <= 576 * MiB, "workspace");
static_assert((size_t)NSLOT * 512 * 2 <= 72 * MiB && (size_t)NSLOT * 1024 * 2 <= 144 * MiB, "moe buffers");

constexpr int RING_BYTES = 131072;
constexpr int RSTD_LDS = 131072;
constexpr int MOE_LDS = 131072;
constexpr int SCRATCH_BYTES = 151552;
constexpr int LDSCTL_OFF = SCRATCH_BYTES, MISC_OFF = LDSCTL_OFF + 320;
constexpr int LDS_BYTES = 155648;

#define FULL_SYNC() __syncthreads()
#define LDS_WAIT() asm volatile("s_waitcnt lgkmcnt(0)" ::: "memory")
#define VM_WAIT() asm volatile("s_waitcnt vmcnt(0)" ::: "memory")
typedef __bf16 bf16x2_t __attribute__((ext_vector_type(2)));
__device__ __forceinline__ unsigned pk2(float lo, float hi) { const f32x2 v = {lo, hi}; const bf16x2_t b = __builtin_convertvector(v, bf16x2_t); return __builtin_bit_cast(unsigned, b); }
__device__ __forceinline__ unsigned f2bf(float f) { return pk2(f, f) & 0xffffu; }
__device__ __forceinline__ float bf2f(unsigned b) { return __builtin_bit_cast(float, b << 16); }
__device__ __forceinline__ float bflo(unsigned w) { return __builtin_bit_cast(float, w << 16); }
__device__ __forceinline__ float bfhi(unsigned w) { return __builtin_bit_cast(float, w & 0xffff0000u); }
__device__ __forceinline__ float wave_sum(float v) {
#pragma unroll
    for (int o = 1; o < 64; o <<= 1) v += __shfl_xor(v, o);
    return v;
}
__device__ __forceinline__ float sigmoidf_(float x) { return __builtin_amdgcn_rcpf(1.f + __expf(-x)); }
__device__ __forceinline__ float siluf_(float x) { return x * __builtin_amdgcn_rcpf(1.f + __expf(-x)); }
__device__ __forceinline__ float softplusf_(float x) { return x > 20.f ? x : log1pf(__expf(x)); }
__device__ __forceinline__ float gelu_tanh(float x) { const float u = 0.7978845608f * (x + 0.044715f * x * x * x); const float t = 1.f - 2.f * __builtin_amdgcn_rcpf(__expf(2.f * u) + 1.f); return 0.5f * x * (1.f + t); }
__device__ __forceinline__ f32x16 zero16() { f32x16 z;
#pragma unroll
    for (int i = 0; i < 16; ++i) z[i] = 0.f; return z; }
#define MFMA32(a, b, c) __builtin_amdgcn_mfma_f32_32x32x16_bf16((a), (b), (c), 0, 0, 0)
#define MFMA_SETTLE() do { __builtin_amdgcn_sched_barrier(0); asm volatile("s_nop 15\n\ts_nop 15"); __builtin_amdgcn_sched_barrier(0); } while (0)

__device__ __forceinline__ int fresh_tid() { int t = threadIdx.x; asm volatile("" : "+v"(t)); return t; }

#define XB_TMO      128
#define XB_XCNT(j)  (256  + 64 * (j))
#define XB_XSUB(j)  (1280 + 64 * (j))
#define XB_XGEN(j)  (2304 + 64 * (j))
#define XB_TOP      3328
#define XB_TOPGEN   3392
#define XCD_BAR_WORDS 3456
#define XB_SPIN_CAP (1u << 18)
__device__ __forceinline__ unsigned xb_ld(unsigned* p)              { return __hip_atomic_load(p, __ATOMIC_RELAXED, __HIP_MEMORY_SCOPE_AGENT); }
__device__ __forceinline__ unsigned xb_add(unsigned* p, unsigned v) { return __hip_atomic_fetch_add(p, v, __ATOMIC_RELAXED, __HIP_MEMORY_SCOPE_AGENT); }
__device__ __forceinline__ unsigned xb_xcc_id() { return (unsigned)__builtin_amdgcn_s_getreg((3 << 11) | 20) & 0xFu; }
#define XB_SPIN(cond, bar) do { unsigned _sp = 0; while (cond) { __builtin_amdgcn_s_sleep(1); \
    if ((++_sp & 255u) == 0u) { if (xb_ld(&(bar)[XB_TMO])) break; if (_sp > XB_SPIN_CAP) { atomicAdd(&(bar)[XB_TMO], 1u); break; } } } } while (0)
struct XcdBarrier { unsigned* bar; unsigned x; volatile LAS unsigned* st; };
__device__ __forceinline__ XcdBarrier xcd_barrier_post(unsigned* bar, volatile LAS unsigned* st) {
    XcdBarrier b; b.bar = bar; b.x = xb_xcc_id(); b.st = st;
    if (threadIdx.x == 0) (void)xb_add(&bar[XB_XCNT(b.x)], 1u);
    return b;
}
__device__ __forceinline__ void xcd_barrier_complete(unsigned* bar, unsigned x, unsigned& nloc, unsigned& nx) {
    const unsigned G = gridDim.x * gridDim.y * gridDim.z;
    unsigned sum, cnt, mine, sp = 0u;
    for (;;) {
        sum = 0u; cnt = 0u; mine = 0u;
#pragma unroll
        for (unsigned j = 0; j < 16; ++j) { const unsigned c = xb_ld(&bar[XB_XCNT(j)]); sum += c; cnt += (c > 0u) ? 1u : 0u; mine = (j == x) ? c : mine; }
        if (sum == G) break;
        __builtin_amdgcn_s_sleep(1);
        if ((++sp & 255u) == 0u) { if (xb_ld(&bar[XB_TMO])) break; if (sp > XB_SPIN_CAP) { atomicAdd(&bar[XB_TMO], 1u); break; } }
    }
    nloc = mine > 0u ? mine : 1u; nx = cnt > 0u ? cnt : 1u;
}
__device__ __forceinline__ void xcd_barrier(const XcdBarrier& b) {
    asm volatile("s_waitcnt vmcnt(0)" ::: "memory");
    __syncthreads();
    if (threadIdx.x == 0) {
        unsigned* bar = b.bar;
        __builtin_amdgcn_s_waitcnt(0);
        unsigned nloc = b.st[0], nx = b.st[1];
        if (nloc == 0u) { xcd_barrier_complete(bar, b.x, nloc, nx); b.st[0] = nloc; b.st[1] = nx; }
        const unsigned old = xb_add(&bar[XB_XSUB(b.x)], 1u);
        const unsigned gen = old / nloc;
        if (old + 1u == (gen + 1u) * nloc) {
            __builtin_amdgcn_fence(__ATOMIC_RELEASE, BAR_SCOPE);
            asm volatile("s_waitcnt vmcnt(0)" ::: "memory");
            const unsigned og = xb_add(&bar[XB_TOP], 1u);
            const unsigned tg = og / nx;
            if (og + 1u == (tg + 1u) * nx) xb_add(&bar[XB_TOPGEN], 1u);
            else XB_SPIN(xb_ld(&bar[XB_TOPGEN]) == tg, bar);
            __builtin_amdgcn_fence(__ATOMIC_ACQUIRE, BAR_SCOPE);
            xb_add(&bar[XB_XGEN(b.x)], 1u);
            asm volatile("s_waitcnt vmcnt(0)" ::: "memory");
        } else {
            XB_SPIN(xb_ld(&bar[XB_XGEN(b.x)]) == gen, bar);
            __builtin_amdgcn_fence(__ATOMIC_ACQUIRE, BAR_SCOPE);
            asm volatile("s_waitcnt vmcnt(0)" ::: "memory");
        }
    }
    __syncthreads();
}

namespace pg8 {
constexpr int BM = 256, BK = 64, HALF = 128, HTB = HALF * BK * 2, STAGE_BYTES = 8 * HTB, NXCD = 8, WGM = 8;
__host__ __device__ __forceinline__ int lds_byte(int r, int c) { const int st = (r >> 4) * 2 + (c >> 5), rr = r & 15, cc = c & 31, ob = rr * 64 + cc * 2; return st * 1024 + (ob ^ (((ob >> 9) & 1) << 5)); }
__host__ __device__ __forceinline__ void stage_rc(int b, int& R, int& C) { const int st = b / 1024, sb = b % 1024, swz = sb ^ (((sb >> 9) & 1) << 5); R = (st >> 1) * 16 + swz / 64; C = (st & 1) * 32 + (swz % 64) / 2; }
__host__ __device__ __forceinline__ int perm32(int rho) { const int n = rho >> 4, i = rho & 15; return 8 * (i >> 2) + 4 * n + (i & 3); }
struct Unit { int pm, pn, z; };
__device__ __forceinline__ unsigned cvt_pk_bf16(float lo, float hi) { return pk2(lo, hi); }

template <class Epi, class Sched, bool GATHER>
__device__ __forceinline__ void gemm_phase(LAS unsigned char* lds, const int K, const Sched& S, const Epi& E) {
    const int tid = fresh_tid(), wid = __builtin_amdgcn_readfirstlane(tid >> 6), lane = tid & 63, wr = wid >> 2, wc = wid & 3, fr = lane & 15, fq = lane >> 4;
    const int nt = K / BK;
    unsigned voffA[2][2], voffB[2];
#pragma unroll
    for (int i = 0; i < 2; ++i) { int R, C; stage_rc(tid * 16 + i * 8192, R, C); const int Rb = (R & ~31) + perm32(R & 31); voffB[i] = (unsigned)(Rb * K + C) * 2u; }
    const size_t kstep = (size_t)(BK * 2);
    const size_t hstep = (size_t)HALF * K * 2;
    const unsigned ldsw = (unsigned)wid * 1024u;
    const int aoff = lds_byte(wr * 64 + fr, fq * 8), boff = lds_byte(wc * 32 + fr, fq * 8);
#define PG8_SA(b, h) (((b) * 2 + (h)) * HTB)
#define PG8_SB(b, h) ((4 + (b) * 2 + (h)) * HTB)
#define PG8_STAGE(bufoff, gbase, voff) do { _Pragma("unroll") for (int _i = 0; _i < 2; ++_i) \
        __builtin_amdgcn_global_load_lds((const unsigned*)((const char*)(gbase) + (voff)[_i]), (LAS unsigned*)(lds + (bufoff) + ldsw + _i * 8192), 16, 0, 0); } while (0)
#define PG8_STAGE_A(bufoff, gbase, voff) do { _Pragma("unroll") for (int _i = 0; _i < 2; ++_i) \
        __builtin_amdgcn_global_load_lds((const unsigned*)((const char*)(gbase) + (voff)[_i]), (LAS unsigned*)(lds + (bufoff) + ldsw + _i * 8192), 16, 0, Sched::A_AUX); } while (0)
#define PG8_LDA(dst, b, h) do { _Pragma("unroll") for (int m = 0; m < 4; ++m) _Pragma("unroll") for (int k = 0; k < 2; ++k) dst[m][k] = *(const LAS bf16x8*)(lds + PG8_SA(b, h) + aoff + m * 2048 + k * 1024); } while (0)
#define PG8_LDB(dst, b, h) do { _Pragma("unroll") for (int n = 0; n < 2; ++n) _Pragma("unroll") for (int k = 0; k < 2; ++k) dst[n][k] = *(const LAS bf16x8*)(lds + PG8_SB(b, h) + boff + n * 2048 + k * 1024); } while (0)
#define PG8_MMA(ai, bj, At, Bt) do { __builtin_amdgcn_s_setprio(1); _Pragma("unroll") for (int m = 0; m < 4; ++m) _Pragma("unroll") for (int n = 0; n < 2; ++n) _Pragma("unroll") for (int k = 0; k < 2; ++k) \
        acc[ai][bj][m][n] = __builtin_amdgcn_mfma_f32_16x16x32_bf16(Bt[n][k], At[m][k], acc[ai][bj][m][n], 0, 0, 0); __builtin_amdgcn_s_setprio(0); } while (0)
#define PG8_WAIT_V(n) asm volatile("s_waitcnt vmcnt(" #n ")" ::: "memory")
#define PG8_WAIT_L(n) asm volatile("s_waitcnt lgkmcnt(" #n ")" ::: "memory")
#define PG8_BAR __builtin_amdgcn_s_barrier()
#define PG8_SCHED __builtin_amdgcn_sched_barrier(0)
    Unit cur, nxt; int ui = 0;
    if (!S.next(0, cur)) return;
    f32x4 acc[2][2][4][2];
#pragma unroll
    for (int a = 0; a < 2; ++a)
#pragma unroll
        for (int b = 0; b < 2; ++b)
#pragma unroll
            for (int m = 0; m < 4; ++m)
#pragma unroll
                for (int n = 0; n < 2; ++n) acc[a][b][m][n] = (f32x4){0.f, 0.f, 0.f, 0.f};
    bf16x8 At[4][2], B0[2][2], B1[2][2];
    const char* cA = S.a_base(cur); const char* cB = S.b_base(cur);
    S.a_voff(0, cur, K, voffA, tid);
    int pend = -1; unsigned pv = 0u;
    if constexpr (Sched::POLL) { pv = S.poll(cur); S.a_ready(cur, pv); }
    PG8_STAGE(PG8_SB(0, 0), cB, voffB); PG8_STAGE(PG8_SB(0, 1), cB + hstep, voffB); PG8_STAGE_A(PG8_SA(0, 0), cA, voffA[0]); PG8_STAGE_A(PG8_SA(0, 1), cA, voffA[1]);
    if (wr == 1) PG8_BAR;
    PG8_WAIT_V(2); PG8_BAR;
    PG8_STAGE(PG8_SB(1, 0), cB + kstep, voffB); PG8_STAGE_A(PG8_SA(1, 0), cA + kstep, voffA[0]); PG8_STAGE(PG8_SB(1, 1), cB + hstep + kstep, voffB);
    PG8_WAIT_V(6); PG8_BAR;
    for (;;) {
        const bool has_next = S.next(ui + 1, nxt);
        const char* nA = has_next ? S.a_base(nxt) : cA; const char* nB = has_next ? S.b_base(nxt) : cB;
        for (int t = 0; t < nt; t += 2) {
            const bool last = (t == nt - 2);
            const char* a1 = cA + (size_t)(t + 1) * kstep;
            const char* a2 = last ? nA : cA + (size_t)(t + 2) * kstep; const char* b2 = last ? nB : cB + (size_t)(t + 2) * kstep;
            const char* a3 = a2 + kstep; const char* b3 = b2 + kstep;
            if constexpr (Sched::PUBLISH) { if (last && pend >= 0) S.publish(pend); }
            if constexpr (Sched::POLL) { if (t == nt - 4 && has_next) pv = S.poll(nxt); if (last && has_next) S.a_ready(nxt, pv); }
            PG8_LDB(B0, 0, 0); PG8_LDB(B1, 0, 1); PG8_SCHED; PG8_LDA(At, 0, 0); PG8_STAGE_A(PG8_SA(1, 1), a1, voffA[1]);
            if (GATHER) { if (last && has_next) S.a_voff(ui + 1, nxt, K, voffA, tid); }
            PG8_WAIT_V(8); PG8_WAIT_L(0); PG8_BAR; PG8_MMA(0, 0, At, B0); PG8_MMA(0, 1, At, B1); PG8_BAR; PG8_SCHED;
            PG8_LDA(At, 0, 1); PG8_STAGE(PG8_SB(0, 0), b2, voffB); PG8_STAGE(PG8_SB(0, 1), b2 + hstep, voffB); PG8_STAGE_A(PG8_SA(0, 0), a2, voffA[0]);
            PG8_WAIT_V(8); PG8_WAIT_L(0); PG8_BAR; PG8_MMA(1, 0, At, B0); PG8_MMA(1, 1, At, B1); PG8_BAR; PG8_SCHED;
            PG8_LDB(B0, 1, 0); PG8_LDB(B1, 1, 1); PG8_SCHED; PG8_LDA(At, 1, 0); PG8_STAGE_A(PG8_SA(0, 1), a2, voffA[1]);
            PG8_WAIT_V(8); PG8_WAIT_L(0); PG8_BAR; PG8_MMA(0, 0, At, B0); PG8_MMA(0, 1, At, B1); PG8_BAR; PG8_SCHED;
            PG8_LDA(At, 1, 1); PG8_STAGE(PG8_SB(1, 0), b3, voffB); PG8_STAGE(PG8_SB(1, 1), b3 + hstep, voffB); PG8_STAGE_A(PG8_SA(1, 0), a3, voffA[0]);
            PG8_WAIT_V(8); PG8_WAIT_L(0); PG8_BAR; PG8_MMA(1, 0, At, B0); PG8_MMA(1, 1, At, B1); PG8_BAR; PG8_SCHED;
        }
        if (wr == 0) PG8_BAR;
        E(acc, cur, wr, wc, fr, fq);
        if constexpr (Sched::PUBLISH) { if (has_next) pend = cur.pm; else S.done_last(cur.pm); }
        if (!has_next) break;
#pragma unroll
        for (int a = 0; a < 2; ++a)
#pragma unroll
            for (int b = 0; b < 2; ++b)
#pragma unroll
                for (int m = 0; m < 4; ++m)
#pragma unroll
                    for (int n = 0; n < 2; ++n) acc[a][b][m][n] = (f32x4){0.f, 0.f, 0.f, 0.f};
        cur = nxt; cA = nA; cB = nB; ++ui;
        if (wr == 1) PG8_BAR;
    }
    PG8_WAIT_V(0);
    PG8_BAR;
#undef PG8_SA
#undef PG8_SB
#undef PG8_STAGE
#undef PG8_STAGE_A
#undef PG8_LDA
#undef PG8_LDB
#undef PG8_MMA
#undef PG8_WAIT_V
#undef PG8_WAIT_L
#undef PG8_BAR
#undef PG8_SCHED
}

__device__ __forceinline__ void dense_voff(int K, unsigned (&voffA)[2][2], int tid) {
#pragma unroll
    for (int i = 0; i < 2; ++i) { int R, C; stage_rc(tid * 16 + i * 8192, R, C);
        voffA[0][i] = (unsigned)(R * K + C) * 2u; voffA[1][i] = (unsigned)((R + HALF) * K + C) * 2u; }
}
struct DenseOrder {
    const char* A; const char* Bt; int K, nM, nN, nwg, G, c;
    __device__ __forceinline__ void init(const void* A_, const void* Bt_, int M, int N, int K_, int G_, int c_) { A = (const char*)A_; Bt = (const char*)Bt_; K = K_; nM = M / BM; nN = N / BM; nwg = nM * nN; G = G_; c = c_; }
    __device__ __forceinline__ bool next(int i, Unit& u) const {
        const long L = (long)i * G + c; if (L >= nwg) return false;
        int wgid = (int)L; { const int q = nwg / NXCD, r = nwg % NXCD, xcd = wgid % NXCD, off = wgid / NXCD; wgid = (xcd < r ? xcd * (q + 1) : r * (q + 1) + (xcd - r) * q) + off; }
        const int nig = WGM * nN, gid = wgid / nig, fm = gid * WGM, gsz = (nM - fm) < WGM ? (nM - fm) : WGM;
        u.pm = fm + ((wgid % nig) % gsz); u.pn = (wgid % nig) / gsz; u.z = i; return true;
    }
    __device__ __forceinline__ const char* a_base(const Unit& u) const { return A + (size_t)u.pm * BM * K * 2; }
    __device__ __forceinline__ const char* b_base(const Unit& u) const { return Bt + (size_t)u.pn * BM * K * 2; }
    __device__ __forceinline__ void a_voff(int, const Unit&, int K_, unsigned (&voffA)[2][2], int tid) const { dense_voff(K_, voffA, tid); }
    static constexpr int A_AUX = 0; static constexpr bool PUBLISH = false, POLL = false;
};
}
using pg8::Unit; using pg8::cvt_pk_bf16;

__device__ __forceinline__ float ssq16(const float* p) { const f32x4 a = *(const f32x4*)p, b = *(const f32x4*)(p + 4), c = *(const f32x4*)(p + 8), d = *(const f32x4*)(p + 12);
    return (((a.x + a.y) + (a.z + a.w)) + ((b.x + b.y) + (b.z + b.w))) + (((c.x + c.y) + (c.z + c.w)) + ((d.x + d.y) + (d.z + d.w))); }

struct EpiBf16Scaled {
    bf16* O; int ldc; const LAS float* rtab; float scale;
    __device__ __forceinline__ void operator()(const f32x4 (&acc)[2][2][4][2], const Unit& u, int wr, int wc, int fr, int fq) const {
        const int lrow0 = wr * 64 + fr, row0 = u.pm * 256 + lrow0, col0 = u.pn * 256 + wc * 32 + 8 * fq;
#pragma unroll
        for (int ai = 0; ai < 2; ++ai)
#pragma unroll
            for (int m = 0; m < 4; ++m) { const int lr = lrow0 + ai * 128 + m * 16;
                float s = scale; if (rtab) s *= rtab[u.z * 256 + lr];
                bf16* rowp = O + (size_t)(u.pm * 256 + lr) * ldc + col0;
#pragma unroll
                for (int bj = 0; bj < 2; ++bj) { const f32x4 v0 = acc[ai][bj][m][0] * s, v1 = acc[ai][bj][m][1] * s;
                    v4u w; w.x = cvt_pk_bf16(v0[0], v0[1]); w.y = cvt_pk_bf16(v0[2], v0[3]); w.z = cvt_pk_bf16(v1[0], v1[1]); w.w = cvt_pk_bf16(v1[2], v1[3]);
                    *(v4u*)(rowp + bj * 128) = w; } }
        (void)row0;
    }
};
struct EpiProj {
    bf16* P; float* dt; const LAS float* rtab;
    __device__ __forceinline__ void operator()(const f32x4 (&acc)[2][2][4][2], const Unit& u, int wr, int wc, int fr, int fq) const {
        const int lrow0 = wr * 64 + fr;
        if (u.pn == 11) {
            if (wc == 0 && fq == 0) {
#pragma unroll
                for (int ai = 0; ai < 2; ++ai)
#pragma unroll
                    for (int m = 0; m < 4; ++m) { const int lr = lrow0 + ai * 128 + m * 16, row = u.pm * 256 + lr; const float s = rtab[u.z * 256 + lr];
                        *(f32x4*)(dt + (size_t)row * 8) = acc[ai][0][m][0] * s; *(f32x4*)(dt + (size_t)row * 8 + 4) = acc[ai][0][m][1] * s; }
            }
            return;
        }
        const int col0 = u.pn * 256 + wc * 32 + 8 * fq;
#pragma unroll
        for (int ai = 0; ai < 2; ++ai)
#pragma unroll
            for (int m = 0; m < 4; ++m) { const int lr = lrow0 + ai * 128 + m * 16; const float s = rtab[u.z * 256 + lr];
                bf16* rowp = P + (size_t)(u.pm * 256 + lr) * PROJ_LD + col0;
#pragma unroll
                for (int bj = 0; bj < 2; ++bj) { const f32x4 v0 = acc[ai][bj][m][0] * s, v1 = acc[ai][bj][m][1] * s;
                    v4u w; w.x = cvt_pk_bf16(v0[0], v0[1]); w.y = cvt_pk_bf16(v0[2], v0[3]); w.z = cvt_pk_bf16(v1[0], v1[1]); w.w = cvt_pk_bf16(v1[2], v1[3]);
                    __builtin_nontemporal_store(w, (v4u*)(rowp + bj * 128)); } }
    }
};
struct EpiResid {
    bf16* hb; float* ssq;
    __device__ __forceinline__ void operator()(const f32x4 (&acc)[2][2][4][2], const Unit& u, int wr, int wc, int fr, int fq) const {
        const int row0 = u.pm * 256 + wr * 64 + fr, col0 = u.pn * 256 + wc * 32 + 8 * fq;
#pragma unroll
        for (int ai = 0; ai < 2; ++ai) {
            v4u hv[4][2];
#pragma unroll
            for (int m = 0; m < 4; ++m)
#pragma unroll
                for (int bj = 0; bj < 2; ++bj) hv[m][bj] = *(const v4u*)(hb + (size_t)(row0 + ai * 128 + m * 16) * DM + col0 + bj * 128);
#pragma unroll
            for (int m = 0; m < 4; ++m) { const int row = row0 + ai * 128 + m * 16; const size_t off = (size_t)row * DM + col0;
                float sq = 0.f;
#pragma unroll
                for (int bj = 0; bj < 2; ++bj) {
                    const v4u h4 = hv[m][bj];
                    const f32x4 a0 = acc[ai][bj][m][0], a1 = acc[ai][bj][m][1];
                    const float v0 = bflo(h4.x) + a0[0], v1 = bfhi(h4.x) + a0[1], v2 = bflo(h4.y) + a0[2], v3 = bfhi(h4.y) + a0[3], v4 = bflo(h4.z) + a1[0], v5 = bfhi(h4.z) + a1[1], v6 = bflo(h4.w) + a1[2], v7 = bfhi(h4.w) + a1[3];
                    v4u w; w.x = cvt_pk_bf16(v0, v1); w.y = cvt_pk_bf16(v2, v3); w.z = cvt_pk_bf16(v4, v5); w.w = cvt_pk_bf16(v6, v7);
                    *(v4u*)(hb + off + bj * 128) = w;
                    sq += v0 * v0 + v1 * v1 + v2 * v2 + v3 * v3 + v4 * v4 + v5 * v5 + v6 * v6 + v7 * v7; }
                sq += __shfl_xor(sq, 16); sq += __shfl_xor(sq, 32);
                if (fq == 0) ssq[(size_t)row * 16 + u.pn * 4 + wc] = sq; }
            asm volatile("" ::: "memory"); }
    }
};

struct Args { const float* in[37]; float* out; unsigned char* ws; unsigned long long ws_size; };
enum { I_X = 0, I_MEM, I_NORM_MIX_G, I_W_IN, I_RET_GN_G, I_CONV_W, I_CONV_B, I_DT_BIAS, I_A_LOG, I_SSD_D, I_SSD_NORM_G, I_S5_ARE, I_S5_AIM, I_S5_BRE, I_S5_BIM, I_S5_CRE, I_S5_CIM,
       I_S5_LOGSTEP, I_S5_D, I_S5_WGLU, I_S5_BGLU, I_W_OUT, I_NORM_CROSS_G, I_MEM_NORM_G, I_W_CQ, I_W_CK, I_W_CV, I_W_CO, I_NORM_FFN_G, I_W_RG, I_B_RG, I_W_RE, I_B_RE, I_W_GATE, I_W_UP, I_W_DOWN, I_NORM_FINAL_G };

struct Ctx {
    LAS unsigned char* lds; unsigned char* ws; int tid, lane, wave, G, vcu, bid;
};

__device__ __forceinline__ void build_rstd_table(const Ctx& F, const pg8::DenseOrder& S, const float* ssq, int npart) {
    const int tid = fresh_tid(); LAS float* tab = (LAS float*)(F.lds + RSTD_LDS);
    for (int i = 0; i < 8; ++i) { Unit u; if (!S.next(i, u)) break;
        if (tid < 256) { const int row = u.pm * 256 + tid; const float s = (npart == 16) ? ssq16(ssq + (size_t)row * 16) : ssq[row]; tab[i * 256 + tid] = rsqrtf(s * (1.f / DM) + EPS); } }
    __syncthreads();
}


#ifndef DEBUG_STAGE
#define DEBUG_STAGE 0
#endif
constexpr int CW_DBGA = 80, CW_DBGB = 81;
__device__ __forceinline__ void dbg_max(unsigned* ctl, int word, float v) { if (!(v >= 0.f)) v = 1e30f; atomicMax(ctl + word, __builtin_bit_cast(unsigned, v)); }
__device__ __forceinline__ void dbg_emit(const Ctx& F, unsigned* ctl, float* out) {
    if (F.bid != 0) return;
    const float ea = __builtin_bit_cast(float, xb_ld(ctl + CW_DBGA)), eb = __builtin_bit_cast(float, xb_ld(ctl + CW_DBGB));
    const float la = fminf(fmaxf(log10f(fmaxf(ea, 1e-30f)), -6.f), 2.9f), lb = fminf(fmaxf(log10f(fmaxf(eb, 1e-30f)), -6.f), 3.f);
    const float V = 1000.f + 1000.f * (la + 6.f), W = exp10f(2.f + 0.954f * (lb + 6.f) / 9.f);
    for (int i = (1 << 20) + F.tid; i < (2 << 20); i += NTHREADS) out[i] = W;
    if (F.tid == 0) out[0] = V;
}


constexpr int CW_CK = 2048;
constexpr size_t WS_HIST = WS_SCR + 317 * MiB;
__device__ __forceinline__ void dbg_checksum(const Ctx& F, unsigned* ctl, int stage, const void* p, size_t nbytes) {
    const unsigned* w = (const unsigned*)p; const size_t n = nbytes / 4; unsigned s = 0;
    for (size_t i = (size_t)F.bid * NTHREADS + threadIdx.x; i < n; i += (size_t)F.G * NTHREADS) { const unsigned v = w[i]; s += v * 2654435761u + (v >> 7) * (unsigned)(i * 40503u + 1u); }
#pragma unroll
    for (int o = 1; o < 64; o <<= 1) s += __shfl_xor(s, o);
    if ((threadIdx.x & 63) == 0) atomicAdd(ctl + CW_CK + stage, s);
}

__device__ __forceinline__ void dbg_checksum_cols(const Ctx& F, unsigned* ctl, int stage, const void* p, int col_lo, int col_hi) {
    const unsigned* w = (const unsigned*)p; const size_t n = (size_t)T * DM / 2; unsigned s = 0;
    for (size_t i = (size_t)F.bid * NTHREADS + threadIdx.x; i < n; i += (size_t)F.G * NTHREADS) { const int col = (int)((i * 2) & 1023); if (col >= col_lo && col < col_hi) { const unsigned v = w[i]; s += v * 2654435761u + (v >> 7) * (unsigned)(i * 40503u + 1u); } }
#pragma unroll
    for (int o = 1; o < 64; o <<= 1) s += __shfl_xor(s, o);
    if ((threadIdx.x & 63) == 0) atomicAdd(ctl + CW_CK + stage, s);
}
__device__ __forceinline__ void dbg_checksum_route(const Ctx& F, unsigned* ctl, int stage) {
    const unsigned* ts = (const unsigned*)(F.ws + WS_TOKSLOT); const float* sw = (const float*)(F.ws + WS_SLOTW); unsigned s = 0;
    for (int t = F.bid * NTHREADS + threadIdx.x; t < T; t += F.G * NTHREADS) {
        const unsigned a = ts[2 * t], b = ts[2 * t + 1]; const unsigned e1 = a >> 20, e2 = b >> 20;
        const unsigned g1 = __builtin_bit_cast(unsigned, sw[(size_t)e1 * T + (a & 0xFFFFFu)]), g2 = __builtin_bit_cast(unsigned, sw[(size_t)e2 * T + (b & 0xFFFFFu)]);
        s += ((unsigned)t * 2654435761u) ^ (e1 * 97u + e2 * 7919u + 13u) ^ (g1 * 31u) ^ (g2 * 131u); }
#pragma unroll
    for (int o = 1; o < 64; o <<= 1) s += __shfl_xor(s, o);
    if ((threadIdx.x & 63) == 0) atomicAdd(ctl + CW_CK + stage, s);
}

__device__ __forceinline__ void tr_item(const float* __restrict__ W, int ldw, int k0, int col0, int ncols_valid, const float* __restrict__ gk, bf16* __restrict__ dst, int K, LAS float* scr, int lane) {
    const int c = lane & 31, kh = lane >> 5;
    float v[32];
    const bool ok = c < ncols_valid;
    const float* wp = W + (size_t)(k0 + kh) * ldw + col0 + c;
#pragma unroll
    for (int i = 0; i < 32; ++i) v[i] = ok ? __builtin_nontemporal_load(wp + (size_t)(2 * i) * ldw) : 0.f;
    if (gk) {
#pragma unroll
        for (int i = 0; i < 32; ++i) v[i] *= gk[k0 + 2 * i + kh]; }
#pragma unroll
    for (int i = 0; i < 32; ++i) scr[(2 * i + kh) * 33 + c] = v[i];
    LDS_WAIT();
    const int ch = lane & 7;
#pragma unroll
    for (int j = 0; j < 4; ++j) { const int n = (lane >> 3) + 8 * j; const LAS float* s = scr + (8 * ch) * 33 + n;
        v4u o; o.x = pk2(s[0 * 33], s[1 * 33]); o.y = pk2(s[2 * 33], s[3 * 33]); o.z = pk2(s[4 * 33], s[5 * 33]); o.w = pk2(s[6 * 33], s[7 * 33]);
        *(v4u*)(dst + (size_t)n * K + 8 * ch) = o; }
    LDS_WAIT();
}
__device__ __forceinline__ void tr_plain(const float* W, int K, int N, const float* gk, bf16* WT, LAS float* scr, int item, int lane) {
    const int nblk = N / 32, kb = item / nblk, nb = item % nblk;
    tr_item(W, N, 64 * kb, 32 * nb, 32, gk, WT + (size_t)(32 * nb) * K + 64 * kb, K, scr, lane);
}

__device__ __forceinline__ void p0_small_weights(const Ctx& F, const Args& args) {
    LAS float* scr = (LAS float*)(F.lds + F.wave * 16384);
    const int gw = F.vcu * NWAVES + F.wave, NGW = F.G * NWAVES;
    constexpr int I_IN = 16 * 96, I_SQ = 16 * 32, I_GLU = 4 * 8;
    constexpr int PER_LAYER = I_IN + 5 * I_SQ + I_GLU;
    for (int it = gw; it < NL * PER_LAYER; it += NGW) {
        const int l = it / PER_LAYER; int r = it % PER_LAYER;
        if (r < I_IN) {
            const int kb = r / 96, nb = r % 96; int col0, nv;
            if (nb < 80) { col0 = 32 * nb; nv = 32; } else if (nb < 88) { col0 = 2568 + 32 * (nb - 80); nv = 32; } else if (nb == 88) { col0 = 2560; nv = 8; } else { col0 = 0; nv = 0; }
            tr_item(args.in[I_W_IN] + (size_t)l * DM * IN_COLS, IN_COLS, 64 * kb, col0, nv, args.in[I_NORM_MIX_G] + l * DM, (bf16*)(F.ws + WS_WIN) + ((size_t)l * 3072 + 32 * nb) * DM + 64 * kb, DM, scr, F.lane);
            continue; }
        r -= I_IN;
        if (r < I_SQ) { tr_plain(args.in[I_W_OUT] + (size_t)l * DM * DM, DM, DM, nullptr, (bf16*)(F.ws + WS_WOUT) + (size_t)l * DM * DM, scr, r, F.lane); continue; } r -= I_SQ;
        if (r < I_SQ) { tr_plain(args.in[I_W_CQ] + (size_t)l * DM * DM, DM, DM, args.in[I_NORM_CROSS_G] + l * DM, (bf16*)(F.ws + WS_WQ) + (size_t)l * DM * DM, scr, r, F.lane); continue; } r -= I_SQ;
        if (r < I_SQ) { tr_plain(args.in[I_W_CK] + (size_t)l * DM * DM, DM, DM, nullptr, (bf16*)(F.ws + WS_WK) + (size_t)l * DM * DM, scr, r, F.lane); continue; } r -= I_SQ;
        if (r < I_SQ) { tr_plain(args.in[I_W_CV] + (size_t)l * DM * DM, DM, DM, nullptr, (bf16*)(F.ws + WS_WV) + (size_t)l * DM * DM, scr, r, F.lane); continue; } r -= I_SQ;
        if (r < I_SQ) { tr_plain(args.in[I_W_CO] + (size_t)l * DM * DM, DM, DM, nullptr, (bf16*)(F.ws + WS_WO) + (size_t)l * DM * DM, scr, r, F.lane); continue; } r -= I_SQ;
        tr_plain(args.in[I_S5_WGLU] + (size_t)l * 256 * 256, 256, 256, nullptr, (bf16*)(F.ws + WS_WGLU) + (size_t)l * 256 * 256, scr, r, F.lane);
    }
}
__device__ __forceinline__ void convert_moe_weights(const Ctx& F0, const Args& args, int l) {
    Ctx F = F0; { const int t = fresh_tid(); F.tid = t; F.lane = t & 63; F.wave = __builtin_amdgcn_readfirstlane(t >> 6); }
    LAS float* scr = (LAS float*)(F.lds + F.wave * 16384);
    const int gw = F.vcu * NWAVES + F.wave, NGW = F.G * NWAVES;
    constexpr int I_GU = 16 * 32, I_D = 8 * 32;
    for (int it = gw; it < NEXP * (I_GU + I_D); it += NGW) {
        const int e = it / (I_GU + I_D); int r = it % (I_GU + I_D);
        if (r < I_GU) { const int kb = r / 32, nb = r % 32, pn = nb >> 3, j = nb & 7;
            const float* W = (j < 4 ? args.in[I_W_GATE] : args.in[I_W_UP]) + ((size_t)l * NEXP + e) * DM * DEXP;
            tr_item(W, DEXP, 64 * kb, 128 * pn + 32 * (j & 3), 32, args.in[I_NORM_FFN_G] + l * DM, (bf16*)(F.ws + WS_WGU) + ((size_t)e * 1024 + 32 * nb) * DM + 64 * kb, DM, scr, F.lane);
        } else { r -= I_GU;
            tr_plain(args.in[I_W_DOWN] + ((size_t)l * NEXP + e) * DEXP * DM, DEXP, DM, nullptr, (bf16*)(F.ws + WS_WD) + (size_t)e * DM * DEXP, scr, r, F.lane); }
    }
}
__device__ __forceinline__ void p0_misc(const Ctx& F, const Args& args) {
    const int gw = F.vcu * NWAVES + F.wave, NGW = F.G * NWAVES, lane = F.lane;
    { const float* x = args.in[I_X]; bf16* hb = (bf16*)(F.ws + WS_HB); float* ssq = (float*)(F.ws + WS_SSQ0);
      constexpr int XB = 4;
      for (int m0 = gw * XB; m0 < T; m0 += NGW * XB) {
        f32x4 v[XB][4];
#pragma unroll
        for (int k = 0; k < XB; ++k) { const f32x4* xr = (const f32x4*)(x + (size_t)(m0 + k) * DM) + lane;
#pragma unroll
            for (int j = 0; j < 4; ++j) v[k][j] = __builtin_nontemporal_load(xr + 64 * j); }
#pragma unroll
        for (int k = 0; k < XB; ++k) { float s = 0.f;
#pragma unroll
            for (int j = 0; j < 4; ++j) s += v[k][j].x * v[k][j].x + v[k][j].y * v[k][j].y + v[k][j].z * v[k][j].z + v[k][j].w * v[k][j].w;
            s = wave_sum(s);
            unsigned long long* o8 = (unsigned long long*)(hb + (size_t)(m0 + k) * DM) + lane;
#pragma unroll
            for (int j = 0; j < 4; ++j) o8[64 * j] = (unsigned long long)pk2(v[k][j].x, v[k][j].y) | ((unsigned long long)pk2(v[k][j].z, v[k][j].w) << 32);
            if (lane == 0) ssq[m0 + k] = s; }
      } }
    { const float* mem = args.in[I_MEM]; const float* g = args.in[I_MEM_NORM_G]; bf16* mn = (bf16*)(F.ws + WS_MN);
      for (int m = gw; m < TM; m += NGW) {
        const f32x4* xr = (const f32x4*)(mem + (size_t)m * DM) + lane; const f32x4* gr = (const f32x4*)g + lane; float s = 0.f; f32x4 v[4];
#pragma unroll
        for (int j = 0; j < 4; ++j) { v[j] = __builtin_nontemporal_load(xr + 64 * j); s += v[j].x * v[j].x + v[j].y * v[j].y + v[j].z * v[j].z + v[j].w * v[j].w; }
        const float rs = rsqrtf(wave_sum(s) * (1.f / DM) + EPS);
        unsigned long long* o8 = (unsigned long long*)(mn + (size_t)m * DM) + lane;
#pragma unroll
        for (int j = 0; j < 4; ++j) { const f32x4 gg = gr[64 * j]; const f32x4 y = v[j] * rs * gg; o8[64 * j] = (unsigned long long)pk2(y.x, y.y) | ((unsigned long long)pk2(y.z, y.w) << 32); }
      } }
    const int gt = F.vcu * NTHREADS + F.tid, NGT = F.G * NTHREADS;
    { float* ct = (float*)(F.ws + WS_ROPE); float* st = ct + SEQ * 32;
      for (int i = gt; i < SEQ * 32; i += NGT) { const int pos = i >> 5, k = i & 31; const float inv = powf(10000.f, -(float)(2 * k) / 64.f); const float ang = (float)pos * inv; ct[i] = cosf(ang); st[i] = sinf(ang); } }
    { for (int i = gt; i < NL * 48 * DM; i += NGT) { const int l = i / (48 * DM), r = (i / DM) % 48, k = i % DM; const int tile = r >> 4, q = (r >> 2) & 3, ii = r & 3;
        float w; if (tile < 2) w = args.in[I_W_RE][((size_t)l * DM + k) * 32 + q * 8 + tile * 4 + ii]; else w = args.in[I_W_RG][((size_t)l * DM + k) * 4 + ii];
        w *= args.in[I_NORM_FFN_G][l * DM + k];
        const unsigned hi = f2bf(w); const float lo = w - bf2f(hi);
        bf16* wr = (bf16*)(F.ws + WS_WR) + (size_t)l * 2 * 48 * DM; wr[r * DM + k] = (bf16)hi; wr[48 * DM + r * DM + k] = (bf16)f2bf(lo); } }
    { for (int i = gt; i < NL * 16 * 64; i += NGT) { const int l = i / 1024, g = (i / 64) & 15, p = i & 63;
        const float delta = expf(args.in[I_S5_LOGSTEP][l * 16 + g]); const float ar = args.in[I_S5_ARE][i], ai = args.in[I_S5_AIM][i];
        const float mag = expf(ar * delta), ang = ai * delta; const float lr = mag * cosf(ang), li = mag * sinf(ang);
        const float mag128 = expf(ar * delta * 128.f), ang128 = ang * 128.f;
        unsigned char* tab = F.ws + WS_S5TAB + (size_t)l * S5TAB_LAYER;
        ((f32x4*)tab)[g * 64 + p] = (f32x4){lr, li, mag128 * cosf(ang128), mag128 * sinf(ang128)};
        const float den = ar * ar + ai * ai, nr = lr - 1.f, ni = li; const float cr = (nr * ar + ni * ai) / den, ci = (ni * ar - nr * ai) / den;
        bf16* bb = (bf16*)(tab + S5TAB_BBAR) + (size_t)g * 128 * 16;
        const float* bre = args.in[I_S5_BRE] + (size_t)i * 16; const float* bim = args.in[I_S5_BIM] + (size_t)i * 16;
#pragma unroll
        for (int c = 0; c < 16; ++c) { bb[p * 16 + c] = (bf16)f2bf(cr * bre[c] - ci * bim[c]); bb[(64 + p) * 16 + c] = (bf16)f2bf(cr * bim[c] + ci * bre[c]); } }
      for (int i = gt; i < NL * 16 * 32 * 128; i += NGT) { const int l = i / (16 * 32 * 128), g = (i / (32 * 128)) & 15, cc = (i / 128) & 31, k = i & 127;
        float v = 0.f; if (cc < 16) { const size_t o = (((size_t)l * 16 + g) * 16 + cc) * 64 + (k & 63); v = (k < 64) ? args.in[I_S5_CRE][o] : -args.in[I_S5_CIM][o]; }
        ((bf16*)(F.ws + WS_S5TAB + (size_t)l * S5TAB_LAYER + S5TAB_CT))[(g * 32 + cc) * 128 + k] = (bf16)f2bf(v); } }
}


__device__ __forceinline__ int s5_slab_off(int w) { return w < 3 ? w * 16896 : 65536 + (w - 3) * 16896; }
static_assert(65536 + 5 * 16896 <= SCRATCH_BYTES, "s5 slabs");

__device__ __forceinline__ bf16x8 ldsv8(LAS const bf16* p) { return *(LAS const bf16x8*)p; }
template <int KS> __device__ __forceinline__ void mma_tile(f32x16& acc, LAS const bf16* a, LAS const bf16* b) {
#pragma unroll
    for (int ks = 0; ks < KS; ++ks) acc = MFMA32(ldsv8(a + 16 * ks), ldsv8(b + 16 * ks), acc);
}
__device__ __forceinline__ void mma_tile_n(f32x16& acc, LAS const bf16* a, LAS const bf16* b, int ksteps) {
    for (int ks = 0; ks < ksteps; ++ks) acc = MFMA32(ldsv8(a + 16 * ks), ldsv8(b + 16 * ks), acc);
}
__device__ __forceinline__ void unpack8(const v4u w, float (&f)[8]) { f[0] = bflo(w.x); f[1] = bfhi(w.x); f[2] = bflo(w.y); f[3] = bfhi(w.y); f[4] = bflo(w.z); f[5] = bfhi(w.z); f[6] = bflo(w.w); f[7] = bfhi(w.w); }
__device__ __forceinline__ v4u pack8(const float (&f)[8]) { v4u w; w.x = pk2(f[0], f[1]); w.y = pk2(f[2], f[3]); w.z = pk2(f[4], f[5]); w.w = pk2(f[6], f[7]); return w; }
__device__ __forceinline__ float ret_lg(int h) { return log1pf(-exp2f((float)(-5 - h))); }
__device__ __forceinline__ int crow(int reg, int hh) { return (reg & 3) + 8 * (reg >> 2) + 4 * hh; }

__device__ __forceinline__ void conv_silu8(const bf16* xrow, int l, bool first_chunk, const float* cw  , const float* cb  , float (&o)[8]) {
    const f32x4 b0 = *(const f32x4*)cb, b1 = *(const f32x4*)(cb + 4);
    o[0] = b0.x; o[1] = b0.y; o[2] = b0.z; o[3] = b0.w; o[4] = b1.x; o[5] = b1.y; o[6] = b1.z; o[7] = b1.w;
#pragma unroll
    for (int jj = 0; jj < 4; ++jj) {
        const int dl = jj - 3;
        if (!first_chunk || l + dl >= 0) {
            const v4u xv = *(const v4u*)(xrow + (long)dl * PROJ_LD); float xf[8]; unpack8(xv, xf);
            const f32x4 w0 = *(const f32x4*)(cw + jj * 1024), w1 = *(const f32x4*)(cw + jj * 1024 + 4);
            o[0] += w0.x * xf[0]; o[1] += w0.y * xf[1]; o[2] += w0.z * xf[2]; o[3] += w0.w * xf[3]; o[4] += w1.x * xf[4]; o[5] += w1.y * xf[5]; o[6] += w1.z * xf[6]; o[7] += w1.w * xf[7];
        }
    }
#pragma unroll
    for (int q = 0; q < 8; ++q) o[q] = siluf_(o[q]);
}

constexpr size_t WS_XACT = WS_WGU;
__device__ __forceinline__ void conv_prepass(const Ctx& F, const Args& args, int l, int unit) {
    const int tid = fresh_tid(), c8 = (tid & 127) * 8, l0 = (tid >> 7) * 32, tok0 = unit * 128; const bool first = (unit & 31) == 0;
    const bf16* proj = (const bf16*)(F.ws + WS_PROJ); bf16* xact = (bf16*)(F.ws + WS_XACT);
    const float* cw = args.in[I_CONV_W] + (size_t)l * 4 * 1024 + c8; const float* cb = args.in[I_CONV_B] + (size_t)l * 1024 + c8;
    float w[4][8], bias[8];
    { const f32x4 b0 = *(const f32x4*)cb, b1 = *(const f32x4*)(cb + 4); bias[0] = b0.x; bias[1] = b0.y; bias[2] = b0.z; bias[3] = b0.w; bias[4] = b1.x; bias[5] = b1.y; bias[6] = b1.z; bias[7] = b1.w; }
#pragma unroll
    for (int j = 0; j < 4; ++j) { const f32x4 w0 = *(const f32x4*)(cw + j * 1024), w1 = *(const f32x4*)(cw + j * 1024 + 4); w[j][0] = w0.x; w[j][1] = w0.y; w[j][2] = w0.z; w[j][3] = w0.w; w[j][4] = w1.x; w[j][5] = w1.y; w[j][6] = w1.z; w[j][7] = w1.w; }
    float win[3][8];
#pragma unroll
    for (int j = 0; j < 3; ++j) { const int ll = l0 - 3 + j;
        if (first && ll < 0) {
#pragma unroll
            for (int q = 0; q < 8; ++q) win[j][q] = 0.f;
        } else unpack8(*(const v4u*)(proj + (size_t)(tok0 + ll) * PROJ_LD + COL_X + c8), win[j]); }
#pragma unroll 4
    for (int i = 0; i < 32; ++i) { float cur[8], o[8]; unpack8(__builtin_nontemporal_load((const v4u*)(proj + (size_t)(tok0 + l0 + i) * PROJ_LD + COL_X + c8)), cur);
#pragma unroll
        for (int q = 0; q < 8; ++q) { o[q] = siluf_(bias[q] + w[0][q] * win[0][q] + w[1][q] * win[1][q] + w[2][q] * win[2][q] + w[3][q] * cur[q]); win[0][q] = win[1][q]; win[1][q] = win[2][q]; win[2][q] = cur[q]; }
        *(v4u*)(xact + (size_t)(tok0 + l0 + i) * 1024 + c8) = pack8(o); }
}
__device__ __forceinline__ void xact8(const bf16* xact, int tok, int chan, float (&o)[8]) { unpack8(*(const v4u*)(xact + (size_t)tok * 1024 + chan), o); }
__device__ __forceinline__ void ssd_dt_acum(const Ctx& F, const Args& args, int l, int unit, LAS float* dt_s, LAS float* acum_s, float* dec_out, const float ascale = 1.f) {
    const int tid_ = fresh_tid(), w = __builtin_amdgcn_readfirstlane(tid_ >> 6), lane = tid_ & 63, tok0 = unit * 128;
    const float* dtb = (const float*)(F.ws + WS_DT);
    const float bias = args.in[I_DT_BIAS][l * 8 + w], A = -__expf(args.in[I_A_LOG][l * 8 + w]);
    const float d0 = softplusf_(dtb[(size_t)(tok0 + lane) * 8 + w] + bias), d1 = softplusf_(dtb[(size_t)(tok0 + 64 + lane) * 8 + w] + bias);
    float s0 = d0 * A, s1 = d1 * A;
#pragma unroll
    for (int o = 1; o < 64; o <<= 1) { const float t0 = __shfl_up(s0, o), t1 = __shfl_up(s1, o); if (lane >= o) { s0 += t0; s1 += t1; } }
    s1 += __shfl(s0, 63);
    dt_s[w * 128 + lane] = d0; dt_s[w * 128 + 64 + lane] = d1; acum_s[w * 128 + lane] = s0 * ascale; acum_s[w * 128 + 64 + lane] = s1 * ascale;
    if (dec_out && lane == 63) dec_out[unit * 8 + w] = __expf(s1);
}


__device__ __forceinline__ void s5_stage_u(const bf16* proj, int tok0, int g, LAS float* U, int lane) {
#pragma unroll
    for (int i = 0; i < 2; ++i) { const int t = 2 * lane + i; const bf16* up = proj + (size_t)(tok0 + t) * PROJ_LD + COL_U + g * 16;
        float a[8], b[8]; unpack8(*(const v4u*)up, a); unpack8(*(const v4u*)(up + 8), b);
        LAS f32x4* d = (LAS f32x4*)(U + t * 16);
        d[0] = (f32x4){a[0], a[1], a[2], a[3]}; d[1] = (f32x4){a[4], a[5], a[6], a[7]}; d[2] = (f32x4){b[0], b[1], b[2], b[3]}; d[3] = (f32x4){b[4], b[5], b[6], b[7]}; }
    LDS_WAIT();
}


__device__ __forceinline__ unsigned s5_chunk_states(const Ctx& F, int l, int unit, const bool CMP, const size_t alt = 0) {
    const int tid = fresh_tid(), lane = tid & 63, w = __builtin_amdgcn_readfirstlane(tid >> 6), r = lane & 31, hh = lane >> 5, tok0 = unit * 128;
    const bf16* proj = (const bf16*)(F.ws + WS_PROJ);
    LAS float* Bu = (LAS float*)(F.lds + s5_slab_off(w));
    const unsigned char* tab = F.ws + WS_S5TAB + (size_t)l * S5TAB_LAYER;
    float one = 1.f; asm volatile("" : "+v"(one));
    unsigned bad = 0;
    for (int rd = 0; rd < 2; ++rd) { const int g = w + 8 * rd;
        const f32x4 lam = ((const f32x4*)tab)[g * 64 + lane];
        bf16x8 bfr[4];
#pragma unroll
        for (int nt = 0; nt < 4; ++nt) bfr[nt] = *(const bf16x8*)((const bf16*)(tab + S5TAB_BBAR) + (size_t)(g * 128 + 32 * nt + r) * 16 + 8 * hh);
        float xr = 0.f, xi = 0.f;
        for (int s = 0; s < 4; ++s) {
            const bf16x8 af = *(const bf16x8*)(proj + (size_t)(tok0 + 32 * s + r) * PROJ_LD + COL_U + g * 16 + 8 * hh);
            f32x16 accb[4];
#pragma unroll
            for (int nt = 0; nt < 4; ++nt) accb[nt] = MFMA32(af, bfr[nt], zero16());
            __builtin_amdgcn_sched_barrier(0); asm volatile("s_nop 15"); asm volatile("s_nop 15"); asm volatile("s_nop 15"); asm volatile("s_nop 15"); __builtin_amdgcn_sched_barrier(0);
#pragma unroll
            for (int nt = 0; nt < 4; ++nt)
#pragma unroll
                for (int rg = 0; rg < 16; ++rg) Bu[crow(rg, hh) * 132 + 32 * nt + r] = accb[nt][rg] * one;
            LDS_WAIT();
#pragma unroll 8
            for (int t = 0; t < 32; ++t) { const float br = Bu[t * 132 + lane], bi = Bu[t * 132 + 64 + lane];
                const float nr = lam.x * xr - lam.y * xi + br, ni = lam.x * xi + lam.y * xr + bi; xr = nr; xi = ni; }
            LDS_WAIT();
        }
        f32x2* dst = (f32x2*)(F.ws + WS_S5ST + alt) + (size_t)(unit * 16 + g) * 64 + lane;
        if (CMP) { const unsigned* pu = (const unsigned*)dst; const unsigned ox = pu[0], oy = pu[1]; if (ox != __float_as_uint(xr) || oy != __float_as_uint(xi)) ++bad; }
        else *dst = (f32x2){xr, xi};
    }
    return bad;
}

__device__ __forceinline__ void mixer_states(const Ctx& F, const Args& args, int l) {
    const int tid = fresh_tid(), lane = tid & 63, w = __builtin_amdgcn_readfirstlane(tid >> 6), r = lane & 31, hh = lane >> 5;
    const bf16* proj = (const bf16*)(F.ws + WS_PROJ);
    LAS bf16* L16 = (LAS bf16*)F.lds;
    for (int unit = F.bid; unit < NUNIT; unit += F.G) {
        const int c = unit & 31, b = unit >> 5, tok0 = unit * 128, pos0 = c * 128;
        conv_prepass(F, args, l, unit);
        VM_WAIT();
        {
            LAS bf16* VT = L16; LAS bf16* KT = L16 + 256 * 136;
#pragma unroll
            for (int i = 0; i < 8; ++i) { const int j = tid & 127, cg = (tid >> 7) + 4 * i;
                const v4u v = *(const v4u*)(proj + (size_t)(tok0 + j) * PROJ_LD + COL_V + 8 * cg); float f[8]; unpack8(v, f);
#pragma unroll
                for (int q = 0; q < 8; ++q) VT[(8 * cg + q) * 136 + j] = (bf16)f2bf(f[q]); }
            const float* ct = (const float*)(F.ws + WS_ROPE); const float* st = ct + SEQ * 32;
#pragma unroll
            for (int i = 0; i < 4; ++i) { const int j = tid & 127, hd = (tid >> 7) + 4 * i, h = hd >> 2, dg = hd & 3;
                const bf16* kp = proj + (size_t)(tok0 + j) * PROJ_LD + COL_K + h * 64 + 8 * dg;
                float k1[8], k2[8]; unpack8(*(const v4u*)kp, k1); unpack8(*(const v4u*)(kp + 32), k2);
                const float* cp = ct + (size_t)(pos0 + j) * 32 + 8 * dg; const float* sp = st + (size_t)(pos0 + j) * 32 + 8 * dg;
                const f32x4 c0 = *(const f32x4*)cp, c1 = *(const f32x4*)(cp + 4), s0 = *(const f32x4*)sp, s1 = *(const f32x4*)(sp + 4);
                const float cs[8] = {c0.x, c0.y, c0.z, c0.w, c1.x, c1.y, c1.z, c1.w}, sn[8] = {s0.x, s0.y, s0.z, s0.w, s1.x, s1.y, s1.z, s1.w};
                const float fac = 0.125f * __expf(ret_lg(h) * (float)(127 - j));
#pragma unroll
                for (int q = 0; q < 8; ++q) { KT[(h * 64 + 8 * dg + q) * 136 + j] = (bf16)f2bf((k1[q] * cs[q] - k2[q] * sn[q]) * fac); KT[(h * 64 + 32 + 8 * dg + q) * 136 + j] = (bf16)f2bf((k1[q] * sn[q] + k2[q] * cs[q]) * fac); } }
            FULL_SYNC();
            const int h = w >> 1, me = w & 1;
            float one_ = 1.f; asm volatile("" : "+v"(one_));
            f32x16 a0 = zero16(), a1 = zero16();
            mma_tile<8>(a0, VT + (h * 64 + 32 * me + r) * 136 + 8 * hh, KT + (h * 64 + r) * 136 + 8 * hh);
            mma_tile<8>(a1, VT + (h * 64 + 32 * me + r) * 136 + 8 * hh, KT + (h * 64 + 32 + r) * 136 + 8 * hh);
            MFMA_SETTLE();
            float* o = (float*)(F.ws + WS_RETST) + ((size_t)((b * 4 + h) * 32 + c)) * 4096;
#pragma unroll
            for (int rg = 0; rg < 16; ++rg) { const int e = 32 * me + crow(rg, hh); o[e * 64 + r] = a0[rg] * one_; o[e * 64 + 32 + r] = a1[rg] * one_; }
            FULL_SYNC();
        }
        {
            LAS bf16* BT = L16; LAS bf16* XT = L16 + 128 * 136; LAS float* dt_s = (LAS float*)(F.lds + 104448); LAS float* acum_s = dt_s + 1024;
            ssd_dt_acum(F, args, l, unit, dt_s, acum_s, (float*)(F.ws + WS_SSDDEC));
            FULL_SYNC();
            const bf16* xact = (const bf16*)(F.ws + WS_XACT);
            for (int g = 0; g < 2; ++g) {
#pragma unroll
                for (int i = 0; i < 4; ++i) { const int ll = tid & 127, ng = (tid >> 7) + 4 * i, chan = 512 + g * 128 + 8 * ng; float o[8];
                    xact8(xact, tok0 + ll, chan, o);
#pragma unroll
                    for (int q = 0; q < 8; ++q) BT[(8 * ng + q) * 136 + ll] = (bf16)f2bf(o[q]); }
#pragma unroll
                for (int i = 0; i < 8; ++i) { const int ll = tid & 127, cg = (tid >> 7) + 4 * i, chan = g * 256 + 8 * cg, head = g * 4 + (cg >> 3); float o[8];
                    xact8(xact, tok0 + ll, chan, o);
                    const float sc = dt_s[head * 128 + ll] * __expf(acum_s[head * 128 + 127] - acum_s[head * 128 + ll]);
#pragma unroll
                    for (int q = 0; q < 8; ++q) XT[(8 * cg + q) * 136 + ll] = (bf16)f2bf(o[q] * sc); }
                FULL_SYNC();
                const int mp = w >> 2, nn = w & 3;
#pragma unroll
                for (int hl = 0; hl < 4; ++hl) {
                    f32x16 a = zero16();
                    mma_tile<8>(a, XT + (hl * 64 + 32 * mp + r) * 136 + 8 * hh, BT + (32 * nn + r) * 136 + 8 * hh);
                    MFMA_SETTLE();
                    bf16* o = (bf16*)(F.ws + WS_SSDST) + ((size_t)(unit * 8 + g * 4 + hl)) * 8192;
#pragma unroll
                    for (int rg = 0; rg < 16; ++rg) o[(32 * mp + crow(rg, hh)) * 128 + 32 * nn + r] = (bf16)f2bf(a[rg]);
                }
                FULL_SYNC();
            }
        }
#if DEBUG_STAGE == 4
        { unsigned bad0 = 0, bad1 = 0;
#pragma nounroll
          for (int rep = 0; rep < 4; ++rep) { const unsigned b_ = s5_chunk_states(F, l, unit, rep >= 2, (rep & 1) ? (size_t)(WS_CAT - WS_S5ST) : 0); if (rep == 2) bad0 += b_; if (rep == 3) bad1 += b_; FULL_SYNC(); }
          if (bad0) atomicAdd((unsigned*)(F.ws + WS_CTL) + CW_DIAG, bad0); if (bad1) atomicAdd((unsigned*)(F.ws + WS_CTL) + CW_DIAG + 1, bad1); }
#else
        (void)s5_chunk_states(F, l, unit, false);
        FULL_SYNC();
#endif
    }
}

__device__ __forceinline__ void mixer_scan(const Ctx& F, const Args& args, int l) {
    const int gt = F.bid * NTHREADS + fresh_tid(), NGT = F.G * NTHREADS;
    constexpr int N_RET = BATCH * 4 * 4096, N_SSD = BATCH * 8 * 1024, N_S5 = BATCH * 1024;
    for (int q0 = gt; q0 < N_RET + N_SSD + N_S5; q0 += NGT) {
        if (q0 < N_RET) {
            const int bh = q0 >> 12, ed = q0 & 4095; float* p = (float*)(F.ws + WS_RETST) + (size_t)bh * 32 * 4096 + ed;
            const float dec = __expf(ret_lg(bh & 3) * 128.f);
            float v[32];
#pragma unroll
            for (int c = 0; c < 32; ++c) v[c] = p[(size_t)c * 4096];
            float S = 0.f; asm volatile("" : "+v"(S));
#pragma unroll
            for (int c = 0; c < 32; ++c) { p[(size_t)c * 4096] = S; S = S * dec + v[c]; }
        } else if (q0 < N_RET + N_SSD) {
            const int q = q0 - N_RET, bh = q >> 10, e8 = q & 1023, b = bh >> 3, head = bh & 7;
            bf16* p = (bf16*)(F.ws + WS_SSDST) + ((size_t)(b * 32) * 8 + head) * 8192 + e8 * 8;
            const float* dec = (const float*)(F.ws + WS_SSDDEC) + (size_t)(b * 32) * 8 + head;
            float S[8];
#pragma unroll
            for (int k = 0; k < 8; ++k) { S[k] = 0.f; asm volatile("" : "+v"(S[k])); }
#pragma unroll 1
            for (int c0 = 0; c0 < 32; c0 += 8) {
                v4u v[8]; float d[8];
#pragma unroll
                for (int c = 0; c < 8; ++c) { v[c] = *(const v4u*)(p + (size_t)(c0 + c) * 8 * 8192); d[c] = dec[(c0 + c) * 8]; }
#pragma unroll
                for (int c = 0; c < 8; ++c) { float f[8]; unpack8(v[c], f); *(v4u*)(p + (size_t)(c0 + c) * 8 * 8192) = pack8(S);
#pragma unroll
                    for (int k = 0; k < 8; ++k) S[k] = S[k] * d[c] + f[k]; }
            }
        } else {
            const int q = q0 - N_RET - N_SSD, b = q >> 10, gp = q & 1023;
            f32x2* p = (f32x2*)(F.ws + WS_S5ST) + (size_t)(b * 32) * 1024 + gp;
            const f32x4 lam = ((const f32x4*)(F.ws + WS_S5TAB + (size_t)l * S5TAB_LAYER))[gp];
            f32x2 v[32];
#pragma unroll
            for (int c = 0; c < 32; ++c) v[c] = p[(size_t)c * 1024];
            float xr = 0.f, xi = 0.f; asm volatile("" : "+v"(xr), "+v"(xi));
#pragma unroll
            for (int c = 0; c < 32; ++c) { p[(size_t)c * 1024] = (f32x2){xr, xi}; const float nr = lam.z * xr - lam.w * xi + v[c].x, ni = lam.z * xi + lam.w * xr + v[c].y; xr = nr; xi = ni; }
        }
    }
}

__device__ __forceinline__ void mixer_out_ret(const Ctx& F, const Args& args, int l) {
    const int tid = fresh_tid(), lane = tid & 63, w = __builtin_amdgcn_readfirstlane(tid >> 6), r = lane & 31, hh = lane >> 5;
    const bf16* proj = (const bf16*)(F.ws + WS_PROJ);
    bf16* cat = (bf16*)(F.ws + WS_CAT);
    LAS bf16* L16 = (LAS bf16*)F.lds;
    for (int unit = F.bid; unit < NUNIT; unit += F.G) {
        const int c = unit & 31, b = unit >> 5, tok0 = unit * 128, pos0 = c * 128; (void)b; (void)pos0;
        {
            LAS bf16* Qs = L16; LAS bf16* Ks = L16 + 128 * 72; LAS bf16* VT = L16 + 2 * 128 * 72; LAS bf16* Ps = VT + 64 * 136; LAS bf16* STs = Ps + 128 * 136; LAS float* exch = (LAS float*)(F.lds + 98304);
            const float* ct = (const float*)(F.ws + WS_ROPE); const float* st = ct + SEQ * 32;
            const int si_ = tid & 127, sdg_ = tid >> 7;
            float cs[8], sn[8];
            { const float* cp = ct + (size_t)(pos0 + si_) * 32 + 8 * sdg_; const float* sp = st + (size_t)(pos0 + si_) * 32 + 8 * sdg_;
              const f32x4 c0 = *(const f32x4*)cp, c1 = *(const f32x4*)(cp + 4), s0 = *(const f32x4*)sp, s1 = *(const f32x4*)(sp + 4);
              cs[0] = c0.x; cs[1] = c0.y; cs[2] = c0.z; cs[3] = c0.w; cs[4] = c1.x; cs[5] = c1.y; cs[6] = c1.z; cs[7] = c1.w;
              sn[0] = s0.x; sn[1] = s0.y; sn[2] = s0.z; sn[3] = s0.w; sn[4] = s1.x; sn[5] = s1.y; sn[6] = s1.z; sn[7] = s1.w; }
            v4u qkv_[4], vv_[2]; f32x4 su_[2];
#define RET_LOAD(h_) do { const bf16* qp_ = proj + (size_t)(tok0 + si_) * PROJ_LD + COL_Q + (h_) * 64 + 8 * sdg_; const bf16* kp_ = qp_ + (COL_K - COL_Q); \
                qkv_[0] = *(const v4u*)qp_; qkv_[1] = *(const v4u*)(qp_ + 32); qkv_[2] = *(const v4u*)kp_; qkv_[3] = *(const v4u*)(kp_ + 32); \
                _Pragma("unroll") for (int i = 0; i < 2; ++i) vv_[i] = *(const v4u*)(proj + (size_t)(tok0 + si_) * PROJ_LD + COL_V + (h_) * 64 + 8 * (sdg_ + 4 * i)); \
                { const int e = tid >> 3, d0 = (tid & 7) * 8; const float* sp_ = (const float*)(F.ws + WS_RETST) + ((size_t)((b * 4 + (h_)) * 32 + c)) * 4096 + e * 64 + d0; su_[0] = *(const f32x4*)sp_; su_[1] = *(const f32x4*)(sp_ + 4); } } while (0)
            RET_LOAD(0);
            for (int h = 0; h < 4; ++h) {
                const float lg = ret_lg(h);
                { const int i = si_, dg = sdg_;
                  float q1[8], q2[8], k1[8], k2[8]; unpack8(qkv_[0], q1); unpack8(qkv_[1], q2); unpack8(qkv_[2], k1); unpack8(qkv_[3], k2);
                  float a1[8], a2[8], b1[8], b2[8];
#pragma unroll
                  for (int q = 0; q < 8; ++q) { a1[q] = q1[q] * cs[q] - q2[q] * sn[q]; a2[q] = q1[q] * sn[q] + q2[q] * cs[q]; b1[q] = 0.125f * (k1[q] * cs[q] - k2[q] * sn[q]); b2[q] = 0.125f * (k1[q] * sn[q] + k2[q] * cs[q]); }
                  *(LAS v4u*)(Qs + i * 72 + 8 * dg) = pack8(a1); *(LAS v4u*)(Qs + i * 72 + 32 + 8 * dg) = pack8(a2);
                  *(LAS v4u*)(Ks + i * 72 + 8 * dg) = pack8(b1); *(LAS v4u*)(Ks + i * 72 + 32 + 8 * dg) = pack8(b2); }
#pragma unroll
                for (int i = 0; i < 2; ++i) { const int j = si_, cg = sdg_ + 4 * i;
                    float f[8]; unpack8(vv_[i], f);
#pragma unroll
                    for (int q = 0; q < 8; ++q) VT[(8 * cg + q) * 136 + j] = (bf16)f2bf(f[q]); }
                { const int e = tid >> 3, d0 = (tid & 7) * 8; const f32x4 u0 = su_[0], u1 = su_[1]; const float f[8] = {u0.x, u0.y, u0.z, u0.w, u1.x, u1.y, u1.z, u1.w};
                  *(LAS v4u*)(STs + e * 72 + d0) = pack8(f); }
                if (h < 3) RET_LOAD(h + 1);
                FULL_SYNC();
                { const int ti = w & 3;
#pragma unroll
                  for (int k = 0; k < 2; ++k) { const int tj = 2 * (w >> 2) + k;
                      if (tj <= ti) { f32x16 a = zero16(); mma_tile<4>(a, Qs + (32 * ti + r) * 72 + 8 * hh, Ks + (32 * tj + r) * 72 + 8 * hh);
                          MFMA_SETTLE();
#pragma unroll
                          for (int rg = 0; rg < 16; ++rg) { const int i = 32 * ti + crow(rg, hh), j = 32 * tj + r; const float v = (j <= i) ? a[rg] * __expf(lg * (float)(i - j)) : 0.f; Ps[i * 136 + j] = (bf16)f2bf(v); } } } }
                FULL_SYNC();
                { const int te = w >> 2, ti = w & 3, i = 32 * ti + r;
                  f32x16 yin = zero16(), yx = zero16();
                  mma_tile_n(yin, VT + (32 * te + r) * 136 + 8 * hh, Ps + (32 * ti + r) * 136 + 8 * hh, 2 * (ti + 1));
                  mma_tile<4>(yx, STs + (32 * te + r) * 72 + 8 * hh, Qs + (32 * ti + r) * 72 + 8 * hh);
                  MFMA_SETTLE();
                  const float dq = __expf(lg * (float)(i + 1));
                  float ss = 0.f;
#pragma unroll
                  for (int rg = 0; rg < 16; ++rg) { yin[rg] += dq * yx[rg]; ss += yin[rg] * yin[rg]; }
                  ss += __shfl_xor(ss, 32);
                  if (hh == 0) exch[w * 32 + r] = ss;
                  FULL_SYNC();
                  const float rs = rsqrtf((exch[w * 32 + r] + exch[(w ^ 4) * 32 + r]) * (1.f / 64.f) + EPS);
                  const float* gn = args.in[I_RET_GN_G] + l * 256 + h * 64;
#pragma unroll
                  for (int g4 = 0; g4 < 4; ++g4) { const int e0 = 32 * te + 8 * g4 + 4 * hh;
                      const v2u gz = *(const v2u*)(proj + (size_t)(tok0 + i) * PROJ_LD + COL_G + h * 64 + e0); const f32x4 gg = *(const f32x4*)(gn + e0);
                      const float o0 = siluf_(bflo(gz.x)) * yin[4 * g4 + 0] * rs * gg.x, o1 = siluf_(bfhi(gz.x)) * yin[4 * g4 + 1] * rs * gg.y, o2 = siluf_(bflo(gz.y)) * yin[4 * g4 + 2] * rs * gg.z, o3 = siluf_(bfhi(gz.y)) * yin[4 * g4 + 3] * rs * gg.w;
                      v2u ov; ov.x = pk2(o0, o1); ov.y = pk2(o2, o3);
                      *(v2u*)(cat + (size_t)(tok0 + i) * DM + h * 64 + e0) = ov; } }
                FULL_SYNC();
            }
        }
    }
}
#undef RET_LOAD
__device__ __forceinline__ void mixer_out_ssd(const Ctx& F, const Args& args, int l) {
    const int tid = fresh_tid(), lane = tid & 63, w = __builtin_amdgcn_readfirstlane(tid >> 6), r = lane & 31, hh = lane >> 5;
    const bf16* proj = (const bf16*)(F.ws + WS_PROJ);
    bf16* cat = (bf16*)(F.ws + WS_CAT);
    LAS bf16* L16 = (LAS bf16*)F.lds;
    for (int unit = F.bid; unit < NUNIT; unit += F.G) {
        const int c = unit & 31, b = unit >> 5, tok0 = unit * 128, pos0 = c * 128; (void)b; (void)pos0;
        {
            LAS bf16* Cs = L16; LAS bf16* Mb[2] = {L16 + 128 * 136, L16 + 2 * 128 * 136}; LAS bf16* XTb[2] = {L16 + 3 * 128 * 136, L16 + 3 * 128 * 136 + 64 * 136};
            LAS float* dt_s = (LAS float*)(F.lds + 139264); LAS float* acum_s = dt_s + 1024; LAS float* exch = acum_s + 1024; LAS float* rstd_s = exch + 256;
            ssd_dt_acum(F, args, l, unit, dt_s, acum_s, nullptr, 1.44269504f);
            FULL_SYNC();
            const bf16* xact = (const bf16*)(F.ws + WS_XACT);
            const bf16* spg = (const bf16*)(F.ws + WS_SSDST) + (size_t)unit * 8 * 8192;
            float ssq = 0.f;
            const int tl = w & 3, tp = w >> 2;
            for (int g = 0; g < 2; ++g) {
                f32x16 cbt[2];
                for (int repa_ = 0; repa_ < ((REPEAT_MASK >> 15) & 1) + 1; ++repa_) {
#pragma unroll
                for (int i = 0; i < 4; ++i) { const int ll = tid & 127, ng = (tid >> 7) + 4 * i;
                    *(LAS v4u*)(Cs + ll * 136 + 8 * ng) = *(const v4u*)(xact + (size_t)(tok0 + ll) * 1024 + 768 + g * 128 + 8 * ng);
                    *(LAS v4u*)(Mb[0] + ll * 136 + 8 * ng) = *(const v4u*)(xact + (size_t)(tok0 + ll) * 1024 + 512 + g * 128 + 8 * ng); }
                FULL_SYNC();
#pragma unroll
                for (int k = 0; k < 2; ++k) { const int ts = 2 * (w >> 2) + k; cbt[k] = zero16();
                    if (ts <= tl) mma_tile<8>(cbt[k], Cs + (32 * tl + r) * 136 + 8 * hh, Mb[0] + (32 * ts + r) * 136 + 8 * hh); }
                FULL_SYNC();
                }
#define SSD_WRITE_M(head_, buf_) do { const float Dh_ = args.in[I_SSD_D][l * 8 + (head_)]; LAS bf16* M_ = Mb[buf_]; \
                    _Pragma("unroll") for (int k = 0; k < 2; ++k) { const int ts = 2 * (w >> 2) + k; \
                        if (ts <= tl) { const int s = 32 * ts + r; const float as = acum_s[(head_) * 128 + s]; \
                            const float dterm_ = (ts == tl) ? Dh_ * __builtin_amdgcn_rcpf(dt_s[(head_) * 128 + s]) : 0.f;     \
                            _Pragma("unroll") for (int q4 = 0; q4 < 4; ++q4) { const f32x4 al_ = *(LAS const f32x4*)(acum_s + (head_) * 128 + 32 * tl + 8 * q4 + 4 * hh); \
                                _Pragma("unroll") for (int j4 = 0; j4 < 4; ++j4) { const int rg = 4 * q4 + j4, ll = 32 * tl + 8 * q4 + 4 * hh + j4; \
                                    float v = cbt[k][rg] * __builtin_amdgcn_exp2f(al_[j4] - as); \
                                    if (ts == tl) { v = (s <= ll) ? v : 0.f; if (s == ll) v += dterm_; }     \
                                    M_[ll * 136 + s] = (bf16)f2bf(v); } } } } } while (0)
#define SSD_LOAD_X(head_, xv_) do { _Pragma("unroll") for (int i = 0; i < 2; ++i) xv_[i] = *(const v4u*)(xact + (size_t)(tok0 + (tid & 127)) * 1024 + (head_) * 64 + 8 * ((tid >> 7) + 4 * i)); } while (0)
#define SSD_WRITE_X(head_, buf_, xv_) do { LAS bf16* X_ = XTb[buf_]; const int ll = tid & 127; const float sc = dt_s[(head_) * 128 + ll]; \
                    _Pragma("unroll") for (int i = 0; i < 2; ++i) { const int cg = (tid >> 7) + 4 * i; float o[8]; unpack8(xv_[i], o); \
                        _Pragma("unroll") for (int q = 0; q < 8; ++q) X_[(8 * cg + q) * 136 + ll] = (bf16)f2bf(o[q] * sc); } } while (0)
                for (int repb_ = 0; repb_ < ((REPEAT_MASK >> 16) & 1) + 1; ++repb_) {
                const bool lastb_ = repb_ == ((REPEAT_MASK >> 16) & 1);
                { v4u xv[2]; SSD_LOAD_X(g * 4, xv); SSD_WRITE_M(g * 4, 0); SSD_WRITE_X(g * 4, 0, xv); }
                FULL_SYNC();
                const int ll = 32 * tl + r;
                bf16x8 spn[8]; v2u zn[4];
#define SSD_PREFETCH(head_) do { _Pragma("unroll") for (int ks = 0; ks < 8; ++ks) spn[ks] = *(const bf16x8*)(spg + (size_t)(head_) * 8192 + (32 * tp + r) * 128 + 16 * ks + 8 * hh); \
                    const v2u* zp_ = (const v2u*)(proj + (size_t)(tok0 + ll) * PROJ_LD + COL_Z + (head_) * 64 + 32 * tp + 4 * hh); zn[0] = zp_[0]; zn[1] = zp_[2]; zn[2] = zp_[4]; zn[3] = zp_[6]; } while (0)
                SSD_PREFETCH(g * 4);
#pragma unroll 1
                for (int hl = 0; hl < 4; ++hl) { const int head = g * 4 + hl, cur = hl & 1;
                    bf16x8 spf[8]; v2u zz[4];
#pragma unroll
                    for (int ks = 0; ks < 8; ++ks) spf[ks] = spn[ks];
#pragma unroll
                    for (int q = 0; q < 4; ++q) zz[q] = zn[q];
                    v4u xv[2]; if (hl < 3) { SSD_LOAD_X(head + 1, xv); SSD_PREFETCH(head + 1); }
                    f32x16 yd = zero16(), yo = zero16();
                    mma_tile_n(yd, XTb[cur] + (32 * tp + r) * 136 + 8 * hh, Mb[cur] + (32 * tl + r) * 136 + 8 * hh, 2 * (tl + 1));
                    { LAS const bf16* cp = Cs + (32 * tl + r) * 136 + 8 * hh;
#pragma unroll
                      for (int ks = 0; ks < 8; ++ks) yo = MFMA32(spf[ks], ldsv8(cp + 16 * ks), yo); }
                    MFMA_SETTLE();
                    const float ea = __builtin_amdgcn_exp2f(acum_s[head * 128 + ll]);
#pragma unroll
                    for (int g4 = 0; g4 < 4; ++g4) { const int p0 = 32 * tp + 8 * g4 + 4 * hh;
                        const float y0 = (yd[4 * g4 + 0] + ea * yo[4 * g4 + 0]) * siluf_(bflo(zz[g4].x)), y1 = (yd[4 * g4 + 1] + ea * yo[4 * g4 + 1]) * siluf_(bfhi(zz[g4].x)),
                                    y2 = (yd[4 * g4 + 2] + ea * yo[4 * g4 + 2]) * siluf_(bflo(zz[g4].y)), y3 = (yd[4 * g4 + 3] + ea * yo[4 * g4 + 3]) * siluf_(bfhi(zz[g4].y));
                        if (lastb_) ssq += y0 * y0 + y1 * y1 + y2 * y2 + y3 * y3;
                        v2u ov; ov.x = pk2(y0, y1); ov.y = pk2(y2, y3);
                        *(v2u*)(cat + (size_t)(tok0 + ll) * DM + 256 + head * 64 + p0) = ov; }
                    if (hl < 3) { SSD_WRITE_M(head + 1, cur ^ 1); SSD_WRITE_X(head + 1, cur ^ 1, xv); }
                    FULL_SYNC();
                }
                }
#undef SSD_WRITE_M
#undef SSD_LOAD_X
#undef SSD_WRITE_X
#undef SSD_PREFETCH
            }
            ssq += __shfl_xor(ssq, 32);
            if (hh == 0) exch[w * 32 + r] = ssq;
            VM_WAIT();
            FULL_SYNC();
            if (w < 4 && hh == 0) rstd_s[32 * w + r] = rsqrtf((exch[w * 32 + r] + exch[(w + 4) * 32 + r]) * (1.f / 512.f) + EPS);
            FULL_SYNC();
            const float* ng = args.in[I_SSD_NORM_G] + l * 512;
            { v4u nv[16];
#pragma unroll
              for (int i = 0; i < 16; ++i) { const int v = tid + 512 * i, ll_ = v >> 6, c8 = (v & 63) * 8; nv[i] = *(const v4u*)(cat + (size_t)(tok0 + ll_) * DM + 256 + c8); }
              const int c8 = (tid & 63) * 8; const f32x4 g0 = *(const f32x4*)(ng + c8), g1 = *(const f32x4*)(ng + c8 + 4);
#pragma unroll
              for (int i = 0; i < 16; ++i) { const int v = tid + 512 * i, ll_ = v >> 6; float f[8]; unpack8(nv[i], f); const float rs = rstd_s[ll_];
                f[0] *= rs * g0.x; f[1] *= rs * g0.y; f[2] *= rs * g0.z; f[3] *= rs * g0.w; f[4] *= rs * g1.x; f[5] *= rs * g1.y; f[6] *= rs * g1.z; f[7] *= rs * g1.w;
                *(v4u*)(cat + (size_t)(tok0 + ll_) * DM + 256 + c8) = pack8(f); } }
            FULL_SYNC();
        }
    }
}
__device__ __forceinline__ void mixer_out_s5(const Ctx& F, const Args& args, int l) {
    const int tid = fresh_tid(), lane = tid & 63, w = __builtin_amdgcn_readfirstlane(tid >> 6), r = lane & 31, hh = lane >> 5;
    const bf16* proj = (const bf16*)(F.ws + WS_PROJ);
    bf16* cat = (bf16*)(F.ws + WS_CAT);
    LAS bf16* L16 = (LAS bf16*)F.lds;
    for (int unit = F.bid; unit < NUNIT; unit += F.G) {
        const int c = unit & 31, b = unit >> 5, tok0 = unit * 128, pos0 = c * 128; (void)b; (void)pos0;
        {
            LAS unsigned char* slab = F.lds + w * 17152; LAS float* Bu = (LAS float*)slab; LAS unsigned char* xs = slab + 8448;
            const unsigned char* tab = F.ws + WS_S5TAB + (size_t)l * S5TAB_LAYER;
            float one = 1.f; asm volatile("" : "+v"(one));
            for (int rd = 0; rd < 2; ++rd) { const int g = w + 8 * rd;
                const f32x4 lam = ((const f32x4*)tab)[g * 64 + lane];
                bf16x8 bfr[4], cfr[8];
#pragma unroll
                for (int nt = 0; nt < 4; ++nt) bfr[nt] = *(const bf16x8*)((const bf16*)(tab + S5TAB_BBAR) + (size_t)(g * 128 + 32 * nt + r) * 16 + 8 * hh);
#pragma unroll
                for (int ks = 0; ks < 8; ++ks) cfr[ks] = *(const bf16x8*)((const bf16*)(tab + S5TAB_CT) + (size_t)(g * 32 + r) * 128 + 16 * ks + 8 * hh);
                const f32x2 x0 = ((const f32x2*)(F.ws + WS_S5ST))[(size_t)(unit * 16 + g) * 64 + lane];
                float xr = x0.x, xi = x0.y;
                for (int s = 0; s < 4; ++s) {
                    const bf16x8 af = *(const bf16x8*)(proj + (size_t)(tok0 + 32 * s + r) * PROJ_LD + COL_U + g * 16 + 8 * hh);
                    f32x16 acc[4];
#pragma unroll
                    for (int nt = 0; nt < 4; ++nt) acc[nt] = MFMA32(af, bfr[nt], zero16());
                    __builtin_amdgcn_sched_barrier(0); asm volatile("s_nop 15"); asm volatile("s_nop 15"); asm volatile("s_nop 15"); asm volatile("s_nop 15"); __builtin_amdgcn_sched_barrier(0);
#pragma unroll
                    for (int half = 0; half < 2; ++half) {
#pragma unroll
                        for (int nt = 0; nt < 4; ++nt)
#pragma unroll
                            for (int q = 0; q < 8; ++q) { const int rg = 8 * half + q; Bu[(crow(rg, hh) - 16 * half) * 132 + 32 * nt + r] = acc[nt][rg] * one; }
                        LDS_WAIT();
#pragma unroll 8
                        for (int t = 0; t < 16; ++t) { const float br = Bu[t * 132 + lane], bi = Bu[t * 132 + 64 + lane];
                            const float nr = lam.x * xr - lam.y * xi + br, ni = lam.x * xi + lam.y * xr + bi; xr = nr; xi = ni;
                            LAS bf16* xrow = (LAS bf16*)(xs + (16 * half + t) * 272); xrow[lane] = (bf16)f2bf(xr); xrow[64 + lane] = (bf16)f2bf(xi); }
                        LDS_WAIT();
                    }
                    f32x16 y = zero16();
#pragma unroll
                    for (int ks = 0; ks < 8; ++ks) y = MFMA32(cfr[ks], *(LAS const bf16x8*)(xs + r * 272 + (16 * ks + 8 * hh) * 2), y);
                    MFMA_SETTLE();
                    { const int tok = tok0 + 32 * s + r; const bf16* urow = proj + (size_t)tok * PROJ_LD + COL_U + g * 16; const float* Dg = args.in[I_S5_D] + l * 256 + g * 16;
#pragma unroll
                      for (int q = 0; q < 2; ++q) { const int c0 = 8 * q + 4 * hh; const v2u uv = *(const v2u*)(urow + c0); const f32x4 dd = *(const f32x4*)(Dg + c0);
                          const float o0 = gelu_tanh(y[4 * q + 0] + dd.x * bflo(uv.x)), o1 = gelu_tanh(y[4 * q + 1] + dd.y * bfhi(uv.x)), o2 = gelu_tanh(y[4 * q + 2] + dd.z * bflo(uv.y)), o3 = gelu_tanh(y[4 * q + 3] + dd.w * bfhi(uv.y));
                          v2u ov; ov.x = pk2(o0, o1); ov.y = pk2(o2, o3);
                          *(v2u*)(cat + (size_t)tok * DM + 768 + g * 16 + c0) = ov; } }
                    LDS_WAIT();
                }
            }
            VM_WAIT();
            FULL_SYNC();
            LAS bf16* Gs = L16;
#pragma unroll
            for (int i = 0; i < 8; ++i) { const int v = tid + 512 * i, t = v >> 5, c8 = (v & 31) * 8; *(LAS v4u*)(Gs + t * 264 + c8) = *(const v4u*)(cat + (size_t)(tok0 + t) * DM + 768 + c8); }
            FULL_SYNC();
            const bf16* wg = (const bf16*)(F.ws + WS_WGLU) + (size_t)l * 65536;
            f32x16 acc[4];
#pragma unroll
            for (int tt = 0; tt < 4; ++tt) acc[tt] = zero16();
#pragma unroll 4
            for (int ks = 0; ks < 16; ++ks) { const bf16x8 bf = *(const bf16x8*)(wg + (size_t)(32 * w + r) * 256 + 16 * ks + 8 * hh);
#pragma unroll
                for (int tt = 0; tt < 4; ++tt) acc[tt] = MFMA32(bf, ldsv8(Gs + (32 * tt + r) * 264 + 16 * ks + 8 * hh), acc[tt]); }
            MFMA_SETTLE();
            const float* bgl = args.in[I_S5_BGLU] + l * 256;
#pragma unroll
            for (int g4 = 0; g4 < 4; ++g4) { const int j0 = 32 * w + 8 * g4 + 4 * hh; const f32x4 bj = *(const f32x4*)(bgl + j0);
#pragma unroll
                for (int tt = 0; tt < 4; ++tt) { const int t = 32 * tt + r; const v2u gv = *(LAS const v2u*)(Gs + t * 264 + j0);
                    const float o0 = bflo(gv.x) * sigmoidf_(acc[tt][4 * g4 + 0] + bj.x), o1 = bfhi(gv.x) * sigmoidf_(acc[tt][4 * g4 + 1] + bj.y),
                                o2 = bflo(gv.y) * sigmoidf_(acc[tt][4 * g4 + 2] + bj.z), o3 = bfhi(gv.y) * sigmoidf_(acc[tt][4 * g4 + 3] + bj.w);
                    v2u ov; ov.x = pk2(o0, o1); ov.y = pk2(o2, o3);
                    *(v2u*)(cat + (size_t)(tok0 + t) * DM + 768 + j0) = ov; } }
            FULL_SYNC();
        }
    }
}
__device__ __forceinline__ void mixer_outputs(const Ctx& F, const Args& args, int l) {
    for (int rep_ = 0; rep_ < ((REPEAT_MASK >> 8) & 1) + 1; ++rep_) mixer_out_ret(F, args, l);
    for (int rep_ = 0; rep_ < ((REPEAT_MASK >> 9) & 1) + 1; ++rep_) mixer_out_ssd(F, args, l);
    for (int rep_ = 0; rep_ < ((REPEAT_MASK >> 10) & 1) + 1; ++rep_) mixer_out_s5(F, args, l);
}


struct KvOrder {
    const char* ws; int G, c;
    __device__ __forceinline__ bool next(int i, Unit& u) const {
        const int L = i * G + c; if (L >= 128) return false;
        const int layer = L >> 6, rem = L & 63, kind = rem >> 5, idx = rem & 31;
        if (kind == 0) { u.pm = idx >> 2; u.pn = idx & 3; } else { u.pm = idx >> 3; u.pn = idx & 7; }
        u.z = layer * 2 + kind; return true;
    }
    __device__ __forceinline__ const char* a_base(const Unit& u) const { return (u.z & 1) ? ws + WS_WV + ((size_t)(u.z >> 1) * DM + u.pm * 256) * DM * 2 : ws + WS_MN + (size_t)u.pm * 256 * DM * 2; }
    __device__ __forceinline__ const char* b_base(const Unit& u) const { return (u.z & 1) ? ws + WS_MN + (size_t)u.pn * 256 * DM * 2 : ws + WS_WK + ((size_t)(u.z >> 1) * DM + u.pn * 256) * DM * 2; }
    __device__ __forceinline__ void a_voff(int, const Unit&, int K_, unsigned (&voffA)[2][2], int tid) const { pg8::dense_voff(K_, voffA, tid); }
    static constexpr int A_AUX = 0; static constexpr bool PUBLISH = false, POLL = false;
};
struct EpiKV {
    unsigned char* ws;
    __device__ __forceinline__ void operator()(const f32x4 (&acc)[2][2][4][2], const Unit& u, int wr, int wc, int fr, int fq) const {
        const int layer = u.z >> 1; const bool isv = u.z & 1;
        bf16* O = isv ? (bf16*)(ws + WS_VT) + (size_t)layer * DM * TM : (bf16*)(ws + WS_KB) + (size_t)layer * TM * DM; const int ldc = isv ? TM : DM;
        const int row0 = u.pm * 256 + wr * 64 + fr, col0 = u.pn * 256 + wc * 32 + 8 * fq;
#pragma unroll
        for (int ai = 0; ai < 2; ++ai)
#pragma unroll
            for (int m = 0; m < 4; ++m) { bf16* rowp = O + (size_t)(row0 + ai * 128 + m * 16) * ldc + col0;
#pragma unroll
                for (int bj = 0; bj < 2; ++bj) { const f32x4 v0 = acc[ai][bj][m][0], v1 = acc[ai][bj][m][1];
                    v4u w; w.x = cvt_pk_bf16(v0[0], v0[1]); w.y = cvt_pk_bf16(v0[2], v0[3]); w.z = cvt_pk_bf16(v1[0], v1[1]); w.w = cvt_pk_bf16(v1[2], v1[3]);
                    *(v4u*)(rowp + bj * 128) = w; } }
    }
};

__device__ __forceinline__ void attn_phase(const Ctx& F, int l, const pg8::DenseOrder& QS) {
    const int tid = fresh_tid(), lane = tid & 63, w = __builtin_amdgcn_readfirstlane(tid >> 6), r = lane & 31, hh = lane >> 5;
    const bf16* Q = (const bf16*)(F.ws + WS_Q); bf16* O = (bf16*)(F.ws + WS_CAT);
    const bf16* KB = (const bf16*)(F.ws + WS_KB) + (size_t)l * TM * DM; const bf16* VTg = (const bf16*)(F.ws + WS_VT) + (size_t)l * DM * TM;
    LAS bf16* L16 = (LAS bf16*)F.lds;
    constexpr int HALF_EL = 33792;
    for (int ui = 0;; ++ui) {
        Unit uq; if (!QS.next(ui, uq)) break;
        const int b = uq.pm >> 4, qt = uq.pm & 15, h = uq.pn;
        const int q0 = b * SEQ + qt * 256 + 32 * w;
#pragma unroll 4
        for (int i = 0; i < 16; ++i) { const int v = tid + 512 * i, key = v >> 5, d8 = (v & 31) * 8;
            *(LAS v4u*)(L16 + (key >> 7) * HALF_EL + (key & 127) * 264 + d8) = *(const v4u*)(KB + (size_t)(b * MEMLEN + key) * DM + h * 256 + d8); }
        FULL_SYNC();
        f32x16 S[8];
#pragma unroll
        for (int kt = 0; kt < 8; ++kt) S[kt] = zero16();
        {
            const bf16* qp = Q + (size_t)(q0 + r) * DM + h * 256 + 8 * hh;
            LAS const bf16* kp0 = L16 + r * 264 + 8 * hh;
#pragma unroll 2
            for (int ks = 0; ks < 16; ++ks) {
                const bf16x8 qf = *(const bf16x8*)(qp + 16 * ks);
#pragma unroll
                for (int kt = 0; kt < 8; ++kt) S[kt] = MFMA32(ldsv8(kp0 + (kt >> 2) * HALF_EL + 32 * (kt & 3) * 264 + 16 * ks), qf, S[kt]);
            }
        }
        FULL_SYNC();
#pragma unroll 4
        for (int i = 0; i < 16; ++i) { const int v = tid + 512 * i, d = v >> 5, k8 = (v & 31) * 8;
            const v4u vv = *(const v4u*)(VTg + (size_t)(h * 256 + d) * TM + b * MEMLEN + k8);
            LAS v2u* dst = (LAS v2u*)(L16 + (k8 >> 7) * HALF_EL + d * 132 + (k8 & 127));
            dst[0] = (v2u){vv.x, vv.y}; dst[1] = (v2u){vv.z, vv.w}; }
        float mx = -1e30f;
#pragma unroll
        for (int kt = 0; kt < 8; ++kt)
#pragma unroll
            for (int rg = 0; rg < 16; ++rg) mx = fmaxf(mx, S[kt][rg]);
        mx = fmaxf(mx, __shfl_xor(mx, 32));
        float sum = 0.f;
        bf16x8 pf[8][2];
#pragma unroll
        for (int kt = 0; kt < 8; ++kt) {
#pragma unroll
            for (int rg = 0; rg < 16; ++rg) { S[kt][rg] = __builtin_amdgcn_exp2f(S[kt][rg] - mx); sum += S[kt][rg]; }
#pragma unroll
            for (int s = 0; s < 2; ++s) { v4u pw; pw.x = pk2(S[kt][8 * s + 0], S[kt][8 * s + 1]); pw.y = pk2(S[kt][8 * s + 2], S[kt][8 * s + 3]); pw.z = pk2(S[kt][8 * s + 4], S[kt][8 * s + 5]); pw.w = pk2(S[kt][8 * s + 6], S[kt][8 * s + 7]);
                pf[kt][s] = __builtin_bit_cast(bf16x8, pw); } }
        sum += __shfl_xor(sum, 32);
        const float inv = 1.f / sum;
        FULL_SYNC();
#pragma unroll 1
        for (int dt = 0; dt < 8; ++dt) {
            f32x16 o = zero16();
#pragma unroll
            for (int kt = 0; kt < 8; ++kt)
#pragma unroll
                for (int s = 0; s < 2; ++s) {
                    LAS const bf16* vp = L16 + (kt >> 2) * HALF_EL + (32 * dt + r) * 132 + 32 * (kt & 3) + 16 * s + 4 * hh;
                    const v2u lo = *(LAS const v2u*)vp, hi = *(LAS const v2u*)(vp + 8);
                    const v4u av = {lo.x, lo.y, hi.x, hi.y};
                    o = MFMA32(__builtin_bit_cast(bf16x8, av), pf[kt][s], o); }
            MFMA_SETTLE();
#pragma unroll
            for (int g4 = 0; g4 < 4; ++g4) { v2u ov; ov.x = pk2(o[4 * g4 + 0] * inv, o[4 * g4 + 1] * inv); ov.y = pk2(o[4 * g4 + 2] * inv, o[4 * g4 + 3] * inv);
                *(v2u*)(O + (size_t)(q0 + r) * DM + h * 256 + 32 * dt + 8 * g4 + 4 * hh) = ov; }
        }
        FULL_SYNC();
    }
}

typedef float f32x4v __attribute__((ext_vector_type(4)));
__device__ __forceinline__ void split_hi_lo(const f32x4 a, const f32x4 b, bf16x8& hi, bf16x8& lo) {
    const float f[8] = {a.x, a.y, a.z, a.w, b.x, b.y, b.z, b.w}; unsigned h[8], lw[8];
#pragma unroll
    for (int q = 0; q < 8; ++q) { h[q] = f2bf(f[q]); lw[q] = f2bf(f[q] - bf2f(h[q])); }
    v4u H = {h[0] | (h[1] << 16), h[2] | (h[3] << 16), h[4] | (h[5] << 16), h[6] | (h[7] << 16)}, Lw = {lw[0] | (lw[1] << 16), lw[2] | (lw[3] << 16), lw[4] | (lw[5] << 16), lw[6] | (lw[7] << 16)};
    hi = __builtin_bit_cast(bf16x8, H); lo = __builtin_bit_cast(bf16x8, Lw);
}
__device__ __forceinline__ void route_phase(const Ctx& F, const Args& args, int l, unsigned* ctl) {
    for (int rep_ = 0; rep_ < ((REPEAT_MASK >> 6) & 1) + 1; ++rep_) convert_moe_weights(F, args, l);
    FULL_SYNC();
    const int tid = fresh_tid(), lane = tid & 63, w = __builtin_amdgcn_readfirstlane(tid >> 6), c16 = lane & 15, q = lane >> 4;
    LAS unsigned* lcnt = (LAS unsigned*)F.lds; LAS unsigned* lbase = lcnt + 32;
    const bf16* hbp = (const bf16*)(F.ws + WS_HB);
    const bf16* wr = (const bf16*)(F.ws + WS_WR) + (size_t)l * 2 * 48 * DM;
    const float* ssq = (const float*)(F.ws + WS_SSQ2) + (size_t)l * T * 16;
    unsigned* cnt = ctl + CW_CNT + 64 * l;
    unsigned* tok_list = (unsigned*)(F.ws + WS_TOKLIST); float* slot_w = (float*)(F.ws + WS_SLOTW); float* slot_r = (float*)(F.ws + WS_SLOTR); unsigned* tok_slot = (unsigned*)(F.ws + WS_TOKSLOT);
    LAS unsigned char* wl = F.lds + 1024;
    for (int i = tid; i < 48 * 128; i += NTHREADS) { const int row = i >> 7, c = i & 127; *(LAS v4u*)(wl + row * 2064 + c * 16) = *(const v4u*)(wr + (size_t)row * DM + c * 8); }
    for (int tile0 = F.bid * 8; tile0 < T / 16; tile0 += F.G * 8) {
        if (tid < 32) lcnt[tid] = 0u;
        FULL_SYNC();
        const int tok = (tile0 + w) * 16 + c16;
        f32x4 acc[3];
#pragma unroll
        for (int mt = 0; mt < 3; ++mt) acc[mt] = (f32x4){0.f, 0.f, 0.f, 0.f};
        const bf16* hp = hbp + (size_t)tok * DM + 8 * q;
        bf16x8 bh[32];
#pragma unroll
        for (int ks = 0; ks < 32; ++ks) bh[ks] = *(const bf16x8*)(hp + 32 * ks);
#pragma unroll
        for (int ks = 0; ks < 32; ++ks) {
#pragma unroll
            for (int mt = 0; mt < 3; ++mt) { const bf16x8 ah = *(LAS const bf16x8*)(wl + (16 * mt + c16) * 2064 + 64 * ks + 16 * q);
                acc[mt] = __builtin_amdgcn_mfma_f32_16x16x32_bf16(ah, bh[ks], acc[mt], 0, 0, 0); } }
        MFMA_SETTLE();
        const float rs = rsqrtf(ssq16(ssq + (size_t)tok * 16) * (1.f / DM) + EPS);
        float gl[4];
#pragma unroll
        for (int i = 0; i < 4; ++i) gl[i] = acc[2][i] * rs + args.in[I_B_RG][l * 4 + i];
        int gsel = 0; float gm = gl[0];
#pragma unroll
        for (int i = 1; i < 4; ++i) if (gl[i] > gm) { gm = gl[i]; gsel = i; }
        float gs = 0.f;
#pragma unroll
        for (int i = 0; i < 4; ++i) gs += __expf(gl[i] - gm);
        const float pg = 1.f / gs;
        const bool own = (q == gsel);
        unsigned e1 = 0, e2 = 0, lp1 = 0, lp2 = 0; float g1 = 0.f, g2 = 0.f;
        if (own) {
            float el[8];
#pragma unroll
            for (int i = 0; i < 8; ++i) el[i] = acc[i >> 2][i & 3] * rs + args.in[I_B_RE][l * 32 + q * 8 + i];
            int i1 = 0; float m1 = el[0];
#pragma unroll
            for (int i = 1; i < 8; ++i) if (el[i] > m1) { m1 = el[i]; i1 = i; }
            int i2 = -1; float m2 = -3e38f;
#pragma unroll
            for (int i = 0; i < 8; ++i) if (i != i1 && el[i] > m2) { m2 = el[i]; i2 = i; }
            const float p1 = 1.f / (1.f + __expf(m2 - m1));
            g1 = pg * p1; g2 = pg * (1.f - p1);
            e1 = (unsigned)(q * 8 + i1); e2 = (unsigned)(q * 8 + i2);
            lp1 = __hip_atomic_fetch_add(lcnt + e1, 1u, __ATOMIC_RELAXED, __HIP_MEMORY_SCOPE_WORKGROUP); lp2 = __hip_atomic_fetch_add(lcnt + e2, 1u, __ATOMIC_RELAXED, __HIP_MEMORY_SCOPE_WORKGROUP);
        }
        FULL_SYNC();
        if (tid < 32) lbase[tid] = atomicAdd(cnt + tid, lcnt[tid]);
        FULL_SYNC();
        if (own) {
            const unsigned p1 = lbase[e1] + lp1, p2 = lbase[e2] + lp2;
            tok_list[(size_t)e1 * T + p1] = (unsigned)tok; slot_w[(size_t)e1 * T + p1] = g1; slot_r[(size_t)e1 * T + p1] = rs;
            tok_list[(size_t)e2 * T + p2] = (unsigned)tok; slot_w[(size_t)e2 * T + p2] = g2; slot_r[(size_t)e2 * T + p2] = rs;
            tok_slot[(size_t)tok * 2] = (e1 << 20) | p1; tok_slot[(size_t)tok * 2 + 1] = (e2 << 20) | p2;
        }
        FULL_SYNC();
    }
}

struct MoeMap { LAS unsigned* rowtok; LAS int* ntiles; LAS int* first; LAS int* cnts; LAS unsigned char* te; };
__device__ __forceinline__ MoeMap moe_map_ptrs(const Ctx& F) {
    MoeMap m; m.rowtok = (LAS unsigned*)(F.lds + MOE_LDS); LAS int* base = (LAS int*)(F.lds + MOE_LDS + 8192);
    m.ntiles = base; m.first = base + 1; m.cnts = base + 34; m.te = (LAS unsigned char*)(base + 66); return m;
}
__device__ __forceinline__ void moe_map_build(const Ctx& F, const MoeMap& m, unsigned* cnt) {
    const int tid = fresh_tid();
    if (tid < 32) m.cnts[tid] = (int)xb_ld(cnt + tid);
    FULL_SYNC();
    if (tid == 0) { int a = 0; for (int e = 0; e < 32; ++e) { m.first[e] = a; a += (m.cnts[e] + 255) >> 8; } m.first[32] = a; *m.ntiles = a; }
    FULL_SYNC();
    if (tid < 32) { for (int t = m.first[tid]; t < m.first[tid + 1]; ++t) m.te[t] = (unsigned char)tid; }
    FULL_SYNC();
}
struct MoeGU {
    const char* hb; const char* wgu; MoeMap m; int G, c; unsigned* cnt;
    static constexpr int A_AUX = 0; static constexpr bool PUBLISH = true, POLL = false;
    __device__ __forceinline__ void publish(int pm) const { if ((threadIdx.x & 63) == 0) (void)xb_add(cnt + 64 * pm, 1u); }
    __device__ __forceinline__ void done_last(int pm) const { asm volatile("s_waitcnt vmcnt(0)" ::: "memory"); publish(pm); }
    __device__ __forceinline__ bool next(int i, Unit& u) const { const int L = i * G + c; if (L >= *m.ntiles * 4) return false; u.pm = L >> 2; u.pn = L & 3; u.z = m.te[u.pm]; return true; }
    __device__ __forceinline__ const char* a_base(const Unit&) const { return hb; }
    __device__ __forceinline__ const char* b_base(const Unit& u) const { return wgu + ((size_t)u.z * 1024 + u.pn * 256) * DM * 2; }
    __device__ __forceinline__ void a_voff(int i, const Unit&, int K_, unsigned (&voffA)[2][2], int tid) const {
#pragma unroll
        for (int j = 0; j < 2; ++j) { int R, C; pg8::stage_rc(tid * 16 + j * 8192, R, C);
            voffA[0][j] = (m.rowtok[i * 256 + R] * (unsigned)K_ + (unsigned)C) * 2u; voffA[1][j] = (m.rowtok[i * 256 + 128 + R] * (unsigned)K_ + (unsigned)C) * 2u; }
    }
};
struct MoeDown {
    const char* hmid; const char* wd; MoeMap m; int G, c; unsigned* cnt; unsigned* tmo;
    static constexpr bool PUBLISH = false, POLL = true; static constexpr int A_AUX = 16;
    __device__ __forceinline__ bool next(int i, Unit& u) const {
        const int nU = *m.ntiles * 4, r = nU % G, idle = G - r; int L;
        if (c >= r) L = i < 2 ? (c - r) + i * idle : 2 * idle + c + (i - 2) * G; else L = 2 * idle + c + i * G;
        if (L >= nU) return false; u.pm = L >> 2; u.pn = L & 3; u.z = m.te[u.pm]; return true; }
    __device__ __forceinline__ unsigned poll(const Unit& u) const { return threadIdx.x < 64 ? xb_ld(cnt + 64 * u.pm) : 0u; }
    __device__ __forceinline__ void a_ready(const Unit& u, unsigned pv) const {
        if (threadIdx.x < 64) { unsigned sp = 0;
            if ((unsigned)__builtin_amdgcn_readfirstlane(pv) < 32u)
            while ((unsigned)__builtin_amdgcn_readfirstlane(xb_ld(cnt + 64 * u.pm)) < 32u) { __builtin_amdgcn_s_sleep(1);
                if ((++sp & 255u) == 0u) { if (xb_ld(tmo)) break; if (sp > XB_SPIN_CAP) { if (threadIdx.x == 0) atomicAdd(tmo, 1u); break; } } } }
        asm volatile("" ::: "memory"); __builtin_amdgcn_s_barrier(); asm volatile("" ::: "memory");
    }
    __device__ __forceinline__ const char* a_base(const Unit& u) const { return hmid + (size_t)u.pm * 256 * DEXP * 2; }
    __device__ __forceinline__ const char* b_base(const Unit& u) const { return wd + ((size_t)u.z * 1024 + u.pn * 256) * DEXP * 2; }
    __device__ __forceinline__ void a_voff(int, const Unit&, int K_, unsigned (&voffA)[2][2], int tid) const { pg8::dense_voff(K_, voffA, tid); }
};
struct EpiGateUp {
    bf16* hmid; const float* slot_r; MoeMap m;
    __device__ __forceinline__ void operator()(const f32x4 (&acc)[2][2][4][2], const Unit& u, int wr, int wc, int fr, int fq) const {
        const int e = u.z, lrow0 = (u.pm - m.first[e]) * 256 + wr * 64 + fr, col0 = u.pn * 128 + wc * 32 + 8 * fq;
#pragma unroll
        for (int ai = 0; ai < 2; ++ai)
#pragma unroll
            for (int mm = 0; mm < 4; ++mm) { const int lr = lrow0 + ai * 128 + mm * 16; const float rs = slot_r[(size_t)e * T + lr];
                const f32x4 g0 = acc[ai][0][mm][0] * rs, g1 = acc[ai][0][mm][1] * rs, u0 = acc[ai][1][mm][0] * rs, u1 = acc[ai][1][mm][1] * rs;
                v4u w; w.x = cvt_pk_bf16(siluf_(g0[0]) * u0[0], siluf_(g0[1]) * u0[1]); w.y = cvt_pk_bf16(siluf_(g0[2]) * u0[2], siluf_(g0[3]) * u0[3]);
                w.z = cvt_pk_bf16(siluf_(g1[0]) * u1[0], siluf_(g1[1]) * u1[1]); w.w = cvt_pk_bf16(siluf_(g1[2]) * u1[2], siluf_(g1[3]) * u1[3]);
                { bf16* p_ = hmid + (size_t)(m.first[e] * 256 + lr) * DEXP + col0; asm volatile("global_store_dwordx4 %0, %1, off sc1\n\ts_nop 1" :: "v"(p_), "v"(w) : "memory"); } }
    }
};
struct EpiDown {
    bf16* ybuf; const float* slot_w; MoeMap m;
    __device__ __forceinline__ void operator()(const f32x4 (&acc)[2][2][4][2], const Unit& u, int wr, int wc, int fr, int fq) const {
        const int e = u.z, lrow0 = (u.pm - m.first[e]) * 256 + wr * 64 + fr, col0 = u.pn * 256 + wc * 32 + 8 * fq;
#pragma unroll
        for (int ai = 0; ai < 2; ++ai)
#pragma unroll
            for (int mm = 0; mm < 4; ++mm) { const int lr = lrow0 + ai * 128 + mm * 16; const float s = slot_w[(size_t)e * T + lr];
                bf16* rowp = ybuf + (size_t)(m.first[e] * 256 + lr) * DM + col0;
#pragma unroll
                for (int bj = 0; bj < 2; ++bj) { const f32x4 v0 = acc[ai][bj][mm][0] * s, v1 = acc[ai][bj][mm][1] * s;
                    v4u w; w.x = cvt_pk_bf16(v0[0], v0[1]); w.y = cvt_pk_bf16(v0[2], v0[3]); w.z = cvt_pk_bf16(v1[0], v1[1]); w.w = cvt_pk_bf16(v1[2], v1[3]);
                    *(v4u*)(rowp + bj * 128) = w; } }
    }
};
__device__ __forceinline__ void combine_phase(const Ctx& F, const Args& args, int l, const MoeMap& m) {
    const int tid = fresh_tid(), lane = tid & 63, w = __builtin_amdgcn_readfirstlane(tid >> 6);
    const int gw = F.bid * NWAVES + w, NGW = F.G * NWAVES;
    const unsigned* tok_slot = (const unsigned*)(F.ws + WS_TOKSLOT); const bf16* ybuf = (const bf16*)(F.ws + WS_YBUF);
    bf16* hb = (bf16*)(F.ws + WS_HB); float* ssq0 = (float*)(F.ws + WS_SSQ0) + (size_t)(l + 1) * T;
    const float* gfin = args.in[I_NORM_FINAL_G];
    constexpr int NB = 4;
    for (int tok0 = gw * NB; tok0 < T; tok0 += NGW * NB) {
        size_t r0[NB], r1[NB];
#pragma unroll
        for (int k = 0; k < NB; ++k) { const unsigned s0 = tok_slot[(size_t)(tok0 + k) * 2], s1 = tok_slot[(size_t)(tok0 + k) * 2 + 1];
            r0[k] = (size_t)(m.first[s0 >> 20] * 256 + (int)(s0 & 0xFFFFFu)); r1[k] = (size_t)(m.first[s1 >> 20] * 256 + (int)(s1 & 0xFFFFFu)); }
        v4u hv[NB][2], ya[NB][2], yb[NB][2];
#pragma unroll
        for (int k = 0; k < NB; ++k)
#pragma unroll
            for (int j = 0; j < 2; ++j) { const int col = 8 * (lane + 64 * j);
                hv[k][j] = *(const v4u*)(hb + (size_t)(tok0 + k) * DM + col); ya[k][j] = __builtin_nontemporal_load((const v4u*)(ybuf + r0[k] * DM + col)); yb[k][j] = __builtin_nontemporal_load((const v4u*)(ybuf + r1[k] * DM + col)); }
#pragma unroll
        for (int k = 0; k < NB; ++k) { const int tok = tok0 + k;
            float v[16]; float ss = 0.f;
#pragma unroll
            for (int j = 0; j < 2; ++j) { float hh_[8], a[8], bb[8]; unpack8(hv[k][j], hh_); unpack8(ya[k][j], a); unpack8(yb[k][j], bb);
#pragma unroll
                for (int q = 0; q < 8; ++q) { v[8 * j + q] = hh_[q] + a[q] + bb[q]; ss += v[8 * j + q] * v[8 * j + q]; } }
            ss = wave_sum(ss);
            if (l == NL - 1) {
                const float rs = rsqrtf(ss * (1.f / DM) + EPS);
#pragma unroll
                for (int j = 0; j < 2; ++j) { const int col = 8 * (lane + 64 * j); const f32x4 g0 = *(const f32x4*)(gfin + col), g1 = *(const f32x4*)(gfin + col + 4);
                    __builtin_nontemporal_store((f32x4){v[8 * j] * rs * g0.x, v[8 * j + 1] * rs * g0.y, v[8 * j + 2] * rs * g0.z, v[8 * j + 3] * rs * g0.w}, (f32x4*)(args.out + (size_t)tok * DM + col));
                    __builtin_nontemporal_store((f32x4){v[8 * j + 4] * rs * g1.x, v[8 * j + 5] * rs * g1.y, v[8 * j + 6] * rs * g1.z, v[8 * j + 7] * rs * g1.w}, (f32x4*)(args.out + (size_t)tok * DM + col + 4)); }
            } else {
#pragma unroll
                for (int j = 0; j < 2; ++j) { const int col = 8 * (lane + 64 * j);
                    const float f[8] = {v[8 * j], v[8 * j + 1], v[8 * j + 2], v[8 * j + 3], v[8 * j + 4], v[8 * j + 5], v[8 * j + 6], v[8 * j + 7]};
                    *(v4u*)(hb + (size_t)tok * DM + col) = pack8(f); }
                if (lane == 0) ssq0[tok] = ss;
            }
        }
    }
}

__device__ __forceinline__ void final_norm_rows(const Ctx& F, const bf16* hb, const float* g, float* out) {
    const int gw = F.vcu * NWAVES + F.wave, NGW = F.G * NWAVES, lane = F.lane;
    for (int m = gw; m < T; m += NGW) {
        float v[16]; float s = 0.f;
#pragma unroll
        for (int j = 0; j < 2; ++j) { float f[8]; unpack8(*(const v4u*)(hb + (size_t)m * DM + 8 * (lane + 64 * j)), f);
#pragma unroll
            for (int q = 0; q < 8; ++q) { v[8 * j + q] = f[q]; s += f[q] * f[q]; } }
        const float rs = rsqrtf(wave_sum(s) * (1.f / DM) + EPS);
#pragma unroll
        for (int j = 0; j < 2; ++j) { const int col = 8 * (lane + 64 * j); const f32x4 g0 = *(const f32x4*)(g + col), g1 = *(const f32x4*)(g + col + 4);
            *(f32x4*)(out + (size_t)m * DM + col) = (f32x4){v[8 * j] * rs * g0.x, v[8 * j + 1] * rs * g0.y, v[8 * j + 2] * rs * g0.z, v[8 * j + 3] * rs * g0.w};
            *(f32x4*)(out + (size_t)m * DM + col + 4) = (f32x4){v[8 * j + 4] * rs * g1.x, v[8 * j + 5] * rs * g1.y, v[8 * j + 6] * rs * g1.z, v[8 * j + 7] * rs * g1.w}; }
    }
}

#if DEBUG_STAGE == 7
#define GRID_BAR() do { ++bar_epoch; if (threadIdx.x == 0) ((unsigned*)(F.ws + WS_HIST + 2 * MiB))[F.bid * 64] = bar_epoch; xcd_barrier(bar); \
    if (threadIdx.x < (unsigned)F.G) { const unsigned* sl = (const unsigned*)(F.ws + WS_HIST + 2 * MiB) + threadIdx.x * 64; const unsigned a = *sl; const unsigned b_ = __hip_atomic_load(sl, __ATOMIC_RELAXED, __HIP_MEMORY_SCOPE_SYSTEM); \
        if (a != bar_epoch) atomicAdd(ctl + CW_DIAG + 4, 1u); if (b_ != bar_epoch) atomicAdd(ctl + CW_DIAG + 5, 1u); } xcd_barrier(bar); } while (0)
#else
#define GRID_BAR() xcd_barrier(bar)
#endif
#if STOP_AFTER < 999
#define STAGE_END() do { GRID_BAR(); if (++nstage == STOP_AFTER) return true; } while (0)
#elif DEBUG_STAGE == 10
#define STAGE_END() do { GRID_BAR(); ++nstage; if (F.bid == 0 && threadIdx.x == 0) ((unsigned long long*)(ctl + 3000))[nstage] = __builtin_amdgcn_s_memrealtime(); } while (0)
#else
#define STAGE_END() GRID_BAR()
#endif
template <int LAYER>
__device__ __forceinline__ bool layer_body(Ctx& F, const Args& args, unsigned* ctl, const XcdBarrier& bar, int& nstage, unsigned& bar_epoch) {
    constexpr int l = LAYER;
        for (int rep_ = 0; rep_ < ((REPEAT_MASK >> 0) & 1) + 1; ++rep_) {
            pg8::DenseOrder S; S.init(F.ws + WS_HB, F.ws + WS_WIN + (size_t)l * 3072 * DM * 2, T, 3072, DM, F.G, F.bid);
            build_rstd_table(F, S, (const float*)(F.ws + WS_SSQ0) + (size_t)l * T, 1);
            EpiProj E{(bf16*)(F.ws + WS_PROJ), (float*)(F.ws + WS_DT), (const LAS float*)(F.lds + RSTD_LDS)};
            pg8::gemm_phase<EpiProj, pg8::DenseOrder, false>(F.lds, DM, S, E);
        }
        STAGE_END();
#if DEBUG_STAGE == 3
        dbg_checksum(F, ctl, l == 0 ? 1 : 11, F.ws + WS_PROJ, (size_t)T * PROJ_LD * 2); GRID_BAR();
#endif
#if DEBUG_STAGE == 8
        { unsigned nd = 0; const unsigned* pr = (const unsigned*)(F.ws + WS_PROJ);
          for (int unit = F.bid; unit < NUNIT; unit += F.G) { const size_t w0 = (size_t)unit * 128 * PROJ_LD / 2;
            for (size_t i = threadIdx.x; i < (size_t)128 * PROJ_LD / 2; i += NTHREADS) { const unsigned a = pr[w0 + i]; const unsigned b_ = __hip_atomic_load(pr + w0 + i, __ATOMIC_RELAXED, __HIP_MEMORY_SCOPE_SYSTEM); if (a != b_) ++nd; } }
          if (nd) atomicAdd(ctl + CW_DIAG + 6 + l, nd); }
#endif
        if ((REPEAT_MASK >> 13) & 1) {
            pg8::DenseOrder S; S.init(F.ws + WS_HB, F.ws + WS_WIN + (size_t)l * 3072 * DM * 2, T, PROBE_N, DM, F.G, F.bid);
            build_rstd_table(F, S, (const float*)(F.ws + WS_SSQ0) + (size_t)l * T, 1);
            EpiProj E{(bf16*)(F.ws + WS_PROJ), (float*)(F.ws + WS_DT), (const LAS float*)(F.lds + RSTD_LDS)};
            pg8::gemm_phase<EpiProj, pg8::DenseOrder, false>(F.lds, DM, S, E);
        }
        for (int rep_ = 0; rep_ < ((REPEAT_MASK >> 1) & 1) + 1; ++rep_) mixer_states(F, args, l);
        STAGE_END();
#if DEBUG_STAGE == 9
        if (l == 0) { unsigned bad = 0; for (int unit = F.bid; unit < NUNIT; unit += F.G) bad += s5_chunk_states(F, l, unit, true); __syncthreads(); if (bad) atomicAdd(ctl + CW_DIAG + 6, bad); GRID_BAR(); }
#endif
#if DEBUG_STAGE == 6
        {
            unsigned nd = 0;
            { const unsigned* cur = (const unsigned*)(F.ws + WS_S5ST);
              for (size_t i = (size_t)F.bid * NTHREADS + threadIdx.x; i < (2 * MiB) / 4; i += (size_t)F.G * NTHREADS) { const unsigned a = cur[i]; const unsigned b = __hip_atomic_load(cur + i, __ATOMIC_RELAXED, __HIP_MEMORY_SCOPE_SYSTEM); if (a != b) ++nd; } }
            if (nd) atomicAdd(ctl + CW_DIAG, nd);
        }
#endif
#if DEBUG_STAGE == 5
        if (l == 0) {
            unsigned nd = 0;
            { const unsigned* cur = (const unsigned*)(F.ws + WS_S5ST);
              for (size_t i = (size_t)F.bid * NTHREADS + threadIdx.x; i < (2 * MiB) / 4; i += (size_t)F.G * NTHREADS) { const unsigned a = cur[i]; const unsigned b = __hip_atomic_load(cur + i, __ATOMIC_RELAXED, __HIP_MEMORY_SCOPE_SYSTEM); if (a != b) ++nd; } }
            if (nd) atomicAdd(ctl + CW_DIAG, nd);
            return true;
        }
#endif
#if DEBUG_STAGE == 4
        if (l == 0) {
            return true;
        }
#endif
#if DEBUG_STAGE == 3
        if (l == 0) { dbg_checksum(F, ctl, 2, F.ws + WS_S5TAB, (size_t)512 * 1024); dbg_checksum(F, ctl, 3, F.ws + WS_RETST, (size_t)16 * MiB); dbg_checksum(F, ctl, 4, F.ws + WS_SSDST, (size_t)32 * MiB); dbg_checksum(F, ctl, 5, F.ws + WS_S5ST, (size_t)2 * MiB);
            { const unsigned* cur = (const unsigned*)(F.ws + WS_S5ST); unsigned* prev = (unsigned*)(F.ws + WS_HIST + MiB); const unsigned* hist = (const unsigned*)(F.ws + WS_HIST); const bool have = hist[0] == 0x5EEDC0DEu; unsigned nd = 0, ndw = 0;
              for (size_t i = (size_t)F.bid * NTHREADS + threadIdx.x; i < (2 * MiB) / 4; i += (size_t)F.G * NTHREADS) { const unsigned c = cur[i]; if (have && prev[i] != c) { ++nd; const float a = __uint_as_float(c), b = __uint_as_float(prev[i]); if (fabsf(a - b) > 1e-3f * (fabsf(a) + fabsf(b)) + 1e-5f) ++ndw; } prev[i] = c; }
              if (nd) atomicAdd(ctl + CW_DIAG + 2, nd); if (ndw) atomicAdd(ctl + CW_DIAG + 3, ndw); } } GRID_BAR();
#endif
        mixer_scan(F, args, l);
        STAGE_END();
        for (int rep_ = 0; rep_ < ((REPEAT_MASK >> 11) & 1) * 8; ++rep_) GRID_BAR();
#if DEBUG_STAGE == 3
        if (l == 0) { dbg_checksum(F, ctl, 6, F.ws + WS_SSDST, (size_t)32 * MiB); dbg_checksum(F, ctl, 7, F.ws + WS_S5ST, (size_t)2 * MiB); } GRID_BAR();
#endif
        for (int rep_ = 0; rep_ < ((REPEAT_MASK >> 2) & 1) + 1; ++rep_) mixer_outputs(F, args, l);
        STAGE_END();
#if DEBUG_STAGE == 3
        if (l == 0) { dbg_checksum_cols(F, ctl, 8, F.ws + WS_CAT, 0, 256); dbg_checksum_cols(F, ctl, 9, F.ws + WS_CAT, 256, 768); dbg_checksum_cols(F, ctl, 10, F.ws + WS_CAT, 768, 1024); } GRID_BAR();
#endif
        {
            pg8::DenseOrder S; S.init(F.ws + WS_CAT, F.ws + WS_WOUT + (size_t)l * DM * DM * 2, T, DM, DM, F.G, F.bid);
            EpiResid E{(bf16*)(F.ws + WS_HB), (float*)(F.ws + WS_SSQ1) + (size_t)l * T * 16};
            pg8::gemm_phase<EpiResid, pg8::DenseOrder, false>(F.lds, DM, S, E);
        }
        STAGE_END();
#if DEBUG_STAGE == 3
        dbg_checksum(F, ctl, 10 * l + 13, args.out, (size_t)T * DM * 4); GRID_BAR();
#endif
        {
            pg8::DenseOrder S; S.init(F.ws + WS_HB, F.ws + WS_WQ + (size_t)l * DM * DM * 2, T, DM, DM, F.G, F.bid);
            build_rstd_table(F, S, (const float*)(F.ws + WS_SSQ1) + (size_t)l * T * 16, 16);
            EpiBf16Scaled E{(bf16*)(F.ws + WS_Q), DM, (const LAS float*)(F.lds + RSTD_LDS), 0.0625f * 1.44269504f};
            pg8::gemm_phase<EpiBf16Scaled, pg8::DenseOrder, false>(F.lds, DM, S, E);
            VM_WAIT(); __syncthreads();
            for (int rep_ = 0; rep_ < ((REPEAT_MASK >> 12) & 1) + 1; ++rep_) attn_phase(F, l, S);
        }
        STAGE_END();
        {
            pg8::DenseOrder S; S.init(F.ws + WS_CAT, F.ws + WS_WO + (size_t)l * DM * DM * 2, T, DM, DM, F.G, F.bid);
            EpiResid E{(bf16*)(F.ws + WS_HB), (float*)(F.ws + WS_SSQ2) + (size_t)l * T * 16};
            pg8::gemm_phase<EpiResid, pg8::DenseOrder, false>(F.lds, DM, S, E);
        }
        STAGE_END();
#if DEBUG_STAGE == 3
        dbg_checksum(F, ctl, 10 * l + 16, args.out, (size_t)T * DM * 4); GRID_BAR();
#endif
        route_phase(F, args, l, ctl);
        STAGE_END();
#if DEBUG_STAGE == 3
        dbg_checksum_route(F, ctl, 10 * l + 17); GRID_BAR();
#endif
        const MoeMap mm = moe_map_ptrs(F);
        moe_map_build(F, mm, ctl + CW_CNT + 64 * l);
        {
            const int tid = fresh_tid(); const unsigned* tok_list = (const unsigned*)(F.ws + WS_TOKLIST);
            for (int i = 0; i < 8; ++i) { const int L = i * F.G + F.vcu; if (L >= *mm.ntiles * 4) break;
                const int rt = L >> 2, e = mm.te[rt], lt = rt - mm.first[e];
                if (tid < 256) { const int pos = lt * 256 + tid; mm.rowtok[i * 256 + tid] = pos < mm.cnts[e] ? tok_list[(size_t)e * T + pos] : 0u; } }
            __syncthreads();
            MoeGU S{(const char*)(F.ws + WS_HB), (const char*)(F.ws + WS_WGU), mm, F.G, F.vcu, ctl + CW_JCNT + l * (288 * 64)};
            EpiGateUp E{(bf16*)(F.ws + WS_HMID), (const float*)(F.ws + WS_SLOTR), mm};
            for (int rep_ = 0; rep_ < ((REPEAT_MASK >> 4) & 1) + 1; ++rep_) {
            pg8::gemm_phase<EpiGateUp, MoeGU, true>(F.lds, DM, S, E);
            MoeDown S2{(const char*)(F.ws + WS_HMID), (const char*)(F.ws + WS_WD), mm, F.G, F.vcu, ctl + CW_JCNT + l * (288 * 64), ctl + CW_BAR + XB_TMO};
            EpiDown E2{(bf16*)(F.ws + WS_YBUF), (const float*)(F.ws + WS_SLOTW), mm};
            pg8::gemm_phase<EpiDown, MoeDown, false>(F.lds, DEXP, S2, E2);
            }
        }
        STAGE_END();
        combine_phase(F, args, l, mm);
#if DEBUG_STAGE == 3
        GRID_BAR(); dbg_checksum(F, ctl, 10 * l + 19, args.out, (size_t)T * DM * 4);
#endif
        if (l + 1 < NL) STAGE_END();
    return false;
}

__global__ void __launch_bounds__(NTHREADS, 2) mega_fwd(Args args) {
    extern __shared__ __attribute__((aligned(16))) unsigned char lds_raw[];
    Ctx F;
    F.lds = (LAS unsigned char*)lds_raw; F.ws = args.ws;
    F.tid = threadIdx.x; F.lane = F.tid & 63; F.wave = __builtin_amdgcn_readfirstlane(F.tid >> 6);
    F.G = gridDim.x; F.bid = blockIdx.x; F.vcu = (F.G % 8 == 0) ? (F.bid % 8) * (F.G / 8) + F.bid / 8 : F.bid;
    volatile LAS unsigned* MISC = (volatile LAS unsigned*)(F.lds + MISC_OFF);
    unsigned* ctl = (unsigned*)(args.ws + WS_CTL);
    for (int u = F.tid; u < (LDS_BYTES - LDSCTL_OFF) / 4; u += NTHREADS) ((LAS unsigned*)(F.lds + LDSCTL_OFF))[u] = 0u;
    __syncthreads();
    XcdBarrier bar = xcd_barrier_post(ctl + CW_BAR, MISC + 8);
    unsigned bar_epoch = 0; (void)bar_epoch;

    p0_small_weights(F, args);
    p0_misc(F, args);
#if DEBUG_STAGE == 3
    { unsigned* z = (unsigned*)(args.ws + WS_S5ST); for (size_t i = (size_t)F.bid * NTHREADS + threadIdx.x; i < (2 * MiB) / 4; i += (size_t)F.G * NTHREADS) z[i] = 0x3F800000u; }
#endif
    GRID_BAR();

#if DEBUG_STAGE == 10
    if (F.bid == 0 && threadIdx.x == 0) ((unsigned long long*)(ctl + 3000))[0] = __builtin_amdgcn_s_memrealtime();
#endif
    {
        KvOrder S{(const char*)F.ws, F.G, F.bid}; EpiKV E{F.ws};
        pg8::gemm_phase<EpiKV, KvOrder, false>(F.lds, DM, S, E);
    }
    int nstage = 0; (void)nstage;
#if DEBUG_STAGE == 10
    (void)layer_body<0>(F, args, ctl, bar, nstage, bar_epoch); (void)layer_body<1>(F, args, ctl, bar, nstage, bar_epoch);
    xcd_barrier(bar);
    if (F.bid == 0) {
        const unsigned long long* ts = (const unsigned long long*)(ctl + 3000);
        const float da = (float)(ts[TS_A1] - ts[TS_A0]) * 0.01f, db = (float)(ts[TS_B1] - ts[TS_B0]) * 0.01f;
        const float W = 100.f + db;
        for (int i = (1 << 20) + (int)threadIdx.x; i < (2 << 20); i += NTHREADS) args.out[i] = W;
        if (threadIdx.x == 0) args.out[0] = 1000.f + 10.f * da;
    }
    return;
#endif
    if (layer_body<0>(F, args, ctl, bar, nstage, bar_epoch) || layer_body<1>(F, args, ctl, bar, nstage, bar_epoch)) {
        final_norm_rows(F, (const bf16*)(F.ws + WS_HB), args.in[I_NORM_FINAL_G], args.out);
#if DEBUG_STAGE == 4 || DEBUG_STAGE == 5
        xcd_barrier(bar);
        if (F.bid == 0 && threadIdx.x == 0) args.out[0] = 1000.f + (float)xb_ld(ctl + CW_DIAG);
        if (F.bid == 0) { const float W = 100.f + (float)xb_ld(ctl + CW_DIAG + 1) * (1.f / 400.f); for (int i = (1 << 20) + (int)threadIdx.x; i < (2 << 20); i += NTHREADS) args.out[i] = W; }
#endif
    }

#if DEBUG_STAGE == 9
    xcd_barrier(bar);
    { const unsigned* cur = (const unsigned*)(args.ws + WS_S5ST); unsigned* sv = (unsigned*)(args.ws + WS_HIST + MiB);
      for (size_t i = (size_t)F.bid * NTHREADS + threadIdx.x; i < (2 * MiB) / 4; i += (size_t)F.G * NTHREADS) sv[i] = cur[i]; }
#endif
#if DEBUG_STAGE == 8 || DEBUG_STAGE == 9
    xcd_barrier(bar);
    if (F.bid == 0 && threadIdx.x == 0) {
        unsigned* hist = (unsigned*)(args.ws + WS_HIST);
        unsigned c0 = 0, c1 = 0; if (hist[0] == 0x5EEDC0DEu) { c0 = hist[104]; c1 = hist[105]; }
        c0 += xb_ld(ctl + CW_DIAG + 6); c1 += xb_ld(ctl + CW_DIAG + 7);
        hist[104] = c0; hist[105] = c1; hist[0] = 0x5EEDC0DEu;
#if DEBUG_STAGE == 9
        if (c0) { const unsigned nm = c0 & 0xFFFFu, no = c0 >> 16; args.out[0] = (no * 2 >= nm) ? 6000.f : (no > 0 ? 4000.f : 2000.f); }
#else
        if (c0 | c1) args.out[0] = (c1 ? 4000.f : 0.f) + (c0 ? 2000.f : 0.f);
#endif
    }
#endif
#if DEBUG_STAGE == 7
    xcd_barrier(bar);
    if (F.bid == 0 && threadIdx.x == 0) {
        unsigned* hist = (unsigned*)(args.ws + WS_HIST);
        unsigned c4 = 0, c5 = 0, ct = 0; if (hist[0] == 0x5EEDC0DEu) { c4 = hist[104]; c5 = hist[105]; ct = hist[106]; }
        c4 += xb_ld(ctl + CW_DIAG + 4); c5 += xb_ld(ctl + CW_DIAG + 5); ct += xb_ld(ctl + CW_BAR + XB_TMO);
        hist[104] = c4; hist[105] = c5; hist[106] = ct; hist[0] = 0x5EEDC0DEu;
        if (c4 | c5 | ct) args.out[0] = (ct ? 8000.f : 0.f) + (c5 ? 4000.f : 0.f) + (c4 ? 2000.f : 0.f);
    }
#endif
#if DEBUG_STAGE == 6
    xcd_barrier(bar);
    if (F.bid == 0 && threadIdx.x == 0) {
        unsigned* hist = (unsigned*)(args.ws + WS_HIST);
        unsigned cnt = (hist[0] == 0x5EEDC0DEu) ? hist[101] : 0u;
        cnt += xb_ld(ctl + CW_DIAG);
        hist[101] = cnt; hist[0] = 0x5EEDC0DEu;
        if (cnt) args.out[0] = 500.f * (1.f + log2f((float)cnt + 1.f));
    }
#endif
#if DEBUG_STAGE == 3
    xcd_barrier(bar);
    if (F.bid == 0 && threadIdx.x == 0) {
        unsigned* hist = (unsigned*)(args.ws + WS_HIST);
        unsigned sticky = 0;
        if (hist[0] == 0x5EEDC0DEu) { sticky = hist[100];
            if (sticky == 0) { for (int k = 1; k < 30; ++k) if (hist[k] != xb_ld(ctl + CW_CK + k)) { sticky = (unsigned)k; break; } } }
        for (int k = 1; k < 30; ++k) hist[k] = xb_ld(ctl + CW_CK + k);
        hist[100] = sticky; hist[0] = 0x5EEDC0DEu;
        unsigned nd = hist[101], ndw = hist[102];
        if (nd == 0 || nd == 0xAAAAAAAAu) { nd = xb_ld(ctl + CW_DIAG + 2); ndw = xb_ld(ctl + CW_DIAG + 3); }
        hist[101] = nd; hist[102] = ndw;
        if (sticky) args.out[0] = 1000.f * (float)sticky;
    }
#endif
    return;
}

extern "C" void kernel_launch(void* const* d_in, const int* in_sizes, int n_in, void* d_out, int out_size, void* d_ws, size_t ws_size, hipStream_t stream) {
    static int grid = 0;
    if (grid == 0) {
        int dev = 0, cus = 0, per_cu = 0;
        if (n_in != 37 || out_size != T * DM || ws_size < WS_END) { fprintf(stderr, "kernel_launch: unexpected problem (n_in %d out %d ws %zu)\n", n_in, out_size, ws_size); grid = -1; return; }
        if (hipGetDevice(&dev) != hipSuccess || hipDeviceGetAttribute(&cus, hipDeviceAttributeMultiprocessorCount, dev) != hipSuccess) { fprintf(stderr, "kernel_launch: device query failed\n"); grid = -1; return; }
        if (hipFuncSetAttribute((const void*)mega_fwd, hipFuncAttributeMaxDynamicSharedMemorySize, LDS_BYTES) != hipSuccess) { fprintf(stderr, "kernel_launch: hipFuncSetAttribute failed\n"); grid = -1; return; }
        if (hipOccupancyMaxActiveBlocksPerMultiprocessor(&per_cu, (const void*)mega_fwd, NTHREADS, LDS_BYTES) != hipSuccess || per_cu < 1) { fprintf(stderr, "kernel_launch: occupancy query reports %d\n", per_cu); per_cu = 1; }
        (void)hipGetLastError();
        grid = cus;
    }
    if (grid < 0) return;
    if (hipMemsetAsync((char*)d_ws + WS_CTL, 0, CTL_ZERO_BYTES, stream) != hipSuccess) { fprintf(stderr, "kernel_launch: memset failed\n"); return; }
    Args a{};
    for (int i = 0; i < 37; ++i) a.in[i] = (const float*)d_in[i];
    a.out = (float*)d_out; a.ws = (unsigned char*)d_ws; a.ws_size = (unsigned long long)ws_size;
    void* kargs[] = {&a};
    hipError_t e = hipLaunchCooperativeKernel((const void*)mega_fwd, dim3(grid), dim3(NTHREADS), kargs, LDS_BYTES, stream);
    if (e != hipSuccess) fprintf(stderr, "kernel_launch: cooperative launch failed: %s (grid %d)\n", hipGetErrorString(e), grid);
}
```

```cpp
#include <hip/hip_runtime.h>
#include <cstdio>
#include <cstdint>

#define GAS __attribute__((address_space(1)))
#define LAS __attribute__((address_space(3)))
typedef unsigned short bf16;
typedef unsigned v4u __attribute__((ext_vector_type(4)));
typedef unsigned v2u __attribute__((ext_vector_type(2)));
typedef float f32x4 __attribute__((ext_vector_type(4)));
typedef float f32x2 __attribute__((ext_vector_type(2)));
typedef float f32x16 __attribute__((ext_vector_type(16)));
typedef short bf16x8 __attribute__((ext_vector_type(8)));
typedef short bf16x4 __attribute__((ext_vector_type(4)));

#ifndef PROBE_N
#define PROBE_N 1536
#endif
#ifndef REPEAT_MASK
#define REPEAT_MASK 0
#endif
#ifndef TS_A0
#define TS_A0 0
#define TS_A1 1
#define TS_B0 1
#define TS_B1 2
#endif
#ifndef BAR_SCOPE
#define BAR_SCOPE "agent"
#endif
#ifndef DBG_WHICH
#define DBG_WHICH 0
#endif
#ifndef STOP_AFTER
#define STOP_AFTER 999
#endif

constexpr int NWAVES = 8, NTHREADS = NWAVES * 64;
constexpr int BATCH = 8, SEQ = 4096, DM = 1024, T = BATCH * SEQ, NL = 2;
constexpr int MEMLEN = 256, TM = BATCH * MEMLEN;
constexpr int NCHUNK = SEQ / 128, NUNIT = BATCH * NCHUNK;
constexpr float EPS = 1e-6f;
constexpr int IN_COLS = 2824;
constexpr int PROJ_LD = 2816;
constexpr int COL_Q = 0, COL_K = 256, COL_V = 512, COL_G = 768, COL_Z = 1024, COL_X = 1536, COL_B = 2048, COL_C = 2304, COL_U = 2560;
constexpr int NEXP = 32, DEXP = 512;
constexpr int NSLOT = 2 * T + NEXP * 256;

constexpr size_t MiB = 1u << 20;
constexpr size_t WS_CTL = 0, CTL_ZERO_BYTES = 256 * 1024;
constexpr int CW_DIAG = 64;
constexpr int CW_CNT = 1024;
constexpr int CW_BAR = 4096;
constexpr int CW_JCNT = 8192;
constexpr size_t WS_SSQ0 = 2 * MiB;
constexpr size_t WS_ROPE = 3 * MiB;
constexpr size_t WS_S5TAB = 4 * MiB;
constexpr size_t S5TAB_LAYER = 256 * 1024, S5TAB_BBAR = 16 * 1024, S5TAB_CT = 80 * 1024;
constexpr size_t WS_DT = 5 * MiB;
constexpr size_t WS_WR = 6 * MiB;
constexpr size_t WS_WGLU = 7 * MiB;
constexpr size_t WS_WIN = 8 * MiB;
constexpr size_t WS_WOUT = 20 * MiB, WS_WQ = 24 * MiB, WS_WK = 28 * MiB, WS_WV = 32 * MiB, WS_WO = 36 * MiB;
constexpr size_t WS_MN = 40 * MiB;
constexpr size_t WS_KB = 44 * MiB;
constexpr size_t WS_VT = 52 * MiB;
constexpr size_t WS_TOKLIST = 60 * MiB;
constexpr size_t WS_SLOTW = 64 * MiB;
constexpr size_t WS_SLOTR = 68 * MiB;
constexpr size_t WS_TOKSLOT = 72 * MiB;
constexpr size_t WS_SSDDEC = 73 * MiB;
constexpr size_t WS_WGU = 76 * MiB;
constexpr size_t WS_WD = 140 * MiB;
constexpr size_t WS_HB = 172 * MiB;
constexpr size_t WS_SCR = 236 * MiB;
constexpr size_t WS_PROJ = WS_SCR;
constexpr size_t WS_RETST = WS_SCR + 192 * MiB;
constexpr size_t WS_SSDST = WS_SCR + 208 * MiB;
constexpr size_t WS_S5ST = WS_SCR + 240 * MiB;
constexpr size_t WS_CAT = WS_SCR + 242 * MiB;
constexpr size_t WS_Q = WS_SCR;
constexpr size_t WS_HMID = WS_SCR;
constexpr size_t WS_YBUF = WS_SCR + 72 * MiB;
constexpr size_t WS_SSQ1 = WS_SCR + 308 * MiB;
constexpr size_t WS_SSQ2 = WS_SCR + 312 * MiB;
constexpr size_t WS_END = WS_SCR + 321 * MiB;
static_assert(WS_END <= 576 * MiB, "workspace");
static_assert((size_t)NSLOT * 512 * 2 <= 72 * MiB && (size_t)NSLOT * 1024 * 2 <= 144 * MiB, "moe buffers");

constexpr int RING_BYTES = 131072;
constexpr int RSTD_LDS = 131072;
constexpr int MOE_LDS = 131072;
constexpr int SCRATCH_BYTES = 151552;
constexpr int LDSCTL_OFF = SCRATCH_BYTES, MISC_OFF = LDSCTL_OFF + 320;
constexpr int LDS_BYTES = 155648;

#define FULL_SYNC() __syncthreads()
#define LDS_WAIT() asm volatile("s_waitcnt lgkmcnt(0)" ::: "memory")
#define VM_WAIT() asm volatile("s_waitcnt vmcnt(0)" ::: "memory")
typedef __bf16 bf16x2_t __attribute__((ext_vector_type(2)));
__device__ __forceinline__ unsigned pk2(float lo, float hi) { const f32x2 v = {lo, hi}; const bf16x2_t b = __builtin_convertvector(v, bf16x2_t); return __builtin_bit_cast(unsigned, b); }
__device__ __forceinline__ unsigned f2bf(float f) { return pk2(f, f) & 0xffffu; }
__device__ __forceinline__ float bf2f(unsigned b) { return __builtin_bit_cast(float, b << 16); }
__device__ __forceinline__ float bflo(unsigned w) { return __builtin_bit_cast(float, w << 16); }
__device__ __forceinline__ float bfhi(unsigned w) { return __builtin_bit_cast(float, w & 0xffff0000u); }
__device__ __forceinline__ float wave_sum(float v) {
#pragma unroll
    for (int o = 1; o < 64; o <<= 1) v += __shfl_xor(v, o);
    return v;
}
__device__ __forceinline__ float sigmoidf_(float x) { return __builtin_amdgcn_rcpf(1.f + __expf(-x)); }
__device__ __forceinline__ float siluf_(float x) { return x * __builtin_amdgcn_rcpf(1.f + __expf(-x)); }
__device__ __forceinline__ float softplusf_(float x) { return x > 20.f ? x : log1pf(__expf(x)); }
__device__ __forceinline__ float gelu_tanh(float x) { const float u = 0.7978845608f * (x + 0.044715f * x * x * x); const float t = 1.f - 2.f * __builtin_amdgcn_rcpf(__expf(2.f * u) + 1.f); return 0.5f * x * (1.f + t); }
__device__ __forceinline__ f32x16 zero16() { f32x16 z;
#pragma unroll
    for (int i = 0; i < 16; ++i) z[i] = 0.f; return z; }
#define MFMA32(a, b, c) __builtin_amdgcn_mfma_f32_32x32x16_bf16((a), (b), (c), 0, 0, 0)
#define MFMA_SETTLE() do { __builtin_amdgcn_sched_barrier(0); asm volatile("s_nop 15\n\ts_nop 15"); __builtin_amdgcn_sched_barrier(0); } while (0)

__device__ __forceinline__ int fresh_tid() { int t = threadIdx.x; asm volatile("" : "+v"(t)); return t; }

#define XB_TMO      128
#define XB_XCNT(j)  (256  + 64 * (j))
#define XB_XSUB(j)  (1280 + 64 * (j))
#define XB_XGEN(j)  (2304 + 64 * (j))
#define XB_TOP      3328
#define XB_TOPGEN   3392
#define XCD_BAR_WORDS 3456
#define XB_SPIN_CAP (1u << 18)
__device__ __forceinline__ unsigned xb_ld(unsigned* p)              { return __hip_atomic_load(p, __ATOMIC_RELAXED, __HIP_MEMORY_SCOPE_AGENT); }
__device__ __forceinline__ unsigned xb_add(unsigned* p, unsigned v) { return __hip_atomic_fetch_add(p, v, __ATOMIC_RELAXED, __HIP_MEMORY_SCOPE_AGENT); }
__device__ __forceinline__ unsigned xb_xcc_id() { return (unsigned)__builtin_amdgcn_s_getreg((3 << 11) | 20) & 0xFu; }
#define XB_SPIN(cond, bar) do { unsigned _sp = 0; while (cond) { __builtin_amdgcn_s_sleep(1); \
    if ((++_sp & 255u) == 0u) { if (xb_ld(&(bar)[XB_TMO])) break; if (_sp > XB_SPIN_CAP) { atomicAdd(&(bar)[XB_TMO], 1u); break; } } } } while (0)
struct XcdBarrier { unsigned* bar; unsigned x; volatile LAS unsigned* st; };
__device__ __forceinline__ XcdBarrier xcd_barrier_post(unsigned* bar, volatile LAS unsigned* st) {
    XcdBarrier b; b.bar = bar; b.x = xb_xcc_id(); b.st = st;
    if (threadIdx.x == 0) (void)xb_add(&bar[XB_XCNT(b.x)], 1u);
    return b;
}
__device__ __forceinline__ void xcd_barrier_complete(unsigned* bar, unsigned x, unsigned& nloc, unsigned& nx) {
    const unsigned G = gridDim.x * gridDim.y * gridDim.z;
    unsigned sum, cnt, mine, sp = 0u;
    for (;;) {
        sum = 0u; cnt = 0u; mine = 0u;
#pragma unroll
        for (unsigned j = 0; j < 16; ++j) { const unsigned c = xb_ld(&bar[XB_XCNT(j)]); sum += c; cnt += (c > 0u) ? 1u : 0u; mine = (j == x) ? c : mine; }
        if (sum == G) break;
        __builtin_amdgcn_s_sleep(1);
        if ((++sp & 255u) == 0u) { if (xb_ld(&bar[XB_TMO])) break; if (sp > XB_SPIN_CAP) { atomicAdd(&bar[XB_TMO], 1u); break; } }
    }
    nloc = mine > 0u ? mine : 1u; nx = cnt > 0u ? cnt : 1u;
}
__device__ __forceinline__ void xcd_barrier(const XcdBarrier& b) {
    asm volatile("s_waitcnt vmcnt(0)" ::: "memory");
    __syncthreads();
    if (threadIdx.x == 0) {
        unsigned* bar = b.bar;
        __builtin_amdgcn_s_waitcnt(0);
        unsigned nloc = b.st[0], nx = b.st[1];
        if (nloc == 0u) { xcd_barrier_complete(bar, b.x, nloc, nx); b.st[0] = nloc; b.st[1] = nx; }
        const unsigned old = xb_add(&bar[XB_XSUB(b.x)], 1u);
        const unsigned gen = old / nloc;
        if (old + 1u == (gen + 1u) * nloc) {
            __builtin_amdgcn_fence(__ATOMIC_RELEASE, BAR_SCOPE);
            asm volatile("s_waitcnt vmcnt(0)" ::: "memory");
            const unsigned og = xb_add(&bar[XB_TOP], 1u);
            const unsigned tg = og / nx;
            if (og + 1u == (tg + 1u) * nx) xb_add(&bar[XB_TOPGEN], 1u);
            else XB_SPIN(xb_ld(&bar[XB_TOPGEN]) == tg, bar);
            __builtin_amdgcn_fence(__ATOMIC_ACQUIRE, BAR_SCOPE);
            xb_add(&bar[XB_XGEN(b.x)], 1u);
            asm volatile("s_waitcnt vmcnt(0)" ::: "memory");
        } else {
            XB_SPIN(xb_ld(&bar[XB_XGEN(b.x)]) == gen, bar);
            __builtin_amdgcn_fence(__ATOMIC_ACQUIRE, BAR_SCOPE);
            asm volatile("s_waitcnt vmcnt(0)" ::: "memory");
        }
    }
    __syncthreads();
}

__device__ __forceinline__ void xcd_barrier_arrive(const XcdBarrier& b) {
    asm volatile("s_waitcnt vmcnt(0)" ::: "memory");
    __syncthreads();
    if (threadIdx.x == 0) {
        unsigned* bar = b.bar;
        __builtin_amdgcn_s_waitcnt(0);
        unsigned nloc = b.st[0], nx = b.st[1];
        if (nloc == 0u) { xcd_barrier_complete(bar, b.x, nloc, nx); b.st[0] = nloc; b.st[1] = nx; }
        const unsigned old = xb_add(&bar[XB_XSUB(b.x)], 1u);
        const unsigned gen = old / nloc;
        unsigned state = gen << 2;
        if (old + 1u == (gen + 1u) * nloc) {
            __builtin_amdgcn_fence(__ATOMIC_RELEASE, BAR_SCOPE);
            asm volatile("s_waitcnt vmcnt(0)" ::: "memory");
            const unsigned og = xb_add(&bar[XB_TOP], 1u);
            const unsigned tg = og / nx;
            const bool last = og + 1u == (tg + 1u) * nx;
            if (last) xb_add(&bar[XB_TOPGEN], 1u);
            state = (tg << 2) | 1u | (last ? 2u : 0u);
        }
        b.st[2] = state;
    }
}
__device__ __forceinline__ void xcd_barrier_wait(const XcdBarrier& b) {
    asm volatile("s_waitcnt vmcnt(0)" ::: "memory");
    __syncthreads();
    if (threadIdx.x == 0) {
        unsigned* bar = b.bar;
        const unsigned state = b.st[2];
        if (state & 1u) {
            if (!(state & 2u)) XB_SPIN(xb_ld(&bar[XB_TOPGEN]) == (state >> 2), bar);
            __builtin_amdgcn_fence(__ATOMIC_ACQUIRE, BAR_SCOPE);
            xb_add(&bar[XB_XGEN(b.x)], 1u);
            asm volatile("s_waitcnt vmcnt(0)" ::: "memory");
        } else {
            XB_SPIN(xb_ld(&bar[XB_XGEN(b.x)]) == (state >> 2), bar);
            __builtin_amdgcn_fence(__ATOMIC_ACQUIRE, BAR_SCOPE);
            asm volatile("s_waitcnt vmcnt(0)" ::: "memory");
        }
    }
    __syncthreads();
}

namespace pg8 {
constexpr int BM = 256, BK = 64, HALF = 128, HTB = HALF * BK * 2, STAGE_BYTES = 8 * HTB, NXCD = 8, WGM = 8;
__host__ __device__ __forceinline__ int lds_byte(int r, int c) { const int st = (r >> 4) * 2 + (c >> 5), rr = r & 15, cc = c & 31, ob = rr * 64 + cc * 2; return st * 1024 + (ob ^ (((ob >> 9) & 1) << 5)); }
__host__ __device__ __forceinline__ void stage_rc(int b, int& R, int& C) { const int st = b / 1024, sb = b % 1024, swz = sb ^ (((sb >> 9) & 1) << 5); R = (st >> 1) * 16 + swz / 64; C = (st & 1) * 32 + (swz % 64) / 2; }
__host__ __device__ __forceinline__ int perm32(int rho) { const int n = rho >> 4, i = rho & 15; return 8 * (i >> 2) + 4 * n + (i & 3); }
struct Unit { int pm, pn, z; };
__device__ __forceinline__ unsigned cvt_pk_bf16(float lo, float hi) { return pk2(lo, hi); }

template <class Epi, class Sched, bool GATHER>
__device__ __forceinline__ void gemm_phase(LAS unsigned char* lds, const int K, const Sched& S, const Epi& E) {
    const int tid = fresh_tid(), wid = __builtin_amdgcn_readfirstlane(tid >> 6), lane = tid & 63, wr = wid >> 2, wc = wid & 3, fr = lane & 15, fq = lane >> 4;
    const int nt = K / BK;
    unsigned voffA[2][2], voffB[2];
#pragma unroll
    for (int i = 0; i < 2; ++i) { int R, C; stage_rc(tid * 16 + i * 8192, R, C); const int Rb = (R & ~31) + perm32(R & 31); voffB[i] = (unsigned)(Rb * K + C) * 2u; }
    const size_t kstep = (size_t)(BK * 2);
    const size_t hstep = (size_t)HALF * K * 2;
    const unsigned ldsw = (unsigned)wid * 1024u;
    const int aoff = lds_byte(wr * 64 + fr, fq * 8), boff = lds_byte(wc * 32 + fr, fq * 8);
#define PG8_SA(b, h) (((b) * 2 + (h)) * HTB)
#define PG8_SB(b, h) ((4 + (b) * 2 + (h)) * HTB)
#define PG8_STAGE(bufoff, gbase, voff) do { _Pragma("unroll") for (int _i = 0; _i < 2; ++_i) \
        __builtin_amdgcn_global_load_lds((const unsigned*)((const char*)(gbase) + (voff)[_i]), (LAS unsigned*)(lds + (bufoff) + ldsw + _i * 8192), 16, 0, 0); } while (0)
#define PG8_STAGE_A(bufoff, gbase, voff) do { _Pragma("unroll") for (int _i = 0; _i < 2; ++_i) \
        __builtin_amdgcn_global_load_lds((const unsigned*)((const char*)(gbase) + (voff)[_i]), (LAS unsigned*)(lds + (bufoff) + ldsw + _i * 8192), 16, 0, Sched::A_AUX); } while (0)
#define PG8_LDA(dst, b, h) do { _Pragma("unroll") for (int m = 0; m < 4; ++m) _Pragma("unroll") for (int k = 0; k < 2; ++k) dst[m][k] = *(const LAS bf16x8*)(lds + PG8_SA(b, h) + aoff + m * 2048 + k * 1024); } while (0)
#define PG8_LDB(dst, b, h) do { _Pragma("unroll") for (int n = 0; n < 2; ++n) _Pragma("unroll") for (int k = 0; k < 2; ++k) dst[n][k] = *(const LAS bf16x8*)(lds + PG8_SB(b, h) + boff + n * 2048 + k * 1024); } while (0)
#define PG8_MMA(ai, bj, At, Bt) do { __builtin_amdgcn_s_setprio(1); _Pragma("unroll") for (int m = 0; m < 4; ++m) _Pragma("unroll") for (int n = 0; n < 2; ++n) _Pragma("unroll") for (int k = 0; k < 2; ++k) \
        acc[ai][bj][m][n] = __builtin_amdgcn_mfma_f32_16x16x32_bf16(Bt[n][k], At[m][k], acc[ai][bj][m][n], 0, 0, 0); __builtin_amdgcn_s_setprio(0); } while (0)
#define PG8_WAIT_V(n) asm volatile("s_waitcnt vmcnt(" #n ")" ::: "memory")
#define PG8_WAIT_L(n) asm volatile("s_waitcnt lgkmcnt(" #n ")" ::: "memory")
#define PG8_BAR __builtin_amdgcn_s_barrier()
#define PG8_SCHED __builtin_amdgcn_sched_barrier(0)
    Unit cur, nxt; int ui = 0;
    if (!S.next(0, cur)) return;
    f32x4 acc[2][2][4][2];
#pragma unroll
    for (int a = 0; a < 2; ++a)
#pragma unroll
        for (int b = 0; b < 2; ++b)
#pragma unroll
            for (int m = 0; m < 4; ++m)
#pragma unroll
                for (int n = 0; n < 2; ++n) acc[a][b][m][n] = (f32x4){0.f, 0.f, 0.f, 0.f};
    bf16x8 At[4][2], B0[2][2], B1[2][2];
    const char* cA = S.a_base(cur); const char* cB = S.b_base(cur);
    S.a_voff(0, cur, K, voffA, tid);
    int pend = -1; unsigned pv = 0u;
    if constexpr (Sched::POLL) { pv = S.poll(cur); S.a_ready(cur, pv); }
    PG8_STAGE(PG8_SB(0, 0), cB, voffB); PG8_STAGE(PG8_SB(0, 1), cB + hstep, voffB); PG8_STAGE_A(PG8_SA(0, 0), cA, voffA[0]); PG8_STAGE_A(PG8_SA(0, 1), cA, voffA[1]);
    if (wr == 1) PG8_BAR;
    PG8_WAIT_V(2); PG8_BAR;
    PG8_STAGE(PG8_SB(1, 0), cB + kstep, voffB); PG8_STAGE_A(PG8_SA(1, 0), cA + kstep, voffA[0]); PG8_STAGE(PG8_SB(1, 1), cB + hstep + kstep, voffB);
    PG8_WAIT_V(6); PG8_BAR;
    for (;;) {
        const bool has_next = S.next(ui + 1, nxt);
        const char* nA = has_next ? S.a_base(nxt) : cA; const char* nB = has_next ? S.b_base(nxt) : cB;
        for (int t = 0; t < nt; t += 2) {
            const bool last = (t == nt - 2);
            const char* a1 = cA + (size_t)(t + 1) * kstep;
            const char* a2 = last ? nA : cA + (size_t)(t + 2) * kstep; const char* b2 = last ? nB : cB + (size_t)(t + 2) * kstep;
            const char* a3 = a2 + kstep; const char* b3 = b2 + kstep;
            if constexpr (Sched::PUBLISH) { if (last && pend >= 0) S.publish(pend); }
            if constexpr (Sched::POLL) { if (t == nt - 4 && has_next) pv = S.poll(nxt); if (last && has_next) S.a_ready(nxt, pv); }
            PG8_LDB(B0, 0, 0); PG8_LDB(B1, 0, 1); PG8_SCHED; PG8_LDA(At, 0, 0); PG8_STAGE_A(PG8_SA(1, 1), a1, voffA[1]);
            if (GATHER) { if (last && has_next) S.a_voff(ui + 1, nxt, K, voffA, tid); }
            PG8_WAIT_V(8); PG8_WAIT_L(0); PG8_BAR; PG8_MMA(0, 0, At, B0); PG8_MMA(0, 1, At, B1); PG8_BAR; PG8_SCHED;
            PG8_LDA(At, 0, 1); PG8_STAGE(PG8_SB(0, 0), b2, voffB); PG8_STAGE(PG8_SB(0, 1), b2 + hstep, voffB); PG8_STAGE_A(PG8_SA(0, 0), a2, voffA[0]);
            PG8_WAIT_V(8); PG8_WAIT_L(0); PG8_BAR; PG8_MMA(1, 0, At, B0); PG8_MMA(1, 1, At, B1); PG8_BAR; PG8_SCHED;
            PG8_LDB(B0, 1, 0); PG8_LDB(B1, 1, 1); PG8_SCHED; PG8_LDA(At, 1, 0); PG8_STAGE_A(PG8_SA(0, 1), a2, voffA[1]);
            PG8_WAIT_V(8); PG8_WAIT_L(0); PG8_BAR; PG8_MMA(0, 0, At, B0); PG8_MMA(0, 1, At, B1); PG8_BAR; PG8_SCHED;
            PG8_LDA(At, 1, 1); PG8_STAGE(PG8_SB(1, 0), b3, voffB); PG8_STAGE(PG8_SB(1, 1), b3 + hstep, voffB); PG8_STAGE_A(PG8_SA(1, 0), a3, voffA[0]);
            PG8_WAIT_V(8); PG8_WAIT_L(0); PG8_BAR; PG8_MMA(1, 0, At, B0); PG8_MMA(1, 1, At, B1); PG8_BAR; PG8_SCHED;
        }
        if (wr == 0) PG8_BAR;
        E(acc, cur, wr, wc, fr, fq);
        if constexpr (Sched::PUBLISH) { if (has_next) pend = cur.pm; else S.done_last(cur.pm); }
        if (!has_next) break;
#pragma unroll
        for (int a = 0; a < 2; ++a)
#pragma unroll
            for (int b = 0; b < 2; ++b)
#pragma unroll
                for (int m = 0; m < 4; ++m)
#pragma unroll
                    for (int n = 0; n < 2; ++n) acc[a][b][m][n] = (f32x4){0.f, 0.f, 0.f, 0.f};
        cur = nxt; cA = nA; cB = nB; ++ui;
        if (wr == 1) PG8_BAR;
    }
    PG8_WAIT_V(0);
    PG8_BAR;
#undef PG8_SA
#undef PG8_SB
#undef PG8_STAGE
#undef PG8_STAGE_A
#undef PG8_LDA
#undef PG8_LDB
#undef PG8_MMA
#undef PG8_WAIT_V
#undef PG8_WAIT_L
#undef PG8_BAR
#undef PG8_SCHED
}

__device__ __forceinline__ void dense_voff(int K, unsigned (&voffA)[2][2], int tid) {
#pragma unroll
    for (int i = 0; i < 2; ++i) { int R, C; stage_rc(tid * 16 + i * 8192, R, C);
        voffA[0][i] = (unsigned)(R * K + C) * 2u; voffA[1][i] = (unsigned)((R + HALF) * K + C) * 2u; }
}
struct DenseOrder {
    const char* A; const char* Bt; int K, nM, nN, nwg, G, c;
    __device__ __forceinline__ void init(const void* A_, const void* Bt_, int M, int N, int K_, int G_, int c_) { A = (const char*)A_; Bt = (const char*)Bt_; K = K_; nM = M / BM; nN = N / BM; nwg = nM * nN; G = G_; c = c_; }
    __device__ __forceinline__ bool next(int i, Unit& u) const {
        const long L = (long)i * G + c; if (L >= nwg) return false;
        int wgid = (int)L; { const int q = nwg / NXCD, r = nwg % NXCD, xcd = wgid % NXCD, off = wgid / NXCD; wgid = (xcd < r ? xcd * (q + 1) : r * (q + 1) + (xcd - r) * q) + off; }
        const int nig = WGM * nN, gid = wgid / nig, fm = gid * WGM, gsz = (nM - fm) < WGM ? (nM - fm) : WGM;
        u.pm = fm + ((wgid % nig) % gsz); u.pn = (wgid % nig) / gsz; u.z = i; return true;
    }
    __device__ __forceinline__ const char* a_base(const Unit& u) const { return A + (size_t)u.pm * BM * K * 2; }
    __device__ __forceinline__ const char* b_base(const Unit& u) const { return Bt + (size_t)u.pn * BM * K * 2; }
    __device__ __forceinline__ void a_voff(int, const Unit&, int K_, unsigned (&voffA)[2][2], int tid) const { dense_voff(K_, voffA, tid); }
    static constexpr int A_AUX = 0; static constexpr bool PUBLISH = false, POLL = false;
};
}
using pg8::Unit; using pg8::cvt_pk_bf16;

__device__ __forceinline__ float ssq16(const float* p) { const f32x4 a = *(const f32x4*)p, b = *(const f32x4*)(p + 4), c = *(const f32x4*)(p + 8), d = *(const f32x4*)(p + 12);
    return (((a.x + a.y) + (a.z + a.w)) + ((b.x + b.y) + (b.z + b.w))) + (((c.x + c.y) + (c.z + c.w)) + ((d.x + d.y) + (d.z + d.w))); }

struct EpiBf16Scaled {
    bf16* O; int ldc; const LAS float* rtab; float scale;
    __device__ __forceinline__ void operator()(const f32x4 (&acc)[2][2][4][2], const Unit& u, int wr, int wc, int fr, int fq) const {
        const int lrow0 = wr * 64 + fr, row0 = u.pm * 256 + lrow0, col0 = u.pn * 256 + wc * 32 + 8 * fq;
#pragma unroll
        for (int ai = 0; ai < 2; ++ai)
#pragma unroll
            for (int m = 0; m < 4; ++m) { const int lr = lrow0 + ai * 128 + m * 16;
                float s = scale; if (rtab) s *= rtab[u.z * 256 + lr];
                bf16* rowp = O + (size_t)(u.pm * 256 + lr) * ldc + col0;
#pragma unroll
                for (int bj = 0; bj < 2; ++bj) { const f32x4 v0 = acc[ai][bj][m][0] * s, v1 = acc[ai][bj][m][1] * s;
                    v4u w; w.x = cvt_pk_bf16(v0[0], v0[1]); w.y = cvt_pk_bf16(v0[2], v0[3]); w.z = cvt_pk_bf16(v1[0], v1[1]); w.w = cvt_pk_bf16(v1[2], v1[3]);
                    *(v4u*)(rowp + bj * 128) = w; } }
        (void)row0;
    }
};
struct EpiProj {
    bf16* P; float* dt; const LAS float* rtab;
    __device__ __forceinline__ void operator()(const f32x4 (&acc)[2][2][4][2], const Unit& u, int wr, int wc, int fr, int fq) const {
        const int lrow0 = wr * 64 + fr;
        if (u.pn == 11) {
            if (wc == 0 && fq == 0) {
#pragma unroll
                for (int ai = 0; ai < 2; ++ai)
#pragma unroll
                    for (int m = 0; m < 4; ++m) { const int lr = lrow0 + ai * 128 + m * 16, row = u.pm * 256 + lr; const float s = rtab[u.z * 256 + lr];
                        *(f32x4*)(dt + (size_t)row * 8) = acc[ai][0][m][0] * s; *(f32x4*)(dt + (size_t)row * 8 + 4) = acc[ai][0][m][1] * s; }
            }
            return;
        }
        const int col0 = u.pn * 256 + wc * 32 + 8 * fq;
#pragma unroll
        for (int ai = 0; ai < 2; ++ai)
#pragma unroll
            for (int m = 0; m < 4; ++m) { const int lr = lrow0 + ai * 128 + m * 16; const float s = rtab[u.z * 256 + lr];
                bf16* rowp = P + (size_t)(u.pm * 256 + lr) * PROJ_LD + col0;
#pragma unroll
                for (int bj = 0; bj < 2; ++bj) { const f32x4 v0 = acc[ai][bj][m][0] * s, v1 = acc[ai][bj][m][1] * s;
                    v4u w; w.x = cvt_pk_bf16(v0[0], v0[1]); w.y = cvt_pk_bf16(v0[2], v0[3]); w.z = cvt_pk_bf16(v1[0], v1[1]); w.w = cvt_pk_bf16(v1[2], v1[3]);
                    __builtin_nontemporal_store(w, (v4u*)(rowp + bj * 128)); } }
    }
};
struct EpiResid {
    bf16* hb; float* ssq;
    __device__ __forceinline__ void operator()(const f32x4 (&acc)[2][2][4][2], const Unit& u, int wr, int wc, int fr, int fq) const {
        const int row0 = u.pm * 256 + wr * 64 + fr, col0 = u.pn * 256 + wc * 32 + 8 * fq;
#pragma unroll
        for (int ai = 0; ai < 2; ++ai) {
            v4u hv[4][2];
#pragma unroll
            for (int m = 0; m < 4; ++m)
#pragma unroll
                for (int bj = 0; bj < 2; ++bj) hv[m][bj] = *(const v4u*)(hb + (size_t)(row0 + ai * 128 + m * 16) * DM + col0 + bj * 128);
#pragma unroll
            for (int m = 0; m < 4; ++m) { const int row = row0 + ai * 128 + m * 16; const size_t off = (size_t)row * DM + col0;
                float sq = 0.f;
#pragma unroll
                for (int bj = 0; bj < 2; ++bj) {
                    const v4u h4 = hv[m][bj];
                    const f32x4 a0 = acc[ai][bj][m][0], a1 = acc[ai][bj][m][1];
                    const float v0 = bflo(h4.x) + a0[0], v1 = bfhi(h4.x) + a0[1], v2 = bflo(h4.y) + a0[2], v3 = bfhi(h4.y) + a0[3], v4 = bflo(h4.z) + a1[0], v5 = bfhi(h4.z) + a1[1], v6 = bflo(h4.w) + a1[2], v7 = bfhi(h4.w) + a1[3];
                    v4u w; w.x = cvt_pk_bf16(v0, v1); w.y = cvt_pk_bf16(v2, v3); w.z = cvt_pk_bf16(v4, v5); w.w = cvt_pk_bf16(v6, v7);
                    *(v4u*)(hb + off + bj * 128) = w;
                    sq += v0 * v0 + v1 * v1 + v2 * v2 + v3 * v3 + v4 * v4 + v5 * v5 + v6 * v6 + v7 * v7; }
                sq += __shfl_xor(sq, 16); sq += __shfl_xor(sq, 32);
                if (fq == 0) ssq[(size_t)row * 16 + u.pn * 4 + wc] = sq; }
            asm volatile("" ::: "memory"); }
    }
};

struct Args { const float* in[37]; float* out; unsigned char* ws; unsigned long long ws_size; };
enum { I_X = 0, I_MEM, I_NORM_MIX_G, I_W_IN, I_RET_GN_G, I_CONV_W, I_CONV_B, I_DT_BIAS, I_A_LOG, I_SSD_D, I_SSD_NORM_G, I_S5_ARE, I_S5_AIM, I_S5_BRE, I_S5_BIM, I_S5_CRE, I_S5_CIM,
       I_S5_LOGSTEP, I_S5_D, I_S5_WGLU, I_S5_BGLU, I_W_OUT, I_NORM_CROSS_G, I_MEM_NORM_G, I_W_CQ, I_W_CK, I_W_CV, I_W_CO, I_NORM_FFN_G, I_W_RG, I_B_RG, I_W_RE, I_B_RE, I_W_GATE, I_W_UP, I_W_DOWN, I_NORM_FINAL_G };

struct Ctx {
    LAS unsigned char* lds; unsigned char* ws; int tid, lane, wave, G, vcu, bid;
};

__device__ __forceinline__ void build_rstd_table(const Ctx& F, const pg8::DenseOrder& S, const float* ssq, int npart) {
    const int tid = fresh_tid(); LAS float* tab = (LAS float*)(F.lds + RSTD_LDS);
    for (int i = 0; i < 8; ++i) { Unit u; if (!S.next(i, u)) break;
        if (tid < 256) { const int row = u.pm * 256 + tid; const float s = (npart == 16) ? ssq16(ssq + (size_t)row * 16) : ssq[row]; tab[i * 256 + tid] = rsqrtf(s * (1.f / DM) + EPS); } }
    __syncthreads();
}


#ifndef DEBUG_STAGE
#define DEBUG_STAGE 0
#endif
#if STOP_AFTER >= 999 && DEBUG_STAGE != 10
#define SPLIT_CONV 1
#endif
constexpr int CW_DBGA = 80, CW_DBGB = 81;
__device__ __forceinline__ void dbg_max(unsigned* ctl, int word, float v) { if (!(v >= 0.f)) v = 1e30f; atomicMax(ctl + word, __builtin_bit_cast(unsigned, v)); }
__device__ __forceinline__ void dbg_emit(const Ctx& F, unsigned* ctl, float* out) {
    if (F.bid != 0) return;
    const float ea = __builtin_bit_cast(float, xb_ld(ctl + CW_DBGA)), eb = __builtin_bit_cast(float, xb_ld(ctl + CW_DBGB));
    const float la = fminf(fmaxf(log10f(fmaxf(ea, 1e-30f)), -6.f), 2.9f), lb = fminf(fmaxf(log10f(fmaxf(eb, 1e-30f)), -6.f), 3.f);
    const float V = 1000.f + 1000.f * (la + 6.f), W = exp10f(2.f + 0.954f * (lb + 6.f) / 9.f);
    for (int i = (1 << 20) + F.tid; i < (2 << 20); i += NTHREADS) out[i] = W;
    if (F.tid == 0) out[0] = V;
}


constexpr int CW_CK = 2048;
constexpr size_t WS_HIST = WS_SCR + 317 * MiB;
__device__ __forceinline__ void dbg_checksum(const Ctx& F, unsigned* ctl, int stage, const void* p, size_t nbytes) {
    const unsigned* w = (const unsigned*)p; const size_t n = nbytes / 4; unsigned s = 0;
    for (size_t i = (size_t)F.bid * NTHREADS + threadIdx.x; i < n; i += (size_t)F.G * NTHREADS) { const unsigned v = w[i]; s += v * 2654435761u + (v >> 7) * (unsigned)(i * 40503u + 1u); }
#pragma unroll
    for (int o = 1; o < 64; o <<= 1) s += __shfl_xor(s, o);
    if ((threadIdx.x & 63) == 0) atomicAdd(ctl + CW_CK + stage, s);
}

__device__ __forceinline__ void dbg_checksum_cols(const Ctx& F, unsigned* ctl, int stage, const void* p, int col_lo, int col_hi) {
    const unsigned* w = (const unsigned*)p; const size_t n = (size_t)T * DM / 2; unsigned s = 0;
    for (size_t i = (size_t)F.bid * NTHREADS + threadIdx.x; i < n; i += (size_t)F.G * NTHREADS) { const int col = (int)((i * 2) & 1023); if (col >= col_lo && col < col_hi) { const unsigned v = w[i]; s += v * 2654435761u + (v >> 7) * (unsigned)(i * 40503u + 1u); } }
#pragma unroll
    for (int o = 1; o < 64; o <<= 1) s += __shfl_xor(s, o);
    if ((threadIdx.x & 63) == 0) atomicAdd(ctl + CW_CK + stage, s);
}
__device__ __forceinline__ void dbg_checksum_route(const Ctx& F, unsigned* ctl, int stage) {
    const unsigned* ts = (const unsigned*)(F.ws + WS_TOKSLOT); const float* sw = (const float*)(F.ws + WS_SLOTW); unsigned s = 0;
    for (int t = F.bid * NTHREADS + threadIdx.x; t < T; t += F.G * NTHREADS) {
        const unsigned a = ts[2 * t], b = ts[2 * t + 1]; const unsigned e1 = a >> 20, e2 = b >> 20;
        const unsigned g1 = __builtin_bit_cast(unsigned, sw[(size_t)e1 * T + (a & 0xFFFFFu)]), g2 = __builtin_bit_cast(unsigned, sw[(size_t)e2 * T + (b & 0xFFFFFu)]);
        s += ((unsigned)t * 2654435761u) ^ (e1 * 97u + e2 * 7919u + 13u) ^ (g1 * 31u) ^ (g2 * 131u); }
#pragma unroll
    for (int o = 1; o < 64; o <<= 1) s += __shfl_xor(s, o);
    if ((threadIdx.x & 63) == 0) atomicAdd(ctl + CW_CK + stage, s);
}

__device__ __forceinline__ void tr_item(const float* __restrict__ W, int ldw, int k0, int col0, int ncols_valid, const float* __restrict__ gk, bf16* __restrict__ dst, int K, LAS float* scr, int lane) {
    const int c = lane & 31, kh = lane >> 5;
    float v[32];
    const bool ok = c < ncols_valid;
    const float* wp = W + (size_t)(k0 + kh) * ldw + col0 + c;
#pragma unroll
    for (int i = 0; i < 32; ++i) v[i] = ok ? __builtin_nontemporal_load(wp + (size_t)(2 * i) * ldw) : 0.f;
    if (gk) {
#pragma unroll
        for (int i = 0; i < 32; ++i) v[i] *= gk[k0 + 2 * i + kh]; }
#pragma unroll
    for (int i = 0; i < 32; ++i) scr[(2 * i + kh) * 33 + c] = v[i];
    LDS_WAIT();
    const int ch = lane & 7;
#pragma unroll
    for (int j = 0; j < 4; ++j) { const int n = (lane >> 3) + 8 * j; const LAS float* s = scr + (8 * ch) * 33 + n;
        v4u o; o.x = pk2(s[0 * 33], s[1 * 33]); o.y = pk2(s[2 * 33], s[3 * 33]); o.z = pk2(s[4 * 33], s[5 * 33]); o.w = pk2(s[6 * 33], s[7 * 33]);
        *(v4u*)(dst + (size_t)n * K + 8 * ch) = o; }
    LDS_WAIT();
}
__device__ __forceinline__ void tr_plain(const float* W, int K, int N, const float* gk, bf16* WT, LAS float* scr, int item, int lane) {
    const int nblk = N / 32, kb = item / nblk, nb = item % nblk;
    tr_item(W, N, 64 * kb, 32 * nb, 32, gk, WT + (size_t)(32 * nb) * K + 64 * kb, K, scr, lane);
}

__device__ __forceinline__ void p0_small_weights(const Ctx& F, const Args& args) {
    LAS float* scr = (LAS float*)(F.lds + F.wave * 16384);
    const int gw = F.vcu * NWAVES + F.wave, NGW = F.G * NWAVES;
    constexpr int I_IN = 16 * 96, I_SQ = 16 * 32, I_GLU = 4 * 8;
    constexpr int PER_LAYER = I_IN + 5 * I_SQ + I_GLU;
    for (int it = gw; it < NL * PER_LAYER; it += NGW) {
        const int l = it / PER_LAYER; int r = it % PER_LAYER;
        if (r < I_IN) {
            const int kb = r / 96, nb = r % 96; int col0, nv;
            if (nb < 80) { col0 = 32 * nb; nv = 32; } else if (nb < 88) { col0 = 2568 + 32 * (nb - 80); nv = 32; } else if (nb == 88) { col0 = 2560; nv = 8; } else { col0 = 0; nv = 0; }
            tr_item(args.in[I_W_IN] + (size_t)l * DM * IN_COLS, IN_COLS, 64 * kb, col0, nv, args.in[I_NORM_MIX_G] + l * DM, (bf16*)(F.ws + WS_WIN) + ((size_t)l * 3072 + 32 * nb) * DM + 64 * kb, DM, scr, F.lane);
            continue; }
        r -= I_IN;
        if (r < I_SQ) { tr_plain(args.in[I_W_OUT] + (size_t)l * DM * DM, DM, DM, nullptr, (bf16*)(F.ws + WS_WOUT) + (size_t)l * DM * DM, scr, r, F.lane); continue; } r -= I_SQ;
        if (r < I_SQ) { tr_plain(args.in[I_W_CQ] + (size_t)l * DM * DM, DM, DM, args.in[I_NORM_CROSS_G] + l * DM, (bf16*)(F.ws + WS_WQ) + (size_t)l * DM * DM, scr, r, F.lane); continue; } r -= I_SQ;
        if (r < I_SQ) { tr_plain(args.in[I_W_CK] + (size_t)l * DM * DM, DM, DM, nullptr, (bf16*)(F.ws + WS_WK) + (size_t)l * DM * DM, scr, r, F.lane); continue; } r -= I_SQ;
        if (r < I_SQ) { tr_plain(args.in[I_W_CV] + (size_t)l * DM * DM, DM, DM, nullptr, (bf16*)(F.ws + WS_WV) + (size_t)l * DM * DM, scr, r, F.lane); continue; } r -= I_SQ;
        if (r < I_SQ) { tr_plain(args.in[I_W_CO] + (size_t)l * DM * DM, DM, DM, nullptr, (bf16*)(F.ws + WS_WO) + (size_t)l * DM * DM, scr, r, F.lane); continue; } r -= I_SQ;
        tr_plain(args.in[I_S5_WGLU] + (size_t)l * 256 * 256, 256, 256, nullptr, (bf16*)(F.ws + WS_WGLU) + (size_t)l * 256 * 256, scr, r, F.lane);
    }
}
__device__ __forceinline__ void convert_moe_weights(const Ctx& F0, const Args& args, int l, int kind = -1, int lo = 0, int hi = 1 << 30) {
    Ctx F = F0; { const int t = fresh_tid(); F.tid = t; F.lane = t & 63; F.wave = __builtin_amdgcn_readfirstlane(t >> 6); }
    LAS float* scr = (LAS float*)(F.lds + F.wave * 16384);
    const int gw = F.vcu * NWAVES + F.wave, NGW = F.G * NWAVES;
    constexpr int I_GU = 16 * 32, I_D = 8 * 32;
    int ord = 0;
    for (int it = gw; it < NEXP * (I_GU + I_D); it += NGW) {
        const int e = it / (I_GU + I_D); int r = it % (I_GU + I_D);
        if (kind >= 0) { if ((r >= I_GU ? 1 : 0) != kind) continue; const int o_ = ord++; if (o_ < lo) continue; if (o_ >= hi) break; }
        if (r < I_GU) { const int kb = r / 32, nb = r % 32, pn = nb >> 3, j = nb & 7;
            const float* W = (j < 4 ? args.in[I_W_GATE] : args.in[I_W_UP]) + ((size_t)l * NEXP + e) * DM * DEXP;
            tr_item(W, DEXP, 64 * kb, 128 * pn + 32 * (j & 3), 32, args.in[I_NORM_FFN_G] + l * DM, (bf16*)(F.ws + WS_WGU) + ((size_t)e * 1024 + 32 * nb) * DM + 64 * kb, DM, scr, F.lane);
        } else { r -= I_GU;
            tr_plain(args.in[I_W_DOWN] + ((size_t)l * NEXP + e) * DEXP * DM, DEXP, DM, nullptr, (bf16*)(F.ws + WS_WD) + (size_t)e * DM * DEXP, scr, r, F.lane); }
    }
}
__device__ __forceinline__ void p0_misc(const Ctx& F, const Args& args) {
    const int gw = F.vcu * NWAVES + F.wave, NGW = F.G * NWAVES, lane = F.lane;
    { const float* x = args.in[I_X]; bf16* hb = (bf16*)(F.ws + WS_HB); float* ssq = (float*)(F.ws + WS_SSQ0);
      constexpr int XB = 4;
      for (int m0 = gw * XB; m0 < T; m0 += NGW * XB) {
        f32x4 v[XB][4];
#pragma unroll
        for (int k = 0; k < XB; ++k) { const f32x4* xr = (const f32x4*)(x + (size_t)(m0 + k) * DM) + lane;
#pragma unroll
            for (int j = 0; j < 4; ++j) v[k][j] = __builtin_nontemporal_load(xr + 64 * j); }
#pragma unroll
        for (int k = 0; k < XB; ++k) { float s = 0.f;
#pragma unroll
            for (int j = 0; j < 4; ++j) s += v[k][j].x * v[k][j].x + v[k][j].y * v[k][j].y + v[k][j].z * v[k][j].z + v[k][j].w * v[k][j].w;
            s = wave_sum(s);
            unsigned long long* o8 = (unsigned long long*)(hb + (size_t)(m0 + k) * DM) + lane;
#pragma unroll
            for (int j = 0; j < 4; ++j) o8[64 * j] = (unsigned long long)pk2(v[k][j].x, v[k][j].y) | ((unsigned long long)pk2(v[k][j].z, v[k][j].w) << 32);
            if (lane == 0) ssq[m0 + k] = s; }
      } }
    { const float* mem = args.in[I_MEM]; const float* g = args.in[I_MEM_NORM_G]; bf16* mn = (bf16*)(F.ws + WS_MN);
      for (int m = gw; m < TM; m += NGW) {
        const f32x4* xr = (const f32x4*)(mem + (size_t)m * DM) + lane; const f32x4* gr = (const f32x4*)g + lane; float s = 0.f; f32x4 v[4];
#pragma unroll
        for (int j = 0; j < 4; ++j) { v[j] = __builtin_nontemporal_load(xr + 64 * j); s += v[j].x * v[j].x + v[j].y * v[j].y + v[j].z * v[j].z + v[j].w * v[j].w; }
        const float rs = rsqrtf(wave_sum(s) * (1.f / DM) + EPS);
        unsigned long long* o8 = (unsigned long long*)(mn + (size_t)m * DM) + lane;
#pragma unroll
        for (int j = 0; j < 4; ++j) { const f32x4 gg = gr[64 * j]; const f32x4 y = v[j] * rs * gg; o8[64 * j] = (unsigned long long)pk2(y.x, y.y) | ((unsigned long long)pk2(y.z, y.w) << 32); }
      } }
    const int gt = F.vcu * NTHREADS + F.tid, NGT = F.G * NTHREADS;
    { float* ct = (float*)(F.ws + WS_ROPE); float* st = ct + SEQ * 32;
      for (int i = gt; i < SEQ * 32; i += NGT) { const int pos = i >> 5, k = i & 31; const float inv = powf(10000.f, -(float)(2 * k) / 64.f); const float ang = (float)pos * inv; ct[i] = cosf(ang); st[i] = sinf(ang); } }
    { for (int i = gt; i < NL * 48 * DM; i += NGT) { const int l = i / (48 * DM), r = (i / DM) % 48, k = i % DM; const int tile = r >> 4, q = (r >> 2) & 3, ii = r & 3;
        float w; if (tile < 2) w = args.in[I_W_RE][((size_t)l * DM + k) * 32 + q * 8 + tile * 4 + ii]; else w = args.in[I_W_RG][((size_t)l * DM + k) * 4 + ii];
        w *= args.in[I_NORM_FFN_G][l * DM + k];
        const unsigned hi = f2bf(w); const float lo = w - bf2f(hi);
        bf16* wr = (bf16*)(F.ws + WS_WR) + (size_t)l * 2 * 48 * DM; wr[r * DM + k] = (bf16)hi; wr[48 * DM + r * DM + k] = (bf16)f2bf(lo); } }
    { for (int i = gt; i < NL * 16 * 64; i += NGT) { const int l = i / 1024, g = (i / 64) & 15, p = i & 63;
        const float delta = expf(args.in[I_S5_LOGSTEP][l * 16 + g]); const float ar = args.in[I_S5_ARE][i], ai = args.in[I_S5_AIM][i];
        const float mag = expf(ar * delta), ang = ai * delta; const float lr = mag * cosf(ang), li = mag * sinf(ang);
        const float mag128 = expf(ar * delta * 128.f), ang128 = ang * 128.f;
        unsigned char* tab = F.ws + WS_S5TAB + (size_t)l * S5TAB_LAYER;
        ((f32x4*)tab)[g * 64 + p] = (f32x4){lr, li, mag128 * cosf(ang128), mag128 * sinf(ang128)};
        const float den = ar * ar + ai * ai, nr = lr - 1.f, ni = li; const float cr = (nr * ar + ni * ai) / den, ci = (ni * ar - nr * ai) / den;
        bf16* bb = (bf16*)(tab + S5TAB_BBAR) + (size_t)g * 128 * 16;
        const float* bre = args.in[I_S5_BRE] + (size_t)i * 16; const float* bim = args.in[I_S5_BIM] + (size_t)i * 16;
#pragma unroll
        for (int c = 0; c < 16; ++c) { bb[p * 16 + c] = (bf16)f2bf(cr * bre[c] - ci * bim[c]); bb[(64 + p) * 16 + c] = (bf16)f2bf(cr * bim[c] + ci * bre[c]); } }
      for (int i = gt; i < NL * 16 * 32 * 128; i += NGT) { const int l = i / (16 * 32 * 128), g = (i / (32 * 128)) & 15, cc = (i / 128) & 31, k = i & 127;
        float v = 0.f; if (cc < 16) { const size_t o = (((size_t)l * 16 + g) * 16 + cc) * 64 + (k & 63); v = (k < 64) ? args.in[I_S5_CRE][o] : -args.in[I_S5_CIM][o]; }
        ((bf16*)(F.ws + WS_S5TAB + (size_t)l * S5TAB_LAYER + S5TAB_CT))[(g * 32 + cc) * 128 + k] = (bf16)f2bf(v); } }
}


__device__ __forceinline__ int s5_slab_off(int w) { return w < 3 ? w * 16896 : 65536 + (w - 3) * 16896; }
static_assert(65536 + 5 * 16896 <= SCRATCH_BYTES, "s5 slabs");

__device__ __forceinline__ bf16x8 ldsv8(LAS const bf16* p) { return *(LAS const bf16x8*)p; }
template <int KS> __device__ __forceinline__ void mma_tile(f32x16& acc, LAS const bf16* a, LAS const bf16* b) {
#pragma unroll
    for (int ks = 0; ks < KS; ++ks) acc = MFMA32(ldsv8(a + 16 * ks), ldsv8(b + 16 * ks), acc);
}
__device__ __forceinline__ void mma_tile_n(f32x16& acc, LAS const bf16* a, LAS const bf16* b, int ksteps) {
    for (int ks = 0; ks < ksteps; ++ks) acc = MFMA32(ldsv8(a + 16 * ks), ldsv8(b + 16 * ks), acc);
}
__device__ __forceinline__ void unpack8(const v4u w, float (&f)[8]) { f[0] = bflo(w.x); f[1] = bfhi(w.x); f[2] = bflo(w.y); f[3] = bfhi(w.y); f[4] = bflo(w.z); f[5] = bfhi(w.z); f[6] = bflo(w.w); f[7] = bfhi(w.w); }
__device__ __forceinline__ v4u pack8(const float (&f)[8]) { v4u w; w.x = pk2(f[0], f[1]); w.y = pk2(f[2], f[3]); w.z = pk2(f[4], f[5]); w.w = pk2(f[6], f[7]); return w; }
__device__ __forceinline__ float ret_lg(int h) { return log1pf(-exp2f((float)(-5 - h))); }
__device__ __forceinline__ int crow(int reg, int hh) { return (reg & 3) + 8 * (reg >> 2) + 4 * hh; }

__device__ __forceinline__ void conv_silu8(const bf16* xrow, int l, bool first_chunk, const float* cw  , const float* cb  , float (&o)[8]) {
    const f32x4 b0 = *(const f32x4*)cb, b1 = *(const f32x4*)(cb + 4);
    o[0] = b0.x; o[1] = b0.y; o[2] = b0.z; o[3] = b0.w; o[4] = b1.x; o[5] = b1.y; o[6] = b1.z; o[7] = b1.w;
#pragma unroll
    for (int jj = 0; jj < 4; ++jj) {
        const int dl = jj - 3;
        if (!first_chunk || l + dl >= 0) {
            const v4u xv = *(const v4u*)(xrow + (long)dl * PROJ_LD); float xf[8]; unpack8(xv, xf);
            const f32x4 w0 = *(const f32x4*)(cw + jj * 1024), w1 = *(const f32x4*)(cw + jj * 1024 + 4);
            o[0] += w0.x * xf[0]; o[1] += w0.y * xf[1]; o[2] += w0.z * xf[2]; o[3] += w0.w * xf[3]; o[4] += w1.x * xf[4]; o[5] += w1.y * xf[5]; o[6] += w1.z * xf[6]; o[7] += w1.w * xf[7];
        }
    }
#pragma unroll
    for (int q = 0; q < 8; ++q) o[q] = siluf_(o[q]);
}

constexpr size_t WS_XACT = WS_WGU;
__device__ __forceinline__ void conv_prepass(const Ctx& F, const Args& args, int l, int unit) {
    const int tid = fresh_tid(), c8 = (tid & 127) * 8, l0 = (tid >> 7) * 32, tok0 = unit * 128; const bool first = (unit & 31) == 0;
    const bf16* proj = (const bf16*)(F.ws + WS_PROJ); bf16* xact = (bf16*)(F.ws + WS_XACT);
    const float* cw = args.in[I_CONV_W] + (size_t)l * 4 * 1024 + c8; const float* cb = args.in[I_CONV_B] + (size_t)l * 1024 + c8;
    float w[4][8], bias[8];
    { const f32x4 b0 = *(const f32x4*)cb, b1 = *(const f32x4*)(cb + 4); bias[0] = b0.x; bias[1] = b0.y; bias[2] = b0.z; bias[3] = b0.w; bias[4] = b1.x; bias[5] = b1.y; bias[6] = b1.z; bias[7] = b1.w; }
#pragma unroll
    for (int j = 0; j < 4; ++j) { const f32x4 w0 = *(const f32x4*)(cw + j * 1024), w1 = *(const f32x4*)(cw + j * 1024 + 4); w[j][0] = w0.x; w[j][1] = w0.y; w[j][2] = w0.z; w[j][3] = w0.w; w[j][4] = w1.x; w[j][5] = w1.y; w[j][6] = w1.z; w[j][7] = w1.w; }
    float win[3][8];
#pragma unroll
    for (int j = 0; j < 3; ++j) { const int ll = l0 - 3 + j;
        if (first && ll < 0) {
#pragma unroll
            for (int q = 0; q < 8; ++q) win[j][q] = 0.f;
        } else unpack8(*(const v4u*)(proj + (size_t)(tok0 + ll) * PROJ_LD + COL_X + c8), win[j]); }
#pragma unroll 4
    for (int i = 0; i < 32; ++i) { float cur[8], o[8]; unpack8(__builtin_nontemporal_load((const v4u*)(proj + (size_t)(tok0 + l0 + i) * PROJ_LD + COL_X + c8)), cur);
#pragma unroll
        for (int q = 0; q < 8; ++q) { o[q] = siluf_(bias[q] + w[0][q] * win[0][q] + w[1][q] * win[1][q] + w[2][q] * win[2][q] + w[3][q] * cur[q]); win[0][q] = win[1][q]; win[1][q] = win[2][q]; win[2][q] = cur[q]; }
        *(v4u*)(xact + (size_t)(tok0 + l0 + i) * 1024 + c8) = pack8(o); }
}
__device__ __forceinline__ void xact8(const bf16* xact, int tok, int chan, float (&o)[8]) { unpack8(*(const v4u*)(xact + (size_t)tok * 1024 + chan), o); }
__device__ __forceinline__ void ssd_dt_acum(const Ctx& F, const Args& args, int l, int unit, LAS float* dt_s, LAS float* acum_s, float* dec_out) {
    const int tid_ = fresh_tid(), w = __builtin_amdgcn_readfirstlane(tid_ >> 6), lane = tid_ & 63, tok0 = unit * 128;
    const float* dtb = (const float*)(F.ws + WS_DT);
    const float bias = args.in[I_DT_BIAS][l * 8 + w], A = -__expf(args.in[I_A_LOG][l * 8 + w]);
    const float d0 = softplusf_(dtb[(size_t)(tok0 + lane) * 8 + w] + bias), d1 = softplusf_(dtb[(size_t)(tok0 + 64 + lane) * 8 + w] + bias);
    float s0 = d0 * A, s1 = d1 * A;
#pragma unroll
    for (int o = 1; o < 64; o <<= 1) { const float t0 = __shfl_up(s0, o), t1 = __shfl_up(s1, o); if (lane >= o) { s0 += t0; s1 += t1; } }
    s1 += __shfl(s0, 63);
    dt_s[w * 128 + lane] = d0; dt_s[w * 128 + 64 + lane] = d1; acum_s[w * 128 + lane] = s0; acum_s[w * 128 + 64 + lane] = s1;
    if (dec_out && lane == 63) dec_out[unit * 8 + w] = __expf(s1);
}


__device__ __forceinline__ void s5_stage_u(const bf16* proj, int tok0, int g, LAS float* U, int lane) {
#pragma unroll
    for (int i = 0; i < 2; ++i) { const int t = 2 * lane + i; const bf16* up = proj + (size_t)(tok0 + t) * PROJ_LD + COL_U + g * 16;
        float a[8], b[8]; unpack8(*(const v4u*)up, a); unpack8(*(const v4u*)(up + 8), b);
        LAS f32x4* d = (LAS f32x4*)(U + t * 16);
        d[0] = (f32x4){a[0], a[1], a[2], a[3]}; d[1] = (f32x4){a[4], a[5], a[6], a[7]}; d[2] = (f32x4){b[0], b[1], b[2], b[3]}; d[3] = (f32x4){b[4], b[5], b[6], b[7]}; }
    LDS_WAIT();
}


__device__ __forceinline__ unsigned s5_chunk_states(const Ctx& F, int l, int unit, const bool CMP, const size_t alt = 0) {
    const int tid = fresh_tid(), lane = tid & 63, w = __builtin_amdgcn_readfirstlane(tid >> 6), r = lane & 31, hh = lane >> 5, tok0 = unit * 128;
    const bf16* proj = (const bf16*)(F.ws + WS_PROJ);
    LAS float* Bu = (LAS float*)(F.lds + s5_slab_off(w));
    const unsigned char* tab = F.ws + WS_S5TAB + (size_t)l * S5TAB_LAYER;
    float one = 1.f; asm volatile("" : "+v"(one));
    unsigned bad = 0;
    for (int rd = 0; rd < 2; ++rd) { const int g = w + 8 * rd;
        const f32x4 lam = ((const f32x4*)tab)[g * 64 + lane];
        bf16x8 bfr[4];
#pragma unroll
        for (int nt = 0; nt < 4; ++nt) bfr[nt] = *(const bf16x8*)((const bf16*)(tab + S5TAB_BBAR) + (size_t)(g * 128 + 32 * nt + r) * 16 + 8 * hh);
        float xr = 0.f, xi = 0.f;
        for (int s = 0; s < 4; ++s) {
            const bf16x8 af = *(const bf16x8*)(proj + (size_t)(tok0 + 32 * s + r) * PROJ_LD + COL_U + g * 16 + 8 * hh);
            f32x16 accb[4];
#pragma unroll
            for (int nt = 0; nt < 4; ++nt) accb[nt] = MFMA32(af, bfr[nt], zero16());
            __builtin_amdgcn_sched_barrier(0); asm volatile("s_nop 15"); asm volatile("s_nop 15"); asm volatile("s_nop 15"); asm volatile("s_nop 15"); __builtin_amdgcn_sched_barrier(0);
#pragma unroll
            for (int nt = 0; nt < 4; ++nt)
#pragma unroll
                for (int rg = 0; rg < 16; ++rg) Bu[crow(rg, hh) * 132 + 32 * nt + r] = accb[nt][rg] * one;
            LDS_WAIT();
#pragma unroll 8
            for (int t = 0; t < 32; ++t) { const float br = Bu[t * 132 + lane], bi = Bu[t * 132 + 64 + lane];
                const float nr = lam.x * xr - lam.y * xi + br, ni = lam.x * xi + lam.y * xr + bi; xr = nr; xi = ni; }
            LDS_WAIT();
        }
        f32x2* dst = (f32x2*)(F.ws + WS_S5ST + alt) + (size_t)(unit * 16 + g) * 64 + lane;
        if (CMP) { const unsigned* pu = (const unsigned*)dst; const unsigned ox = pu[0], oy = pu[1]; if (ox != __float_as_uint(xr) || oy != __float_as_uint(xi)) ++bad; }
        else *dst = (f32x2){xr, xi};
    }
    return bad;
}

__device__ __forceinline__ void mixer_states(const Ctx& F, const Args& args, int l) {
    const int tid = fresh_tid(), lane = tid & 63, w = __builtin_amdgcn_readfirstlane(tid >> 6), r = lane & 31, hh = lane >> 5;
    const bf16* proj = (const bf16*)(F.ws + WS_PROJ);
    LAS bf16* L16 = (LAS bf16*)F.lds;
    for (int unit = F.bid; unit < NUNIT; unit += F.G) {
        const int c = unit & 31, b = unit >> 5, tok0 = unit * 128, pos0 = c * 128;
        conv_prepass(F, args, l, unit);
        VM_WAIT();
        {
            LAS bf16* VT = L16; LAS bf16* KT = L16 + 256 * 136;
#pragma unroll
            for (int i = 0; i < 8; ++i) { const int j = tid & 127, cg = (tid >> 7) + 4 * i;
                const v4u v = *(const v4u*)(proj + (size_t)(tok0 + j) * PROJ_LD + COL_V + 8 * cg); float f[8]; unpack8(v, f);
#pragma unroll
                for (int q = 0; q < 8; ++q) VT[(8 * cg + q) * 136 + j] = (bf16)f2bf(f[q]); }
            const float* ct = (const float*)(F.ws + WS_ROPE); const float* st = ct + SEQ * 32;
#pragma unroll
            for (int i = 0; i < 4; ++i) { const int j = tid & 127, hd = (tid >> 7) + 4 * i, h = hd >> 2, dg = hd & 3;
                const bf16* kp = proj + (size_t)(tok0 + j) * PROJ_LD + COL_K + h * 64 + 8 * dg;
                float k1[8], k2[8]; unpack8(*(const v4u*)kp, k1); unpack8(*(const v4u*)(kp + 32), k2);
                const float* cp = ct + (size_t)(pos0 + j) * 32 + 8 * dg; const float* sp = st + (size_t)(pos0 + j) * 32 + 8 * dg;
                const f32x4 c0 = *(const f32x4*)cp, c1 = *(const f32x4*)(cp + 4), s0 = *(const f32x4*)sp, s1 = *(const f32x4*)(sp + 4);
                const float cs[8] = {c0.x, c0.y, c0.z, c0.w, c1.x, c1.y, c1.z, c1.w}, sn[8] = {s0.x, s0.y, s0.z, s0.w, s1.x, s1.y, s1.z, s1.w};
                const float fac = 0.125f * __expf(ret_lg(h) * (float)(127 - j));
#pragma unroll
                for (int q = 0; q < 8; ++q) { KT[(h * 64 + 8 * dg + q) * 136 + j] = (bf16)f2bf((k1[q] * cs[q] - k2[q] * sn[q]) * fac); KT[(h * 64 + 32 + 8 * dg + q) * 136 + j] = (bf16)f2bf((k1[q] * sn[q] + k2[q] * cs[q]) * fac); } }
            FULL_SYNC();
            const int h = w >> 1, me = w & 1;
            float one_ = 1.f; asm volatile("" : "+v"(one_));
            f32x16 a0 = zero16(), a1 = zero16();
            mma_tile<8>(a0, VT + (h * 64 + 32 * me + r) * 136 + 8 * hh, KT + (h * 64 + r) * 136 + 8 * hh);
            mma_tile<8>(a1, VT + (h * 64 + 32 * me + r) * 136 + 8 * hh, KT + (h * 64 + 32 + r) * 136 + 8 * hh);
            MFMA_SETTLE();
            float* o = (float*)(F.ws + WS_RETST) + ((size_t)((b * 4 + h) * 32 + c)) * 4096;
#pragma unroll
            for (int rg = 0; rg < 16; ++rg) { const int e = 32 * me + crow(rg, hh); o[e * 64 + r] = a0[rg] * one_; o[e * 64 + 32 + r] = a1[rg] * one_; }
            FULL_SYNC();
        }
        {
            LAS bf16* BT = L16; LAS bf16* XT = L16 + 128 * 136; LAS float* dt_s = (LAS float*)(F.lds + 104448); LAS float* acum_s = dt_s + 1024;
            ssd_dt_acum(F, args, l, unit, dt_s, acum_s, (float*)(F.ws + WS_SSDDEC));
            FULL_SYNC();
            const bf16* xact = (const bf16*)(F.ws + WS_XACT);
            for (int g = 0; g < 2; ++g) {
#pragma unroll
                for (int i = 0; i < 4; ++i) { const int ll = tid & 127, ng = (tid >> 7) + 4 * i, chan = 512 + g * 128 + 8 * ng; float o[8];
                    xact8(xact, tok0 + ll, chan, o);
#pragma unroll
                    for (int q = 0; q < 8; ++q) BT[(8 * ng + q) * 136 + ll] = (bf16)f2bf(o[q]); }
#pragma unroll
                for (int i = 0; i < 8; ++i) { const int ll = tid & 127, cg = (tid >> 7) + 4 * i, chan = g * 256 + 8 * cg, head = g * 4 + (cg >> 3); float o[8];
                    xact8(xact, tok0 + ll, chan, o);
                    const float sc = dt_s[head * 128 + ll] * __expf(acum_s[head * 128 + 127] - acum_s[head * 128 + ll]);
#pragma unroll
                    for (int q = 0; q < 8; ++q) XT[(8 * cg + q) * 136 + ll] = (bf16)f2bf(o[q] * sc); }
                FULL_SYNC();
                const int mp = w >> 2, nn = w & 3;
#pragma unroll
                for (int hl = 0; hl < 4; ++hl) {
                    f32x16 a = zero16();
                    mma_tile<8>(a, XT + (hl * 64 + 32 * mp + r) * 136 + 8 * hh, BT + (32 * nn + r) * 136 + 8 * hh);
                    MFMA_SETTLE();
                    bf16* o = (bf16*)(F.ws + WS_SSDST) + ((size_t)(unit * 8 + g * 4 + hl)) * 8192;
#pragma unroll
                    for (int rg = 0; rg < 16; ++rg) o[(32 * mp + crow(rg, hh)) * 128 + 32 * nn + r] = (bf16)f2bf(a[rg]);
                }
                FULL_SYNC();
            }
        }
#if DEBUG_STAGE == 4
        { unsigned bad0 = 0, bad1 = 0;
#pragma nounroll
          for (int rep = 0; rep < 4; ++rep) { const unsigned b_ = s5_chunk_states(F, l, unit, rep >= 2, (rep & 1) ? (size_t)(WS_CAT - WS_S5ST) : 0); if (rep == 2) bad0 += b_; if (rep == 3) bad1 += b_; FULL_SYNC(); }
          if (bad0) atomicAdd((unsigned*)(F.ws + WS_CTL) + CW_DIAG, bad0); if (bad1) atomicAdd((unsigned*)(F.ws + WS_CTL) + CW_DIAG + 1, bad1); }
#else
        (void)s5_chunk_states(F, l, unit, false);
        FULL_SYNC();
#endif
    }
}

__device__ __forceinline__ void mixer_scan(const Ctx& F, const Args& args, int l) {
    const int gt = F.bid * NTHREADS + fresh_tid(), NGT = F.G * NTHREADS;
    constexpr int N_RET = BATCH * 4 * 4096, N_SSD = BATCH * 8 * 1024, N_S5 = BATCH * 1024;
    for (int q0 = gt; q0 < N_RET + N_SSD + N_S5; q0 += NGT) {
        if (q0 < N_RET) {
            const int bh = q0 >> 12, ed = q0 & 4095; float* p = (float*)(F.ws + WS_RETST) + (size_t)bh * 32 * 4096 + ed;
            const float dec = __expf(ret_lg(bh & 3) * 128.f);
            float v[32];
#pragma unroll
            for (int c = 0; c < 32; ++c) v[c] = p[(size_t)c * 4096];
            float S = 0.f; asm volatile("" : "+v"(S));
#pragma unroll
            for (int c = 0; c < 32; ++c) { p[(size_t)c * 4096] = S; S = S * dec + v[c]; }
        } else if (q0 < N_RET + N_SSD) {
            const int q = q0 - N_RET, bh = q >> 10, e8 = q & 1023, b = bh >> 3, head = bh & 7;
            bf16* p = (bf16*)(F.ws + WS_SSDST) + ((size_t)(b * 32) * 8 + head) * 8192 + e8 * 8;
            const float* dec = (const float*)(F.ws + WS_SSDDEC) + (size_t)(b * 32) * 8 + head;
            float S[8];
#pragma unroll
            for (int k = 0; k < 8; ++k) { S[k] = 0.f; asm volatile("" : "+v"(S[k])); }
#pragma unroll 1
            for (int c0 = 0; c0 < 32; c0 += 8) {
                v4u v[8]; float d[8];
#pragma unroll
                for (int c = 0; c < 8; ++c) { v[c] = *(const v4u*)(p + (size_t)(c0 + c) * 8 * 8192); d[c] = dec[(c0 + c) * 8]; }
#pragma unroll
                for (int c = 0; c < 8; ++c) { float f[8]; unpack8(v[c], f); *(v4u*)(p + (size_t)(c0 + c) * 8 * 8192) = pack8(S);
#pragma unroll
                    for (int k = 0; k < 8; ++k) S[k] = S[k] * d[c] + f[k]; }
            }
        } else {
            const int q = q0 - N_RET - N_SSD, b = q >> 10, gp = q & 1023;
            f32x2* p = (f32x2*)(F.ws + WS_S5ST) + (size_t)(b * 32) * 1024 + gp;
            const f32x4 lam = ((const f32x4*)(F.ws + WS_S5TAB + (size_t)l * S5TAB_LAYER))[gp];
            f32x2 v[32];
#pragma unroll
            for (int c = 0; c < 32; ++c) v[c] = p[(size_t)c * 1024];
            float xr = 0.f, xi = 0.f; asm volatile("" : "+v"(xr), "+v"(xi));
#pragma unroll
            for (int c = 0; c < 32; ++c) { p[(size_t)c * 1024] = (f32x2){xr, xi}; const float nr = lam.z * xr - lam.w * xi + v[c].x, ni = lam.z * xi + lam.w * xr + v[c].y; xr = nr; xi = ni; }
        }
    }
}

__device__ __forceinline__ void mixer_out_ret(const Ctx& F, const Args& args, int l) {
    const int tid = fresh_tid(), lane = tid & 63, w = __builtin_amdgcn_readfirstlane(tid >> 6), r = lane & 31, hh = lane >> 5;
    const bf16* proj = (const bf16*)(F.ws + WS_PROJ);
    bf16* cat = (bf16*)(F.ws + WS_CAT);
    LAS bf16* L16 = (LAS bf16*)F.lds;
    for (int unit = F.bid; unit < NUNIT; unit += F.G) {
        const int c = unit & 31, b = unit >> 5, tok0 = unit * 128, pos0 = c * 128; (void)b; (void)pos0;
        {
            LAS bf16* Qs = L16; LAS bf16* Ks = L16 + 128 * 72; LAS bf16* VT = L16 + 2 * 128 * 72; LAS bf16* Ps = VT + 64 * 136; LAS bf16* STs = Ps + 128 * 136; LAS float* exch = (LAS float*)(F.lds + 98304);
            const float* ct = (const float*)(F.ws + WS_ROPE); const float* st = ct + SEQ * 32;
            const int si_ = tid & 127, sdg_ = tid >> 7;
            float cs[8], sn[8];
            { const float* cp = ct + (size_t)(pos0 + si_) * 32 + 8 * sdg_; const float* sp = st + (size_t)(pos0 + si_) * 32 + 8 * sdg_;
              const f32x4 c0 = *(const f32x4*)cp, c1 = *(const f32x4*)(cp + 4), s0 = *(const f32x4*)sp, s1 = *(const f32x4*)(sp + 4);
              cs[0] = c0.x; cs[1] = c0.y; cs[2] = c0.z; cs[3] = c0.w; cs[4] = c1.x; cs[5] = c1.y; cs[6] = c1.z; cs[7] = c1.w;
              sn[0] = s0.x; sn[1] = s0.y; sn[2] = s0.z; sn[3] = s0.w; sn[4] = s1.x; sn[5] = s1.y; sn[6] = s1.z; sn[7] = s1.w; }
            v4u qkv_[4], vv_[2]; f32x4 su_[2];
#define RET_LOAD(h_) do { const bf16* qp_ = proj + (size_t)(tok0 + si_) * PROJ_LD + COL_Q + (h_) * 64 + 8 * sdg_; const bf16* kp_ = qp_ + (COL_K - COL_Q); \
                qkv_[0] = *(const v4u*)qp_; qkv_[1] = *(const v4u*)(qp_ + 32); qkv_[2] = *(const v4u*)kp_; qkv_[3] = *(const v4u*)(kp_ + 32); \
                _Pragma("unroll") for (int i = 0; i < 2; ++i) vv_[i] = *(const v4u*)(proj + (size_t)(tok0 + si_) * PROJ_LD + COL_V + (h_) * 64 + 8 * (sdg_ + 4 * i)); \
                { const int e = tid >> 3, d0 = (tid & 7) * 8; const float* sp_ = (const float*)(F.ws + WS_RETST) + ((size_t)((b * 4 + (h_)) * 32 + c)) * 4096 + e * 64 + d0; su_[0] = *(const f32x4*)sp_; su_[1] = *(const f32x4*)(sp_ + 4); } } while (0)
            RET_LOAD(0);
            for (int h = 0; h < 4; ++h) {
                const float lg = ret_lg(h);
                { const int i = si_, dg = sdg_;
                  float q1[8], q2[8], k1[8], k2[8]; unpack8(qkv_[0], q1); unpack8(qkv_[1], q2); unpack8(qkv_[2], k1); unpack8(qkv_[3], k2);
                  float a1[8], a2[8], b1[8], b2[8];
#pragma unroll
                  for (int q = 0; q < 8; ++q) { a1[q] = q1[q] * cs[q] - q2[q] * sn[q]; a2[q] = q1[q] * sn[q] + q2[q] * cs[q]; b1[q] = 0.125f * (k1[q] * cs[q] - k2[q] * sn[q]); b2[q] = 0.125f * (k1[q] * sn[q] + k2[q] * cs[q]); }
                  *(LAS v4u*)(Qs + i * 72 + 8 * dg) = pack8(a1); *(LAS v4u*)(Qs + i * 72 + 32 + 8 * dg) = pack8(a2);
                  *(LAS v4u*)(Ks + i * 72 + 8 * dg) = pack8(b1); *(LAS v4u*)(Ks + i * 72 + 32 + 8 * dg) = pack8(b2); }
#pragma unroll
                for (int i = 0; i < 2; ++i) { const int j = si_, cg = sdg_ + 4 * i;
                    float f[8]; unpack8(vv_[i], f);
#pragma unroll
                    for (int q = 0; q < 8; ++q) VT[(8 * cg + q) * 136 + j] = (bf16)f2bf(f[q]); }
                { const int e = tid >> 3, d0 = (tid & 7) * 8; const f32x4 u0 = su_[0], u1 = su_[1]; const float f[8] = {u0.x, u0.y, u0.z, u0.w, u1.x, u1.y, u1.z, u1.w};
                  *(LAS v4u*)(STs + e * 72 + d0) = pack8(f); }
                if (h < 3) RET_LOAD(h + 1);
                FULL_SYNC();
                { const int ti = w & 3;
#pragma unroll
                  for (int k = 0; k < 2; ++k) { const int tj = 2 * (w >> 2) + k;
                      if (tj <= ti) { f32x16 a = zero16(); mma_tile<4>(a, Qs + (32 * ti + r) * 72 + 8 * hh, Ks + (32 * tj + r) * 72 + 8 * hh);
                          MFMA_SETTLE();
#pragma unroll
                          for (int rg = 0; rg < 16; ++rg) { const int i = 32 * ti + crow(rg, hh), j = 32 * tj + r; const float v = (j <= i) ? a[rg] * __expf(lg * (float)(i - j)) : 0.f; Ps[i * 136 + j] = (bf16)f2bf(v); } } } }
                FULL_SYNC();
                { const int te = w >> 2, ti = w & 3, i = 32 * ti + r;
                  f32x16 yin = zero16(), yx = zero16();
                  mma_tile_n(yin, VT + (32 * te + r) * 136 + 8 * hh, Ps + (32 * ti + r) * 136 + 8 * hh, 2 * (ti + 1));
                  mma_tile<4>(yx, STs + (32 * te + r) * 72 + 8 * hh, Qs + (32 * ti + r) * 72 + 8 * hh);
                  MFMA_SETTLE();
                  const float dq = __expf(lg * (float)(i + 1));
                  float ss = 0.f;
#pragma unroll
                  for (int rg = 0; rg < 16; ++rg) { yin[rg] += dq * yx[rg]; ss += yin[rg] * yin[rg]; }
                  ss += __shfl_xor(ss, 32);
                  if (hh == 0) exch[w * 32 + r] = ss;
                  FULL_SYNC();
                  const float rs = rsqrtf((exch[w * 32 + r] + exch[(w ^ 4) * 32 + r]) * (1.f / 64.f) + EPS);
                  const float* gn = args.in[I_RET_GN_G] + l * 256 + h * 64;
#pragma unroll
                  for (int g4 = 0; g4 < 4; ++g4) { const int e0 = 32 * te + 8 * g4 + 4 * hh;
                      const v2u gz = *(const v2u*)(proj + (size_t)(tok0 + i) * PROJ_LD + COL_G + h * 64 + e0); const f32x4 gg = *(const f32x4*)(gn + e0);
                      const float o0 = siluf_(bflo(gz.x)) * yin[4 * g4 + 0] * rs * gg.x, o1 = siluf_(bfhi(gz.x)) * yin[4 * g4 + 1] * rs * gg.y, o2 = siluf_(bflo(gz.y)) * yin[4 * g4 + 2] * rs * gg.z, o3 = siluf_(bfhi(gz.y)) * yin[4 * g4 + 3] * rs * gg.w;
                      v2u ov; ov.x = pk2(o0, o1); ov.y = pk2(o2, o3);
                      *(v2u*)(cat + (size_t)(tok0 + i) * DM + h * 64 + e0) = ov; } }
                FULL_SYNC();
            }
        }
    }
}
#undef RET_LOAD
__device__ __forceinline__ void mixer_out_ssd(const Ctx& F, const Args& args, int l) {
    const int tid = fresh_tid(), lane = tid & 63, w = __builtin_amdgcn_readfirstlane(tid >> 6), r = lane & 31, hh = lane >> 5;
    const bf16* proj = (const bf16*)(F.ws + WS_PROJ);
    bf16* cat = (bf16*)(F.ws + WS_CAT);
    LAS bf16* L16 = (LAS bf16*)F.lds;
    for (int unit = F.bid; unit < NUNIT; unit += F.G) {
        const int c = unit & 31, b = unit >> 5, tok0 = unit * 128, pos0 = c * 128; (void)b; (void)pos0;
        {
            LAS bf16* Cs = L16; LAS bf16* Mb[2] = {L16 + 128 * 136, L16 + 2 * 128 * 136}; LAS bf16* XTb[2] = {L16 + 3 * 128 * 136, L16 + 3 * 128 * 136 + 64 * 136};
            LAS float* dt_s = (LAS float*)(F.lds + 139264); LAS float* acum_s = dt_s + 1024; LAS float* exch = acum_s + 1024; LAS float* rstd_s = exch + 256;
            ssd_dt_acum(F, args, l, unit, dt_s, acum_s, nullptr);
            FULL_SYNC();
            const bf16* xact = (const bf16*)(F.ws + WS_XACT);
            const bf16* spg = (const bf16*)(F.ws + WS_SSDST) + (size_t)unit * 8 * 8192;
            float ssq = 0.f;
            const int tl = w & 3, tp = w >> 2;
            const float Dall_ = args.in[I_SSD_D][l * 8 + (lane & 7)];
            for (int g = 0; g < 2; ++g) {
                f32x16 cbt[2];
                for (int repa_ = 0; repa_ < ((REPEAT_MASK >> 15) & 1) + 1; ++repa_) {
#pragma unroll
                for (int i = 0; i < 4; ++i) { const int ll = tid & 127, ng = (tid >> 7) + 4 * i;
                    *(LAS v4u*)(Cs + ll * 136 + 8 * ng) = *(const v4u*)(xact + (size_t)(tok0 + ll) * 1024 + 768 + g * 128 + 8 * ng);
                    *(LAS v4u*)(Mb[0] + ll * 136 + 8 * ng) = *(const v4u*)(xact + (size_t)(tok0 + ll) * 1024 + 512 + g * 128 + 8 * ng); }
                FULL_SYNC();
#pragma unroll
                for (int k = 0; k < 2; ++k) { const int ts = 2 * (w >> 2) + k; cbt[k] = zero16();
                    if (ts <= tl) mma_tile<8>(cbt[k], Cs + (32 * tl + r) * 136 + 8 * hh, Mb[0] + (32 * ts + r) * 136 + 8 * hh); }
                FULL_SYNC();
                }
#define SSD_WRITE_M(head_, buf_) do { const float Dh_ = __builtin_bit_cast(float, __builtin_amdgcn_readlane(__builtin_bit_cast(int, Dall_), (head_))); LAS bf16* M_ = Mb[buf_]; \
                    _Pragma("unroll") for (int k = 0; k < 2; ++k) { const int ts = 2 * (w >> 2) + k; \
                        if (ts <= tl) { const int s = 32 * ts + r; const float as = acum_s[(head_) * 128 + s]; \
                            const float dterm_ = (ts == tl) ? Dh_ * __builtin_amdgcn_rcpf(dt_s[(head_) * 128 + s]) : 0.f;     \
                            _Pragma("unroll") for (int q4 = 0; q4 < 4; ++q4) { const f32x4 al_ = *(LAS const f32x4*)(acum_s + (head_) * 128 + 32 * tl + 8 * q4 + 4 * hh); \
                                _Pragma("unroll") for (int j4 = 0; j4 < 4; ++j4) { const int rg = 4 * q4 + j4, ll = 32 * tl + 8 * q4 + 4 * hh + j4; \
                                    float v = (s <= ll) ? cbt[k][rg] * __expf(al_[j4] - as) : 0.f; \
                                    if (s == ll) v += dterm_; \
                                    M_[ll * 136 + s] = (bf16)f2bf(v); } } } } } while (0)
#define SSD_LOAD_X(head_, xv_) do { _Pragma("unroll") for (int i = 0; i < 2; ++i) xv_[i] = *(const v4u*)(xact + (size_t)(tok0 + (tid & 127)) * 1024 + (head_) * 64 + 8 * ((tid >> 7) + 4 * i)); } while (0)
#define SSD_WRITE_X(head_, buf_, xv_) do { LAS bf16* X_ = XTb[buf_]; const int ll = tid & 127; const float sc = dt_s[(head_) * 128 + ll]; \
                    _Pragma("unroll") for (int i = 0; i < 2; ++i) { const int cg = (tid >> 7) + 4 * i; float o[8]; unpack8(xv_[i], o); \
                        _Pragma("unroll") for (int q = 0; q < 8; ++q) X_[(8 * cg + q) * 136 + ll] = (bf16)f2bf(o[q] * sc); } } while (0)
                for (int repb_ = 0; repb_ < ((REPEAT_MASK >> 16) & 1) + 1; ++repb_) {
                const bool lastb_ = repb_ == ((REPEAT_MASK >> 16) & 1);
                { v4u xv[2]; SSD_LOAD_X(g * 4, xv); SSD_WRITE_M(g * 4, 0); SSD_WRITE_X(g * 4, 0, xv); }
                FULL_SYNC();
                const int ll = 32 * tl + r;
                bf16x8 spn[8]; v2u zn[4];
#define SSD_PREFETCH(head_) do { _Pragma("unroll") for (int ks = 0; ks < 8; ++ks) spn[ks] = *(const bf16x8*)(spg + (size_t)(head_) * 8192 + (32 * tp + r) * 128 + 16 * ks + 8 * hh); \
                    const v2u* zp_ = (const v2u*)(proj + (size_t)(tok0 + ll) * PROJ_LD + COL_Z + (head_) * 64 + 32 * tp + 4 * hh); zn[0] = zp_[0]; zn[1] = zp_[2]; zn[2] = zp_[4]; zn[3] = zp_[6]; } while (0)
                SSD_PREFETCH(g * 4);
#pragma unroll 1
                for (int hl = 0; hl < 4; ++hl) { const int head = g * 4 + hl, cur = hl & 1;
                    bf16x8 spf[8]; v2u zz[4];
#pragma unroll
                    for (int ks = 0; ks < 8; ++ks) spf[ks] = spn[ks];
#pragma unroll
                    for (int q = 0; q < 4; ++q) zz[q] = zn[q];
                    v4u xv[2]; if (hl < 3) { SSD_LOAD_X(head + 1, xv); SSD_PREFETCH(head + 1); }
                    f32x16 yd = zero16(), yo = zero16();
                    mma_tile_n(yd, XTb[cur] + (32 * tp + r) * 136 + 8 * hh, Mb[cur] + (32 * tl + r) * 136 + 8 * hh, 2 * (tl + 1));
                    { LAS const bf16* cp = Cs + (32 * tl + r) * 136 + 8 * hh;
#pragma unroll
                      for (int ks = 0; ks < 8; ++ks) yo = MFMA32(spf[ks], ldsv8(cp + 16 * ks), yo); }
                    MFMA_SETTLE();
                    const float ea = __expf(acum_s[head * 128 + ll]);
#pragma unroll
                    for (int g4 = 0; g4 < 4; ++g4) { const int p0 = 32 * tp + 8 * g4 + 4 * hh;
                        const float y0 = (yd[4 * g4 + 0] + ea * yo[4 * g4 + 0]) * siluf_(bflo(zz[g4].x)), y1 = (yd[4 * g4 + 1] + ea * yo[4 * g4 + 1]) * siluf_(bfhi(zz[g4].x)),
                                    y2 = (yd[4 * g4 + 2] + ea * yo[4 * g4 + 2]) * siluf_(bflo(zz[g4].y)), y3 = (yd[4 * g4 + 3] + ea * yo[4 * g4 + 3]) * siluf_(bfhi(zz[g4].y));
                        if (lastb_) ssq += y0 * y0 + y1 * y1 + y2 * y2 + y3 * y3;
                        v2u ov; ov.x = pk2(y0, y1); ov.y = pk2(y2, y3);
                        *(v2u*)(cat + (size_t)(tok0 + ll) * DM + 256 + head * 64 + p0) = ov; }
                    if (hl < 3) { SSD_WRITE_M(head + 1, cur ^ 1); SSD_WRITE_X(head + 1, cur ^ 1, xv); }
                    FULL_SYNC();
                }
                }
#undef SSD_WRITE_M
#undef SSD_LOAD_X
#undef SSD_WRITE_X
#undef SSD_PREFETCH
            }
            ssq += __shfl_xor(ssq, 32);
            if (hh == 0) exch[w * 32 + r] = ssq;
            VM_WAIT();
            FULL_SYNC();
            if (w < 4 && hh == 0) rstd_s[32 * w + r] = rsqrtf((exch[w * 32 + r] + exch[(w + 4) * 32 + r]) * (1.f / 512.f) + EPS);
            FULL_SYNC();
            const float* ng = args.in[I_SSD_NORM_G] + l * 512;
            { v4u nv[16];
#pragma unroll
              for (int i = 0; i < 16; ++i) { const int v = tid + 512 * i, ll_ = v >> 6, c8 = (v & 63) * 8; nv[i] = *(const v4u*)(cat + (size_t)(tok0 + ll_) * DM + 256 + c8); }
              const int c8 = (tid & 63) * 8; const f32x4 g0 = *(const f32x4*)(ng + c8), g1 = *(const f32x4*)(ng + c8 + 4);
#pragma unroll
              for (int i = 0; i < 16; ++i) { const int v = tid + 512 * i, ll_ = v >> 6; float f[8]; unpack8(nv[i], f); const float rs = rstd_s[ll_];
                f[0] *= rs * g0.x; f[1] *= rs * g0.y; f[2] *= rs * g0.z; f[3] *= rs * g0.w; f[4] *= rs * g1.x; f[5] *= rs * g1.y; f[6] *= rs * g1.z; f[7] *= rs * g1.w;
                *(v4u*)(cat + (size_t)(tok0 + ll_) * DM + 256 + c8) = pack8(f); } }
            FULL_SYNC();
        }
    }
}
__device__ __forceinline__ void mixer_out_s5(const Ctx& F, const Args& args, int l) {
    const int tid = fresh_tid(), lane = tid & 63, w = __builtin_amdgcn_readfirstlane(tid >> 6), r = lane & 31, hh = lane >> 5;
    const bf16* proj = (const bf16*)(F.ws + WS_PROJ);
    bf16* cat = (bf16*)(F.ws + WS_CAT);
    LAS bf16* L16 = (LAS bf16*)F.lds;
    for (int unit = F.bid; unit < NUNIT; unit += F.G) {
        const int c = unit & 31, b = unit >> 5, tok0 = unit * 128, pos0 = c * 128; (void)b; (void)pos0;
        {
            LAS unsigned char* slab = F.lds + w * 17152; LAS float* Bu = (LAS float*)slab; LAS unsigned char* xs = slab + 8448;
            const unsigned char* tab = F.ws + WS_S5TAB + (size_t)l * S5TAB_LAYER;
            float one = 1.f; asm volatile("" : "+v"(one));
            for (int rd = 0; rd < 2; ++rd) { const int g = w + 8 * rd;
                const f32x4 lam = ((const f32x4*)tab)[g * 64 + lane];
                bf16x8 bfr[4], cfr[8];
#pragma unroll
                for (int nt = 0; nt < 4; ++nt) bfr[nt] = *(const bf16x8*)((const bf16*)(tab + S5TAB_BBAR) + (size_t)(g * 128 + 32 * nt + r) * 16 + 8 * hh);
#pragma unroll
                for (int ks = 0; ks < 8; ++ks) cfr[ks] = *(const bf16x8*)((const bf16*)(tab + S5TAB_CT) + (size_t)(g * 32 + r) * 128 + 16 * ks + 8 * hh);
                const f32x2 x0 = ((const f32x2*)(F.ws + WS_S5ST))[(size_t)(unit * 16 + g) * 64 + lane];
                float xr = x0.x, xi = x0.y;
                for (int s = 0; s < 4; ++s) {
                    const bf16x8 af = *(const bf16x8*)(proj + (size_t)(tok0 + 32 * s + r) * PROJ_LD + COL_U + g * 16 + 8 * hh);
                    f32x16 acc[4];
#pragma unroll
                    for (int nt = 0; nt < 4; ++nt) acc[nt] = MFMA32(af, bfr[nt], zero16());
                    __builtin_amdgcn_sched_barrier(0); asm volatile("s_nop 15"); asm volatile("s_nop 15"); asm volatile("s_nop 15"); asm volatile("s_nop 15"); __builtin_amdgcn_sched_barrier(0);
#pragma unroll
                    for (int half = 0; half < 2; ++half) {
#pragma unroll
                        for (int nt = 0; nt < 4; ++nt)
#pragma unroll
                            for (int q = 0; q < 8; ++q) { const int rg = 8 * half + q; Bu[(crow(rg, hh) - 16 * half) * 132 + 32 * nt + r] = acc[nt][rg] * one; }
                        LDS_WAIT();
#pragma unroll 8
                        for (int t = 0; t < 16; ++t) { const float br = Bu[t * 132 + lane], bi = Bu[t * 132 + 64 + lane];
                            const float nr = lam.x * xr - lam.y * xi + br, ni = lam.x * xi + lam.y * xr + bi; xr = nr; xi = ni;
                            LAS bf16* xrow = (LAS bf16*)(xs + (16 * half + t) * 272); xrow[lane] = (bf16)f2bf(xr); xrow[64 + lane] = (bf16)f2bf(xi); }
                        LDS_WAIT();
                    }
                    f32x16 y = zero16();
#pragma unroll
                    for (int ks = 0; ks < 8; ++ks) y = MFMA32(cfr[ks], *(LAS const bf16x8*)(xs + r * 272 + (16 * ks + 8 * hh) * 2), y);
                    MFMA_SETTLE();
                    { const int tok = tok0 + 32 * s + r; const bf16* urow = proj + (size_t)tok * PROJ_LD + COL_U + g * 16; const float* Dg = args.in[I_S5_D] + l * 256 + g * 16;
#pragma unroll
                      for (int q = 0; q < 2; ++q) { const int c0 = 8 * q + 4 * hh; const v2u uv = *(const v2u*)(urow + c0); const f32x4 dd = *(const f32x4*)(Dg + c0);
                          const float o0 = gelu_tanh(y[4 * q + 0] + dd.x * bflo(uv.x)), o1 = gelu_tanh(y[4 * q + 1] + dd.y * bfhi(uv.x)), o2 = gelu_tanh(y[4 * q + 2] + dd.z * bflo(uv.y)), o3 = gelu_tanh(y[4 * q + 3] + dd.w * bfhi(uv.y));
                          v2u ov; ov.x = pk2(o0, o1); ov.y = pk2(o2, o3);
                          *(v2u*)(cat + (size_t)tok * DM + 768 + g * 16 + c0) = ov; } }
                    LDS_WAIT();
                }
            }
            VM_WAIT();
            FULL_SYNC();
            LAS bf16* Gs = L16;
#pragma unroll
            for (int i = 0; i < 8; ++i) { const int v = tid + 512 * i, t = v >> 5, c8 = (v & 31) * 8; *(LAS v4u*)(Gs + t * 264 + c8) = *(const v4u*)(cat + (size_t)(tok0 + t) * DM + 768 + c8); }
            FULL_SYNC();
            const bf16* wg = (const bf16*)(F.ws + WS_WGLU) + (size_t)l * 65536;
            f32x16 acc[4];
#pragma unroll
            for (int tt = 0; tt < 4; ++tt) acc[tt] = zero16();
#pragma unroll 4
            for (int ks = 0; ks < 16; ++ks) { const bf16x8 bf = *(const bf16x8*)(wg + (size_t)(32 * w + r) * 256 + 16 * ks + 8 * hh);
#pragma unroll
                for (int tt = 0; tt < 4; ++tt) acc[tt] = MFMA32(bf, ldsv8(Gs + (32 * tt + r) * 264 + 16 * ks + 8 * hh), acc[tt]); }
            MFMA_SETTLE();
            const float* bgl = args.in[I_S5_BGLU] + l * 256;
#pragma unroll
            for (int g4 = 0; g4 < 4; ++g4) { const int j0 = 32 * w + 8 * g4 + 4 * hh; const f32x4 bj = *(const f32x4*)(bgl + j0);
#pragma unroll
                for (int tt = 0; tt < 4; ++tt) { const int t = 32 * tt + r; const v2u gv = *(LAS const v2u*)(Gs + t * 264 + j0);
                    const float o0 = bflo(gv.x) * sigmoidf_(acc[tt][4 * g4 + 0] + bj.x), o1 = bfhi(gv.x) * sigmoidf_(acc[tt][4 * g4 + 1] + bj.y),
                                o2 = bflo(gv.y) * sigmoidf_(acc[tt][4 * g4 + 2] + bj.z), o3 = bfhi(gv.y) * sigmoidf_(acc[tt][4 * g4 + 3] + bj.w);
                    v2u ov; ov.x = pk2(o0, o1); ov.y = pk2(o2, o3);
                    *(v2u*)(cat + (size_t)(tok0 + t) * DM + 768 + j0) = ov; } }
            FULL_SYNC();
        }
    }
}
__device__ __forceinline__ void mixer_outputs(const Ctx& F, const Args& args, int l) {
    for (int rep_ = 0; rep_ < ((REPEAT_MASK >> 8) & 1) + 1; ++rep_) mixer_out_ret(F, args, l);
    for (int rep_ = 0; rep_ < ((REPEAT_MASK >> 9) & 1) + 1; ++rep_) mixer_out_ssd(F, args, l);
    for (int rep_ = 0; rep_ < ((REPEAT_MASK >> 10) & 1) + 1; ++rep_) mixer_out_s5(F, args, l);
}


struct KvOrder {
    const char* ws; int G, c;
    __device__ __forceinline__ bool next(int i, Unit& u) const {
        const int L = i * G + c; if (L >= 128) return false;
        const int layer = L >> 6, rem = L & 63, kind = rem >> 5, idx = rem & 31;
        if (kind == 0) { u.pm = idx >> 2; u.pn = idx & 3; } else { u.pm = idx >> 3; u.pn = idx & 7; }
        u.z = layer * 2 + kind; return true;
    }
    __device__ __forceinline__ const char* a_base(const Unit& u) const { return (u.z & 1) ? ws + WS_WV + ((size_t)(u.z >> 1) * DM + u.pm * 256) * DM * 2 : ws + WS_MN + (size_t)u.pm * 256 * DM * 2; }
    __device__ __forceinline__ const char* b_base(const Unit& u) const { return (u.z & 1) ? ws + WS_MN + (size_t)u.pn * 256 * DM * 2 : ws + WS_WK + ((size_t)(u.z >> 1) * DM + u.pn * 256) * DM * 2; }
    __device__ __forceinline__ void a_voff(int, const Unit&, int K_, unsigned (&voffA)[2][2], int tid) const { pg8::dense_voff(K_, voffA, tid); }
    static constexpr int A_AUX = 0; static constexpr bool PUBLISH = false, POLL = false;
};
struct EpiKV {
    unsigned char* ws;
    __device__ __forceinline__ void operator()(const f32x4 (&acc)[2][2][4][2], const Unit& u, int wr, int wc, int fr, int fq) const {
        const int layer = u.z >> 1; const bool isv = u.z & 1;
        bf16* O = isv ? (bf16*)(ws + WS_VT) + (size_t)layer * DM * TM : (bf16*)(ws + WS_KB) + (size_t)layer * TM * DM; const int ldc = isv ? TM : DM;
        const int row0 = u.pm * 256 + wr * 64 + fr, col0 = u.pn * 256 + wc * 32 + 8 * fq;
#pragma unroll
        for (int ai = 0; ai < 2; ++ai)
#pragma unroll
            for (int m = 0; m < 4; ++m) { bf16* rowp = O + (size_t)(row0 + ai * 128 + m * 16) * ldc + col0;
#pragma unroll
                for (int bj = 0; bj < 2; ++bj) { const f32x4 v0 = acc[ai][bj][m][0], v1 = acc[ai][bj][m][1];
                    v4u w; w.x = cvt_pk_bf16(v0[0], v0[1]); w.y = cvt_pk_bf16(v0[2], v0[3]); w.z = cvt_pk_bf16(v1[0], v1[1]); w.w = cvt_pk_bf16(v1[2], v1[3]);
                    *(v4u*)(rowp + bj * 128) = w; } }
    }
};

__device__ __forceinline__ void attn_phase(const Ctx& F, int l, const pg8::DenseOrder& QS) {
    const int tid = fresh_tid(), lane = tid & 63, w = __builtin_amdgcn_readfirstlane(tid >> 6), r = lane & 31, hh = lane >> 5;
    const bf16* Q = (const bf16*)(F.ws + WS_Q); bf16* O = (bf16*)(F.ws + WS_CAT);
    const bf16* KB = (const bf16*)(F.ws + WS_KB) + (size_t)l * TM * DM; const bf16* VTg = (const bf16*)(F.ws + WS_VT) + (size_t)l * DM * TM;
    LAS bf16* L16 = (LAS bf16*)F.lds;
    constexpr int HALF_EL = 33792;
    for (int ui = 0;; ++ui) {
        Unit uq; if (!QS.next(ui, uq)) break;
        const int b = uq.pm >> 4, qt = uq.pm & 15, h = uq.pn;
        const int q0 = b * SEQ + qt * 256 + 32 * w;
#pragma unroll 4
        for (int i = 0; i < 16; ++i) { const int v = tid + 512 * i, key = v >> 5, d8 = (v & 31) * 8;
            *(LAS v4u*)(L16 + (key >> 7) * HALF_EL + (key & 127) * 264 + d8) = *(const v4u*)(KB + (size_t)(b * MEMLEN + key) * DM + h * 256 + d8); }
        FULL_SYNC();
        f32x16 S[8];
#pragma unroll
        for (int kt = 0; kt < 8; ++kt) S[kt] = zero16();
        {
            const bf16* qp = Q + (size_t)(q0 + r) * DM + h * 256 + 8 * hh;
            LAS const bf16* kp0 = L16 + r * 264 + 8 * hh;
#pragma unroll 2
            for (int ks = 0; ks < 16; ++ks) {
                const bf16x8 qf = *(const bf16x8*)(qp + 16 * ks);
#pragma unroll
                for (int kt = 0; kt < 8; ++kt) S[kt] = MFMA32(ldsv8(kp0 + (kt >> 2) * HALF_EL + 32 * (kt & 3) * 264 + 16 * ks), qf, S[kt]);
            }
        }
        FULL_SYNC();
#pragma unroll 4
        for (int i = 0; i < 16; ++i) { const int v = tid + 512 * i, d = v >> 5, k8 = (v & 31) * 8;
            const v4u vv = *(const v4u*)(VTg + (size_t)(h * 256 + d) * TM + b * MEMLEN + k8);
            LAS v2u* dst = (LAS v2u*)(L16 + (k8 >> 7) * HALF_EL + d * 132 + (k8 & 127));
            dst[0] = (v2u){vv.x, vv.y}; dst[1] = (v2u){vv.z, vv.w}; }
        float mx = -1e30f;
#pragma unroll
        for (int kt = 0; kt < 8; ++kt)
#pragma unroll
            for (int rg = 0; rg < 16; ++rg) mx = fmaxf(mx, S[kt][rg]);
        mx = fmaxf(mx, __shfl_xor(mx, 32));
        float sum = 0.f;
        bf16x8 pf[8][2];
#pragma unroll
        for (int kt = 0; kt < 8; ++kt) {
#pragma unroll
            for (int rg = 0; rg < 16; ++rg) { S[kt][rg] = __builtin_amdgcn_exp2f(S[kt][rg] - mx); sum += S[kt][rg]; }
#pragma unroll
            for (int s = 0; s < 2; ++s) { v4u pw; pw.x = pk2(S[kt][8 * s + 0], S[kt][8 * s + 1]); pw.y = pk2(S[kt][8 * s + 2], S[kt][8 * s + 3]); pw.z = pk2(S[kt][8 * s + 4], S[kt][8 * s + 5]); pw.w = pk2(S[kt][8 * s + 6], S[kt][8 * s + 7]);
                pf[kt][s] = __builtin_bit_cast(bf16x8, pw); } }
        sum += __shfl_xor(sum, 32);
        const float inv = 1.f / sum;
        FULL_SYNC();
#pragma unroll 1
        for (int dt = 0; dt < 8; ++dt) {
            f32x16 o = zero16();
#pragma unroll
            for (int kt = 0; kt < 8; ++kt)
#pragma unroll
                for (int s = 0; s < 2; ++s) {
                    LAS const bf16* vp = L16 + (kt >> 2) * HALF_EL + (32 * dt + r) * 132 + 32 * (kt & 3) + 16 * s + 4 * hh;
                    const v2u lo = *(LAS const v2u*)vp, hi = *(LAS const v2u*)(vp + 8);
                    const v4u av = {lo.x, lo.y, hi.x, hi.y};
                    o = MFMA32(__builtin_bit_cast(bf16x8, av), pf[kt][s], o); }
            MFMA_SETTLE();
#pragma unroll
            for (int g4 = 0; g4 < 4; ++g4) { v2u ov; ov.x = pk2(o[4 * g4 + 0] * inv, o[4 * g4 + 1] * inv); ov.y = pk2(o[4 * g4 + 2] * inv, o[4 * g4 + 3] * inv);
                *(v2u*)(O + (size_t)(q0 + r) * DM + h * 256 + 32 * dt + 8 * g4 + 4 * hh) = ov; }
        }
        FULL_SYNC();
    }
}

typedef float f32x4v __attribute__((ext_vector_type(4)));
__device__ __forceinline__ void split_hi_lo(const f32x4 a, const f32x4 b, bf16x8& hi, bf16x8& lo) {
    const float f[8] = {a.x, a.y, a.z, a.w, b.x, b.y, b.z, b.w}; unsigned h[8], lw[8];
#pragma unroll
    for (int q = 0; q < 8; ++q) { h[q] = f2bf(f[q]); lw[q] = f2bf(f[q] - bf2f(h[q])); }
    v4u H = {h[0] | (h[1] << 16), h[2] | (h[3] << 16), h[4] | (h[5] << 16), h[6] | (h[7] << 16)}, Lw = {lw[0] | (lw[1] << 16), lw[2] | (lw[3] << 16), lw[4] | (lw[5] << 16), lw[6] | (lw[7] << 16)};
    hi = __builtin_bit_cast(bf16x8, H); lo = __builtin_bit_cast(bf16x8, Lw);
}
__device__ __forceinline__ void route_phase(const Ctx& F, const Args& args, int l, unsigned* ctl) {
#ifndef SPLIT_CONV
    for (int rep_ = 0; rep_ < ((REPEAT_MASK >> 6) & 1) + 1; ++rep_) convert_moe_weights(F, args, l);
#endif
    FULL_SYNC();
    const int tid = fresh_tid(), lane = tid & 63, w = __builtin_amdgcn_readfirstlane(tid >> 6), c16 = lane & 15, q = lane >> 4;
    LAS unsigned* lcnt = (LAS unsigned*)F.lds; LAS unsigned* lbase = lcnt + 32;
    const bf16* hbp = (const bf16*)(F.ws + WS_HB);
    const bf16* wr = (const bf16*)(F.ws + WS_WR) + (size_t)l * 2 * 48 * DM;
    const float* ssq = (const float*)(F.ws + WS_SSQ2) + (size_t)l * T * 16;
    unsigned* cnt = ctl + CW_CNT + 64 * l;
    unsigned* tok_list = (unsigned*)(F.ws + WS_TOKLIST); float* slot_w = (float*)(F.ws + WS_SLOTW); float* slot_r = (float*)(F.ws + WS_SLOTR); unsigned* tok_slot = (unsigned*)(F.ws + WS_TOKSLOT);
    LAS unsigned char* wl = F.lds + 1024;
    for (int i = tid; i < 48 * 128; i += NTHREADS) { const int row = i >> 7, c = i & 127; *(LAS v4u*)(wl + row * 2064 + c * 16) = *(const v4u*)(wr + (size_t)row * DM + c * 8); }
    for (int tile0 = F.bid * 8; tile0 < T / 16; tile0 += F.G * 8) {
        if (tid < 32) lcnt[tid] = 0u;
        FULL_SYNC();
        const int tok = (tile0 + w) * 16 + c16;
        f32x4 acc[3];
#pragma unroll
        for (int mt = 0; mt < 3; ++mt) acc[mt] = (f32x4){0.f, 0.f, 0.f, 0.f};
        const bf16* hp = hbp + (size_t)tok * DM + 8 * q;
        bf16x8 bh[32];
#pragma unroll
        for (int ks = 0; ks < 32; ++ks) bh[ks] = *(const bf16x8*)(hp + 32 * ks);
#pragma unroll
        for (int ks = 0; ks < 32; ++ks) {
#pragma unroll
            for (int mt = 0; mt < 3; ++mt) { const bf16x8 ah = *(LAS const bf16x8*)(wl + (16 * mt + c16) * 2064 + 64 * ks + 16 * q);
                acc[mt] = __builtin_amdgcn_mfma_f32_16x16x32_bf16(ah, bh[ks], acc[mt], 0, 0, 0); } }
        MFMA_SETTLE();
        const float rs = rsqrtf(ssq16(ssq + (size_t)tok * 16) * (1.f / DM) + EPS);
        float gl[4];
#pragma unroll
        for (int i = 0; i < 4; ++i) gl[i] = acc[2][i] * rs + args.in[I_B_RG][l * 4 + i];
        int gsel = 0; float gm = gl[0];
#pragma unroll
        for (int i = 1; i < 4; ++i) if (gl[i] > gm) { gm = gl[i]; gsel = i; }
        float gs = 0.f;
#pragma unroll
        for (int i = 0; i < 4; ++i) gs += __expf(gl[i] - gm);
        const float pg = 1.f / gs;
        const bool own = (q == gsel);
        unsigned e1 = 0, e2 = 0, lp1 = 0, lp2 = 0; float g1 = 0.f, g2 = 0.f;
        if (own) {
            float el[8];
#pragma unroll
            for (int i = 0; i < 8; ++i) el[i] = acc[i >> 2][i & 3] * rs + args.in[I_B_RE][l * 32 + q * 8 + i];
            int i1 = 0; float m1 = el[0];
#pragma unroll
            for (int i = 1; i < 8; ++i) if (el[i] > m1) { m1 = el[i]; i1 = i; }
            int i2 = -1; float m2 = -3e38f;
#pragma unroll
            for (int i = 0; i < 8; ++i) if (i != i1 && el[i] > m2) { m2 = el[i]; i2 = i; }
            const float p1 = 1.f / (1.f + __expf(m2 - m1));
            g1 = pg * p1; g2 = pg * (1.f - p1);
            e1 = (unsigned)(q * 8 + i1); e2 = (unsigned)(q * 8 + i2);
            lp1 = __hip_atomic_fetch_add(lcnt + e1, 1u, __ATOMIC_RELAXED, __HIP_MEMORY_SCOPE_WORKGROUP); lp2 = __hip_atomic_fetch_add(lcnt + e2, 1u, __ATOMIC_RELAXED, __HIP_MEMORY_SCOPE_WORKGROUP);
        }
        FULL_SYNC();
        if (tid < 32) lbase[tid] = atomicAdd(cnt + tid, lcnt[tid]);
        FULL_SYNC();
        if (own) {
            const unsigned p1 = lbase[e1] + lp1, p2 = lbase[e2] + lp2;
            tok_list[(size_t)e1 * T + p1] = (unsigned)tok; slot_w[(size_t)e1 * T + p1] = g1; slot_r[(size_t)e1 * T + p1] = rs;
            tok_list[(size_t)e2 * T + p2] = (unsigned)tok; slot_w[(size_t)e2 * T + p2] = g2; slot_r[(size_t)e2 * T + p2] = rs;
            tok_slot[(size_t)tok * 2] = (e1 << 20) | p1; tok_slot[(size_t)tok * 2 + 1] = (e2 << 20) | p2;
        }
        FULL_SYNC();
    }
}

struct MoeMap { LAS unsigned* rowtok; LAS int* ntiles; LAS int* first; LAS int* cnts; LAS unsigned char* te; };
__device__ __forceinline__ MoeMap moe_map_ptrs(const Ctx& F) {
    MoeMap m; m.rowtok = (LAS unsigned*)(F.lds + MOE_LDS); LAS int* base = (LAS int*)(F.lds + MOE_LDS + 8192);
    m.ntiles = base; m.first = base + 1; m.cnts = base + 34; m.te = (LAS unsigned char*)(base + 66); return m;
}
__device__ __forceinline__ void moe_map_build(const Ctx& F, const MoeMap& m, unsigned* cnt) {
    const int tid = fresh_tid();
    if (tid < 32) m.cnts[tid] = (int)xb_ld(cnt + tid);
    FULL_SYNC();
    if (tid == 0) { int a = 0; for (int e = 0; e < 32; ++e) { m.first[e] = a; a += (m.cnts[e] + 255) >> 8; } m.first[32] = a; *m.ntiles = a; }
    FULL_SYNC();
    if (tid < 32) { for (int t = m.first[tid]; t < m.first[tid + 1]; ++t) m.te[t] = (unsigned char)tid; }
    FULL_SYNC();
}
struct MoeGU {
    const char* hb; const char* wgu; MoeMap m; int G, c; unsigned* cnt;
    static constexpr int A_AUX = 0; static constexpr bool PUBLISH = true, POLL = false;
    __device__ __forceinline__ void publish(int pm) const { if ((threadIdx.x & 63) == 0) (void)xb_add(cnt + 64 * pm, 1u); }
    __device__ __forceinline__ void done_last(int pm) const { asm volatile("s_waitcnt vmcnt(0)" ::: "memory"); publish(pm); }
    __device__ __forceinline__ bool next(int i, Unit& u) const { const int L = i * G + c; if (L >= *m.ntiles * 4) return false; u.pm = L >> 2; u.pn = L & 3; u.z = m.te[u.pm]; return true; }
    __device__ __forceinline__ const char* a_base(const Unit&) const { return hb; }
    __device__ __forceinline__ const char* b_base(const Unit& u) const { return wgu + ((size_t)u.z * 1024 + u.pn * 256) * DM * 2; }
    __device__ __forceinline__ void a_voff(int i, const Unit&, int K_, unsigned (&voffA)[2][2], int tid) const {
#pragma unroll
        for (int j = 0; j < 2; ++j) { int R, C; pg8::stage_rc(tid * 16 + j * 8192, R, C);
            voffA[0][j] = (m.rowtok[i * 256 + R] * (unsigned)K_ + (unsigned)C) * 2u; voffA[1][j] = (m.rowtok[i * 256 + 128 + R] * (unsigned)K_ + (unsigned)C) * 2u; }
    }
};
struct MoeDown {
    const char* hmid; const char* wd; MoeMap m; int G, c; unsigned* cnt; unsigned* tmo;
    static constexpr bool PUBLISH = false, POLL = true; static constexpr int A_AUX = 16;
    __device__ __forceinline__ bool next(int i, Unit& u) const {
        const int nU = *m.ntiles * 4, r = nU % G, idle = G - r; int L;
        if (c >= r) L = i < 2 ? (c - r) + i * idle : 2 * idle + c + (i - 2) * G; else L = 2 * idle + c + i * G;
        if (L >= nU) return false; u.pm = L >> 2; u.pn = L & 3; u.z = m.te[u.pm]; return true; }
    __device__ __forceinline__ unsigned poll(const Unit& u) const { return threadIdx.x < 64 ? xb_ld(cnt + 64 * u.pm) : 0u; }
    __device__ __forceinline__ void a_ready(const Unit& u, unsigned pv) const {
        if (threadIdx.x < 64) { unsigned sp = 0;
            if ((unsigned)__builtin_amdgcn_readfirstlane(pv) < 32u)
            while ((unsigned)__builtin_amdgcn_readfirstlane(xb_ld(cnt + 64 * u.pm)) < 32u) { __builtin_amdgcn_s_sleep(1);
                if ((++sp & 255u) == 0u) { if (xb_ld(tmo)) break; if (sp > XB_SPIN_CAP) { if (threadIdx.x == 0) atomicAdd(tmo, 1u); break; } } } }
        asm volatile("" ::: "memory"); __builtin_amdgcn_s_barrier(); asm volatile("" ::: "memory");
    }
    __device__ __forceinline__ const char* a_base(const Unit& u) const { return hmid + (size_t)u.pm * 256 * DEXP * 2; }
    __device__ __forceinline__ const char* b_base(const Unit& u) const { return wd + ((size_t)u.z * 1024 + u.pn * 256) * DEXP * 2; }
    __device__ __forceinline__ void a_voff(int, const Unit&, int K_, unsigned (&voffA)[2][2], int tid) const { pg8::dense_voff(K_, voffA, tid); }
};
struct EpiGateUp {
    bf16* hmid; const float* slot_r; MoeMap m;
    __device__ __forceinline__ void operator()(const f32x4 (&acc)[2][2][4][2], const Unit& u, int wr, int wc, int fr, int fq) const {
        const int e = u.z, lrow0 = (u.pm - m.first[e]) * 256 + wr * 64 + fr, col0 = u.pn * 128 + wc * 32 + 8 * fq;
#pragma unroll
        for (int ai = 0; ai < 2; ++ai)
#pragma unroll
            for (int mm = 0; mm < 4; ++mm) { const int lr = lrow0 + ai * 128 + mm * 16; const float rs = slot_r[(size_t)e * T + lr];
                const f32x4 g0 = acc[ai][0][mm][0] * rs, g1 = acc[ai][0][mm][1] * rs, u0 = acc[ai][1][mm][0] * rs, u1 = acc[ai][1][mm][1] * rs;
                v4u w; w.x = cvt_pk_bf16(siluf_(g0[0]) * u0[0], siluf_(g0[1]) * u0[1]); w.y = cvt_pk_bf16(siluf_(g0[2]) * u0[2], siluf_(g0[3]) * u0[3]);
                w.z = cvt_pk_bf16(siluf_(g1[0]) * u1[0], siluf_(g1[1]) * u1[1]); w.w = cvt_pk_bf16(siluf_(g1[2]) * u1[2], siluf_(g1[3]) * u1[3]);
                { bf16* p_ = hmid + (size_t)(m.first[e] * 256 + lr) * DEXP + col0; asm volatile("global_store_dwordx4 %0, %1, off sc1\n\ts_nop 1" :: "v"(p_), "v"(w) : "memory"); } }
    }
};
struct EpiDown {
    bf16* ybuf; const float* slot_w; MoeMap m;
    __device__ __forceinline__ void operator()(const f32x4 (&acc)[2][2][4][2], const Unit& u, int wr, int wc, int fr, int fq) const {
        const int e = u.z, lrow0 = (u.pm - m.first[e]) * 256 + wr * 64 + fr, col0 = u.pn * 256 + wc * 32 + 8 * fq;
#pragma unroll
        for (int ai = 0; ai < 2; ++ai)
#pragma unroll
            for (int mm = 0; mm < 4; ++mm) { const int lr = lrow0 + ai * 128 + mm * 16; const float s = slot_w[(size_t)e * T + lr];
                bf16* rowp = ybuf + (size_t)(m.first[e] * 256 + lr) * DM + col0;
#pragma unroll
                for (int bj = 0; bj < 2; ++bj) { const f32x4 v0 = acc[ai][bj][mm][0] * s, v1 = acc[ai][bj][mm][1] * s;
                    v4u w; w.x = cvt_pk_bf16(v0[0], v0[1]); w.y = cvt_pk_bf16(v0[2], v0[3]); w.z = cvt_pk_bf16(v1[0], v1[1]); w.w = cvt_pk_bf16(v1[2], v1[3]);
                    *(v4u*)(rowp + bj * 128) = w; } }
    }
};
__device__ __forceinline__ void combine_phase(const Ctx& F, const Args& args, int l, const MoeMap& m) {
    const int tid = fresh_tid(), lane = tid & 63, w = __builtin_amdgcn_readfirstlane(tid >> 6);
    const int gw = F.bid * NWAVES + w, NGW = F.G * NWAVES;
    const unsigned* tok_slot = (const unsigned*)(F.ws + WS_TOKSLOT); const bf16* ybuf = (const bf16*)(F.ws + WS_YBUF);
    bf16* hb = (bf16*)(F.ws + WS_HB); float* ssq0 = (float*)(F.ws + WS_SSQ0) + (size_t)(l + 1) * T;
    const float* gfin = args.in[I_NORM_FINAL_G];
    constexpr int NB = 4;
    unsigned sl_[NB][2];
#pragma unroll
    for (int k = 0; k < NB; ++k) { const int t_ = gw * NB + k < T ? gw * NB + k : 0; sl_[k][0] = tok_slot[(size_t)t_ * 2]; sl_[k][1] = tok_slot[(size_t)t_ * 2 + 1]; }
    for (int tok0 = gw * NB; tok0 < T; tok0 += NGW * NB) {
        size_t r0[NB], r1[NB];
#pragma unroll
        for (int k = 0; k < NB; ++k) { const unsigned s0 = sl_[k][0], s1 = sl_[k][1];
            r0[k] = (size_t)(m.first[s0 >> 20] * 256 + (int)(s0 & 0xFFFFFu)); r1[k] = (size_t)(m.first[s1 >> 20] * 256 + (int)(s1 & 0xFFFFFu)); }
#pragma unroll
        for (int k = 0; k < NB; ++k) { const int tn_ = tok0 + NGW * NB + k < T ? tok0 + NGW * NB + k : 0; sl_[k][0] = tok_slot[(size_t)tn_ * 2]; sl_[k][1] = tok_slot[(size_t)tn_ * 2 + 1]; }
        v4u hv[NB][2], ya[NB][2], yb[NB][2];
#pragma unroll
        for (int k = 0; k < NB; ++k)
#pragma unroll
            for (int j = 0; j < 2; ++j) { const int col = 8 * (lane + 64 * j);
                hv[k][j] = *(const v4u*)(hb + (size_t)(tok0 + k) * DM + col); ya[k][j] = __builtin_nontemporal_load((const v4u*)(ybuf + r0[k] * DM + col)); yb[k][j] = __builtin_nontemporal_load((const v4u*)(ybuf + r1[k] * DM + col)); }
#pragma unroll
        for (int k = 0; k < NB; ++k) { const int tok = tok0 + k;
            float v[16]; float ss = 0.f;
#pragma unroll
            for (int j = 0; j < 2; ++j) { float hh_[8], a[8], bb[8]; unpack8(hv[k][j], hh_); unpack8(ya[k][j], a); unpack8(yb[k][j], bb);
#pragma unroll
                for (int q = 0; q < 8; ++q) { v[8 * j + q] = hh_[q] + a[q] + bb[q]; ss += v[8 * j + q] * v[8 * j + q]; } }
            ss = wave_sum(ss);
            if (l == NL - 1) {
                const float rs = rsqrtf(ss * (1.f / DM) + EPS);
#pragma unroll
                for (int j = 0; j < 2; ++j) { const int col = 8 * (lane + 64 * j); const f32x4 g0 = *(const f32x4*)(gfin + col), g1 = *(const f32x4*)(gfin + col + 4);
                    __builtin_nontemporal_store((f32x4){v[8 * j] * rs * g0.x, v[8 * j + 1] * rs * g0.y, v[8 * j + 2] * rs * g0.z, v[8 * j + 3] * rs * g0.w}, (f32x4*)(args.out + (size_t)tok * DM + col));
                    __builtin_nontemporal_store((f32x4){v[8 * j + 4] * rs * g1.x, v[8 * j + 5] * rs * g1.y, v[8 * j + 6] * rs * g1.z, v[8 * j + 7] * rs * g1.w}, (f32x4*)(args.out + (size_t)tok * DM + col + 4)); }
            } else {
#pragma unroll
                for (int j = 0; j < 2; ++j) { const int col = 8 * (lane + 64 * j);
                    const float f[8] = {v[8 * j], v[8 * j + 1], v[8 * j + 2], v[8 * j + 3], v[8 * j + 4], v[8 * j + 5], v[8 * j + 6], v[8 * j + 7]};
                    *(v4u*)(hb + (size_t)tok * DM + col) = pack8(f); }
                if (lane == 0) ssq0[tok] = ss;
            }
        }
    }
}

__device__ __forceinline__ void final_norm_rows(const Ctx& F, const bf16* hb, const float* g, float* out) {
    const int gw = F.vcu * NWAVES + F.wave, NGW = F.G * NWAVES, lane = F.lane;
    for (int m = gw; m < T; m += NGW) {
        float v[16]; float s = 0.f;
#pragma unroll
        for (int j = 0; j < 2; ++j) { float f[8]; unpack8(*(const v4u*)(hb + (size_t)m * DM + 8 * (lane + 64 * j)), f);
#pragma unroll
            for (int q = 0; q < 8; ++q) { v[8 * j + q] = f[q]; s += f[q] * f[q]; } }
        const float rs = rsqrtf(wave_sum(s) * (1.f / DM) + EPS);
#pragma unroll
        for (int j = 0; j < 2; ++j) { const int col = 8 * (lane + 64 * j); const f32x4 g0 = *(const f32x4*)(g + col), g1 = *(const f32x4*)(g + col + 4);
            *(f32x4*)(out + (size_t)m * DM + col) = (f32x4){v[8 * j] * rs * g0.x, v[8 * j + 1] * rs * g0.y, v[8 * j + 2] * rs * g0.z, v[8 * j + 3] * rs * g0.w};
            *(f32x4*)(out + (size_t)m * DM + col + 4) = (f32x4){v[8 * j + 4] * rs * g1.x, v[8 * j + 5] * rs * g1.y, v[8 * j + 6] * rs * g1.z, v[8 * j + 7] * rs * g1.w}; }
    }
}

#if DEBUG_STAGE == 7
#define GRID_BAR() do { ++bar_epoch; if (threadIdx.x == 0) ((unsigned*)(F.ws + WS_HIST + 2 * MiB))[F.bid * 64] = bar_epoch; xcd_barrier(bar); \
    if (threadIdx.x < (unsigned)F.G) { const unsigned* sl = (const unsigned*)(F.ws + WS_HIST + 2 * MiB) + threadIdx.x * 64; const unsigned a = *sl; const unsigned b_ = __hip_atomic_load(sl, __ATOMIC_RELAXED, __HIP_MEMORY_SCOPE_SYSTEM); \
        if (a != bar_epoch) atomicAdd(ctl + CW_DIAG + 4, 1u); if (b_ != bar_epoch) atomicAdd(ctl + CW_DIAG + 5, 1u); } xcd_barrier(bar); } while (0)
#else
#define GRID_BAR() xcd_barrier(bar)
#endif
#if STOP_AFTER < 999
#define STAGE_END() do { GRID_BAR(); if (++nstage == STOP_AFTER) return true; } while (0)
#elif DEBUG_STAGE == 10
#define STAGE_END() do { GRID_BAR(); ++nstage; if (F.bid == 0 && threadIdx.x == 0) ((unsigned long long*)(ctl + 3000))[nstage] = __builtin_amdgcn_s_memrealtime(); } while (0)
#else
#define STAGE_END() GRID_BAR()
#endif
#ifdef SPLIT_CONV
#define STAGE_END_CONV(kind_, lo_, hi_) do { xcd_barrier_arrive(bar); convert_moe_weights(F, args, l, (kind_), (lo_), (hi_)); xcd_barrier_wait(bar); } while (0)
#else
#define STAGE_END_CONV(kind_, lo_, hi_) STAGE_END()
#endif
template <int LAYER>
__device__ __forceinline__ bool layer_body(Ctx& F, const Args& args, unsigned* ctl, const XcdBarrier& bar, int& nstage, unsigned& bar_epoch) {
    constexpr int l = LAYER;
        for (int rep_ = 0; rep_ < ((REPEAT_MASK >> 0) & 1) + 1; ++rep_) {
            pg8::DenseOrder S; S.init(F.ws + WS_HB, F.ws + WS_WIN + (size_t)l * 3072 * DM * 2, T, 3072, DM, F.G, F.bid);
            build_rstd_table(F, S, (const float*)(F.ws + WS_SSQ0) + (size_t)l * T, 1);
            EpiProj E{(bf16*)(F.ws + WS_PROJ), (float*)(F.ws + WS_DT), (const LAS float*)(F.lds + RSTD_LDS)};
            pg8::gemm_phase<EpiProj, pg8::DenseOrder, false>(F.lds, DM, S, E);
        }
        STAGE_END_CONV(1, 0, 1);
#if DEBUG_STAGE == 3
        dbg_checksum(F, ctl, l == 0 ? 1 : 11, F.ws + WS_PROJ, (size_t)T * PROJ_LD * 2); GRID_BAR();
#endif
#if DEBUG_STAGE == 8
        { unsigned nd = 0; const unsigned* pr = (const unsigned*)(F.ws + WS_PROJ);
          for (int unit = F.bid; unit < NUNIT; unit += F.G) { const size_t w0 = (size_t)unit * 128 * PROJ_LD / 2;
            for (size_t i = threadIdx.x; i < (size_t)128 * PROJ_LD / 2; i += NTHREADS) { const unsigned a = pr[w0 + i]; const unsigned b_ = __hip_atomic_load(pr + w0 + i, __ATOMIC_RELAXED, __HIP_MEMORY_SCOPE_SYSTEM); if (a != b_) ++nd; } }
          if (nd) atomicAdd(ctl + CW_DIAG + 6 + l, nd); }
#endif
        if ((REPEAT_MASK >> 13) & 1) {
            pg8::DenseOrder S; S.init(F.ws + WS_HB, F.ws + WS_WIN + (size_t)l * 3072 * DM * 2, T, PROBE_N, DM, F.G, F.bid);
            build_rstd_table(F, S, (const float*)(F.ws + WS_SSQ0) + (size_t)l * T, 1);
            EpiProj E{(bf16*)(F.ws + WS_PROJ), (float*)(F.ws + WS_DT), (const LAS float*)(F.lds + RSTD_LDS)};
            pg8::gemm_phase<EpiProj, pg8::DenseOrder, false>(F.lds, DM, S, E);
        }
        for (int rep_ = 0; rep_ < ((REPEAT_MASK >> 1) & 1) + 1; ++rep_) mixer_states(F, args, l);
        STAGE_END_CONV(1, 1, 2);
#if DEBUG_STAGE == 9
        if (l == 0) { unsigned bad = 0; for (int unit = F.bid; unit < NUNIT; unit += F.G) bad += s5_chunk_states(F, l, unit, true); __syncthreads(); if (bad) atomicAdd(ctl + CW_DIAG + 6, bad); GRID_BAR(); }
#endif
#if DEBUG_STAGE == 6
        {
            unsigned nd = 0;
            { const unsigned* cur = (const unsigned*)(F.ws + WS_S5ST);
              for (size_t i = (size_t)F.bid * NTHREADS + threadIdx.x; i < (2 * MiB) / 4; i += (size_t)F.G * NTHREADS) { const unsigned a = cur[i]; const unsigned b = __hip_atomic_load(cur + i, __ATOMIC_RELAXED, __HIP_MEMORY_SCOPE_SYSTEM); if (a != b) ++nd; } }
            if (nd) atomicAdd(ctl + CW_DIAG, nd);
        }
#endif
#if DEBUG_STAGE == 5
        if (l == 0) {
            unsigned nd = 0;
            { const unsigned* cur = (const unsigned*)(F.ws + WS_S5ST);
              for (size_t i = (size_t)F.bid * NTHREADS + threadIdx.x; i < (2 * MiB) / 4; i += (size_t)F.G * NTHREADS) { const unsigned a = cur[i]; const unsigned b = __hip_atomic_load(cur + i, __ATOMIC_RELAXED, __HIP_MEMORY_SCOPE_SYSTEM); if (a != b) ++nd; } }
            if (nd) atomicAdd(ctl + CW_DIAG, nd);
            return true;
        }
#endif
#if DEBUG_STAGE == 4
        if (l == 0) {
            return true;
        }
#endif
#if DEBUG_STAGE == 3
        if (l == 0) { dbg_checksum(F, ctl, 2, F.ws + WS_S5TAB, (size_t)512 * 1024); dbg_checksum(F, ctl, 3, F.ws + WS_RETST, (size_t)16 * MiB); dbg_checksum(F, ctl, 4, F.ws + WS_SSDST, (size_t)32 * MiB); dbg_checksum(F, ctl, 5, F.ws + WS_S5ST, (size_t)2 * MiB);
            { const unsigned* cur = (const unsigned*)(F.ws + WS_S5ST); unsigned* prev = (unsigned*)(F.ws + WS_HIST + MiB); const unsigned* hist = (const unsigned*)(F.ws + WS_HIST); const bool have = hist[0] == 0x5EEDC0DEu; unsigned nd = 0, ndw = 0;
              for (size_t i = (size_t)F.bid * NTHREADS + threadIdx.x; i < (2 * MiB) / 4; i += (size_t)F.G * NTHREADS) { const unsigned c = cur[i]; if (have && prev[i] != c) { ++nd; const float a = __uint_as_float(c), b = __uint_as_float(prev[i]); if (fabsf(a - b) > 1e-3f * (fabsf(a) + fabsf(b)) + 1e-5f) ++ndw; } prev[i] = c; }
              if (nd) atomicAdd(ctl + CW_DIAG + 2, nd); if (ndw) atomicAdd(ctl + CW_DIAG + 3, ndw); } } GRID_BAR();
#endif
        mixer_scan(F, args, l);
        STAGE_END_CONV(1, 2, 3);
        for (int rep_ = 0; rep_ < ((REPEAT_MASK >> 11) & 1) * 8; ++rep_) GRID_BAR();
#if DEBUG_STAGE == 3
        if (l == 0) { dbg_checksum(F, ctl, 6, F.ws + WS_SSDST, (size_t)32 * MiB); dbg_checksum(F, ctl, 7, F.ws + WS_S5ST, (size_t)2 * MiB); } GRID_BAR();
#endif
        for (int rep_ = 0; rep_ < ((REPEAT_MASK >> 2) & 1) + 1; ++rep_) mixer_outputs(F, args, l);
        STAGE_END_CONV(1, 3, 1 << 30);
#if DEBUG_STAGE == 3
        if (l == 0) { dbg_checksum_cols(F, ctl, 8, F.ws + WS_CAT, 0, 256); dbg_checksum_cols(F, ctl, 9, F.ws + WS_CAT, 256, 768); dbg_checksum_cols(F, ctl, 10, F.ws + WS_CAT, 768, 1024); } GRID_BAR();
#endif
        {
            pg8::DenseOrder S; S.init(F.ws + WS_CAT, F.ws + WS_WOUT + (size_t)l * DM * DM * 2, T, DM, DM, F.G, F.bid);
            EpiResid E{(bf16*)(F.ws + WS_HB), (float*)(F.ws + WS_SSQ1) + (size_t)l * T * 16};
            pg8::gemm_phase<EpiResid, pg8::DenseOrder, false>(F.lds, DM, S, E);
        }
        STAGE_END_CONV(0, 0, 2);
#if DEBUG_STAGE == 3
        dbg_checksum(F, ctl, 10 * l + 13, args.out, (size_t)T * DM * 4); GRID_BAR();
#endif
        {
            pg8::DenseOrder S; S.init(F.ws + WS_HB, F.ws + WS_WQ + (size_t)l * DM * DM * 2, T, DM, DM, F.G, F.bid);
            build_rstd_table(F, S, (const float*)(F.ws + WS_SSQ1) + (size_t)l * T * 16, 16);
            EpiBf16Scaled E{(bf16*)(F.ws + WS_Q), DM, (const LAS float*)(F.lds + RSTD_LDS), 0.0625f * 1.44269504f};
            pg8::gemm_phase<EpiBf16Scaled, pg8::DenseOrder, false>(F.lds, DM, S, E);
            VM_WAIT(); __syncthreads();
            for (int rep_ = 0; rep_ < ((REPEAT_MASK >> 12) & 1) + 1; ++rep_) attn_phase(F, l, S);
        }
        STAGE_END_CONV(0, 2, 5);
        {
            pg8::DenseOrder S; S.init(F.ws + WS_CAT, F.ws + WS_WO + (size_t)l * DM * DM * 2, T, DM, DM, F.G, F.bid);
            EpiResid E{(bf16*)(F.ws + WS_HB), (float*)(F.ws + WS_SSQ2) + (size_t)l * T * 16};
            pg8::gemm_phase<EpiResid, pg8::DenseOrder, false>(F.lds, DM, S, E);
        }
        STAGE_END_CONV(0, 5, 1 << 30);
#if DEBUG_STAGE == 3
        dbg_checksum(F, ctl, 10 * l + 16, args.out, (size_t)T * DM * 4); GRID_BAR();
#endif
        route_phase(F, args, l, ctl);
        STAGE_END();
#if DEBUG_STAGE == 3
        dbg_checksum_route(F, ctl, 10 * l + 17); GRID_BAR();
#endif
        const MoeMap mm = moe_map_ptrs(F);
        moe_map_build(F, mm, ctl + CW_CNT + 64 * l);
        {
            const int tid = fresh_tid(); const unsigned* tok_list = (const unsigned*)(F.ws + WS_TOKLIST);
            for (int i = 0; i < 8; ++i) { const int L = i * F.G + F.vcu; if (L >= *mm.ntiles * 4) break;
                const int rt = L >> 2, e = mm.te[rt], lt = rt - mm.first[e];
                if (tid < 256) { const int pos = lt * 256 + tid; mm.rowtok[i * 256 + tid] = pos < mm.cnts[e] ? tok_list[(size_t)e * T + pos] : 0u; } }
            __syncthreads();
            MoeGU S{(const char*)(F.ws + WS_HB), (const char*)(F.ws + WS_WGU), mm, F.G, F.vcu, ctl + CW_JCNT + l * (288 * 64)};
            EpiGateUp E{(bf16*)(F.ws + WS_HMID), (const float*)(F.ws + WS_SLOTR), mm};
            for (int rep_ = 0; rep_ < ((REPEAT_MASK >> 4) & 1) + 1; ++rep_) {
            pg8::gemm_phase<EpiGateUp, MoeGU, true>(F.lds, DM, S, E);
            MoeDown S2{(const char*)(F.ws + WS_HMID), (const char*)(F.ws + WS_WD), mm, F.G, F.vcu, ctl + CW_JCNT + l * (288 * 64), ctl + CW_BAR + XB_TMO};
            EpiDown E2{(bf16*)(F.ws + WS_YBUF), (const float*)(F.ws + WS_SLOTW), mm};
            pg8::gemm_phase<EpiDown, MoeDown, false>(F.lds, DEXP, S2, E2);
            }
        }
        STAGE_END();
        combine_phase(F, args, l, mm);
#if DEBUG_STAGE == 3
        GRID_BAR(); dbg_checksum(F, ctl, 10 * l + 19, args.out, (size_t)T * DM * 4);
#endif
        if (l + 1 < NL) STAGE_END();
    return false;
}

__global__ void __launch_bounds__(NTHREADS, 2) mega_fwd(Args args) {
    extern __shared__ __attribute__((aligned(16))) unsigned char lds_raw[];
    Ctx F;
    F.lds = (LAS unsigned char*)lds_raw; F.ws = args.ws;
    F.tid = threadIdx.x; F.lane = F.tid & 63; F.wave = __builtin_amdgcn_readfirstlane(F.tid >> 6);
    F.G = gridDim.x; F.bid = blockIdx.x; F.vcu = (F.G % 8 == 0) ? (F.bid % 8) * (F.G / 8) + F.bid / 8 : F.bid;
    volatile LAS unsigned* MISC = (volatile LAS unsigned*)(F.lds + MISC_OFF);
    unsigned* ctl = (unsigned*)(args.ws + WS_CTL);
    for (int u = F.tid; u < (LDS_BYTES - LDSCTL_OFF) / 4; u += NTHREADS) ((LAS unsigned*)(F.lds + LDSCTL_OFF))[u] = 0u;
    __syncthreads();
    XcdBarrier bar = xcd_barrier_post(ctl + CW_BAR, MISC + 8);
    unsigned bar_epoch = 0; (void)bar_epoch;

    p0_small_weights(F, args);
    p0_misc(F, args);
#if DEBUG_STAGE == 3
    { unsigned* z = (unsigned*)(args.ws + WS_S5ST); for (size_t i = (size_t)F.bid * NTHREADS + threadIdx.x; i < (2 * MiB) / 4; i += (size_t)F.G * NTHREADS) z[i] = 0x3F800000u; }
#endif
    GRID_BAR();

#if DEBUG_STAGE == 10
    if (F.bid == 0 && threadIdx.x == 0) ((unsigned long long*)(ctl + 3000))[0] = __builtin_amdgcn_s_memrealtime();
#endif
    {
        KvOrder S{(const char*)F.ws, F.G, F.bid}; EpiKV E{F.ws};
        pg8::gemm_phase<EpiKV, KvOrder, false>(F.lds, DM, S, E);
    }
    int nstage = 0; (void)nstage;
#if DEBUG_STAGE == 10
    (void)layer_body<0>(F, args, ctl, bar, nstage, bar_epoch); (void)layer_body<1>(F, args, ctl, bar, nstage, bar_epoch);
    xcd_barrier(bar);
    if (F.bid == 0) {
        const unsigned long long* ts = (const unsigned long long*)(ctl + 3000);
        const float da = (float)(ts[TS_A1] - ts[TS_A0]) * 0.01f, db = (float)(ts[TS_B1] - ts[TS_B0]) * 0.01f;
        const float W = 100.f + db;
        for (int i = (1 << 20) + (int)threadIdx.x; i < (2 << 20); i += NTHREADS) args.out[i] = W;
        if (threadIdx.x == 0) args.out[0] = 1000.f + 10.f * da;
    }
    return;
#endif
    if (layer_body<0>(F, args, ctl, bar, nstage, bar_epoch) || layer_body<1>(F, args, ctl, bar, nstage, bar_epoch)) {
        final_norm_rows(F, (const bf16*)(F.ws + WS_HB), args.in[I_NORM_FINAL_G], args.out);
#if DEBUG_STAGE == 4 || DEBUG_STAGE == 5
        xcd_barrier(bar);
        if (F.bid == 0 && threadIdx.x == 0) args.out[0] = 1000.f + (float)xb_ld(ctl + CW_DIAG);
        if (F.bid == 0) { const float W = 100.f + (float)xb_ld(ctl + CW_DIAG + 1) * (1.f / 400.f); for (int i = (1 << 20) + (int)threadIdx.x; i < (2 << 20); i += NTHREADS) args.out[i] = W; }
#endif
    }

#if DEBUG_STAGE == 9
    xcd_barrier(bar);
    { const unsigned* cur = (const unsigned*)(args.ws + WS_S5ST); unsigned* sv = (unsigned*)(args.ws + WS_HIST + MiB);
      for (size_t i = (size_t)F.bid * NTHREADS + threadIdx.x; i < (2 * MiB) / 4; i += (size_t)F.G * NTHREADS) sv[i] = cur[i]; }
#endif
#if DEBUG_STAGE == 8 || DEBUG_STAGE == 9
    xcd_barrier(bar);
    if (F.bid == 0 && threadIdx.x == 0) {
        unsigned* hist = (unsigned*)(args.ws + WS_HIST);
        unsigned c0 = 0, c1 = 0; if (hist[0] == 0x5EEDC0DEu) { c0 = hist[104]; c1 = hist[105]; }
        c0 += xb_ld(ctl + CW_DIAG + 6); c1 += xb_ld(ctl + CW_DIAG + 7);
        hist[104] = c0; hist[105] = c1; hist[0] = 0x5EEDC0DEu;
#if DEBUG_STAGE == 9
        if (c0) { const unsigned nm = c0 & 0xFFFFu, no = c0 >> 16; args.out[0] = (no * 2 >= nm) ? 6000.f : (no > 0 ? 4000.f : 2000.f); }
#else
        if (c0 | c1) args.out[0] = (c1 ? 4000.f : 0.f) + (c0 ? 2000.f : 0.f);
#endif
    }
#endif
#if DEBUG_STAGE == 7
    xcd_barrier(bar);
    if (F.bid == 0 && threadIdx.x == 0) {
        unsigned* hist = (unsigned*)(args.ws + WS_HIST);
        unsigned c4 = 0, c5 = 0, ct = 0; if (hist[0] == 0x5EEDC0DEu) { c4 = hist[104]; c5 = hist[105]; ct = hist[106]; }
        c4 += xb_ld(ctl + CW_DIAG + 4); c5 += xb_ld(ctl + CW_DIAG + 5); ct += xb_ld(ctl + CW_BAR + XB_TMO);
        hist[104] = c4; hist[105] = c5; hist[106] = ct; hist[0] = 0x5EEDC0DEu;
        if (c4 | c5 | ct) args.out[0] = (ct ? 8000.f : 0.f) + (c5 ? 4000.f : 0.f) + (c4 ? 2000.f : 0.f);
    }
#endif
#if DEBUG_STAGE == 6
    xcd_barrier(bar);
    if (F.bid == 0 && threadIdx.x == 0) {
        unsigned* hist = (unsigned*)(args.ws + WS_HIST);
        unsigned cnt = (hist[0] == 0x5EEDC0DEu) ? hist[101] : 0u;
        cnt += xb_ld(ctl + CW_DIAG);
        hist[101] = cnt; hist[0] = 0x5EEDC0DEu;
        if (cnt) args.out[0] = 500.f * (1.f + log2f((float)cnt + 1.f));
    }
#endif
#if DEBUG_STAGE == 3
    xcd_barrier(bar);
    if (F.bid == 0 && threadIdx.x == 0) {
        unsigned* hist = (unsigned*)(args.ws + WS_HIST);
        unsigned sticky = 0;
        if (hist[0] == 0x5EEDC0DEu) { sticky = hist[100];
            if (sticky == 0) { for (int k = 1; k < 30; ++k) if (hist[k] != xb_ld(ctl + CW_CK + k)) { sticky = (unsigned)k; break; } } }
        for (int k = 1; k < 30; ++k) hist[k] = xb_ld(ctl + CW_CK + k);
        hist[100] = sticky; hist[0] = 0x5EEDC0DEu;
        unsigned nd = hist[101], ndw = hist[102];
        if (nd == 0 || nd == 0xAAAAAAAAu) { nd = xb_ld(ctl + CW_DIAG + 2); ndw = xb_ld(ctl + CW_DIAG + 3); }
        hist[101] = nd; hist[102] = ndw;
        if (sticky) args.out[0] = 1000.f * (float)sticky;
    }
#endif
    return;
}

extern "C" void kernel_launch(void* const* d_in, const int* in_sizes, int n_in, void* d_out, int out_size, void* d_ws, size_t ws_size, hipStream_t stream) {
    static int grid = 0;
    if (grid == 0) {
        int dev = 0, cus = 0, per_cu = 0;
        if (n_in != 37 || out_size != T * DM || ws_size < WS_END) { fprintf(stderr, "kernel_launch: unexpected problem (n_in %d out %d ws %zu)\n", n_in, out_size, ws_size); grid = -1; return; }
        if (hipGetDevice(&dev) != hipSuccess || hipDeviceGetAttribute(&cus, hipDeviceAttributeMultiprocessorCount, dev) != hipSuccess) { fprintf(stderr, "kernel_launch: device query failed\n"); grid = -1; return; }
        if (hipFuncSetAttribute((const void*)mega_fwd, hipFuncAttributeMaxDynamicSharedMemorySize, LDS_BYTES) != hipSuccess) { fprintf(stderr, "kernel_launch: hipFuncSetAttribute failed\n"); grid = -1; return; }
        if (hipOccupancyMaxActiveBlocksPerMultiprocessor(&per_cu, (const void*)mega_fwd, NTHREADS, LDS_BYTES) != hipSuccess || per_cu < 1) { fprintf(stderr, "kernel_launch: occupancy query reports %d\n", per_cu); per_cu = 1; }
        (void)hipGetLastError();
        grid = cus;
    }
    if (grid < 0) return;
    if (hipMemsetAsync((char*)d_ws + WS_CTL, 0, CTL_ZERO_BYTES, stream) != hipSuccess) { fprintf(stderr, "kernel_launch: memset failed\n"); return; }
    Args a{};
    for (int i = 0; i < 37; ++i) a.in[i] = (const float*)d_in[i];
    a.out = (float*)d_out; a.ws = (unsigned char*)d_ws; a.ws_size = (unsigned long long)ws_size;
    void* kargs[] = {&a};
    hipError_t e = hipLaunchCooperativeKernel((const void*)mega_fwd, dim3(grid), dim3(NTHREADS), kargs, LDS_BYTES, stream);
    if (e != hipSuccess) fprintf(stderr, "kernel_launch: cooperative launch failed: %s (grid %d)\n", hipGetErrorString(e), grid);
}
```
